# Optimizing an MI355X kernel written in HIP

```python
import jax, jax.numpy as jnp
from jax import lax
import numpy as np

D_MODEL = 2048
BATCH = 2
SEQ = 16384
DEPTH = 2

PLE_DIM = 256
D_FF = 5632
CONV_WIDTH = 512
CONV_K = 3
ATTN_HEADS = 16
ATTN_KV_HEADS = 2
HEAD_DIM = 64
WINDOW = 128
ATTN_BLOCK = 128
HGRN_HEADS = 8
HGRN_DK = 128
HGRN_DV = 64
HGRN_CHUNK = 64
NORM_EPS = 1e-6
NEG_BIG = -1e30
LB_FLOOR = 1e-20

IN_SPLITS = (CONV_WIDTH, CONV_WIDTH, CONV_WIDTH,
             ATTN_HEADS * HEAD_DIM, ATTN_KV_HEADS * HEAD_DIM, ATTN_KV_HEADS * HEAD_DIM,
             HGRN_HEADS * HGRN_DK, HGRN_HEADS * HGRN_DK, HGRN_HEADS * HGRN_DV, HGRN_HEADS * HGRN_DV,
             D_MODEL, D_MODEL, D_MODEL)
D_IN = sum(IN_SPLITS)

kernel_name = "hybrid_conv_swa_hgrn2_macaron_block"


def rmsnorm(x, w):
    xf = x.astype(jnp.float32)
    y = xf * lax.rsqrt(jnp.mean(xf * xf, axis=-1, keepdims=True) + NORM_EPS) * w.astype(jnp.float32)
    return y.astype(x.dtype)


def swiglu_half_step(x, norm_pre, w_gu, w_down, norm_post):
    h = rmsnorm(x, norm_pre)
    g, u = jnp.split(h @ w_gu, 2, axis=-1)
    y = (jax.nn.silu(g) * u) @ w_down
    return x + 0.5 * rmsnorm(y, norm_post)


def short_conv(xin, b_gate, c_gate, conv_w):
    u = c_gate * xin
    s = u.shape[1]
    y = conv_w[CONV_K - 1] * u
    for j in range(1, CONV_K):
        y = y + conv_w[CONV_K - 1 - j] * jnp.pad(u, ((0, 0), (j, 0), (0, 0)))[:, :s]
    return b_gate * y


def alibi_slopes(n_heads):
    return jnp.exp2(-8.0 * jnp.arange(1, n_heads + 1, dtype=jnp.float32) / n_heads)


def swa_attention(q, k, v, sinks):
    dtype = q.dtype
    b, s, _ = q.shape
    nb = s // ATTN_BLOCK
    g = ATTN_HEADS // ATTN_KV_HEADS
    qb = q.astype(jnp.float32).reshape(b, nb, ATTN_BLOCK, ATTN_KV_HEADS, g, HEAD_DIM)
    kb = k.astype(jnp.float32).reshape(b, nb, ATTN_BLOCK, ATTN_KV_HEADS, HEAD_DIM)
    vb = v.astype(jnp.float32).reshape(b, nb, ATTN_BLOCK, ATTN_KV_HEADS, HEAD_DIM)

    def with_prev(t):
        prev = jnp.concatenate([jnp.zeros_like(t[:, :1]), t[:, :-1]], axis=1)
        return jnp.concatenate([prev, t], axis=2)

    kk, vv = with_prev(kb), with_prev(vb)
    scores = jnp.einsum('bnqhgd,bnkhd->bnhgqk', qb, kk) * (HEAD_DIM ** -0.5)
    qi = jnp.arange(ATTN_BLOCK)
    ki = jnp.arange(2 * ATTN_BLOCK)
    dist = qi[:, None] + ATTN_BLOCK - ki[None, :]
    band = (dist >= 0) & (dist < WINDOW)
    key_pos = jnp.arange(nb)[:, None] * ATTN_BLOCK - ATTN_BLOCK + ki[None, :]
    mask = band[None] & (key_pos >= 0)[:, None, :]
    slopes = alibi_slopes(ATTN_HEADS).reshape(ATTN_KV_HEADS, g)
    scores = scores - slopes[:, :, None, None] * dist.astype(jnp.float32)
    scores = jnp.where(mask[None, :, None, None], scores, NEG_BIG)
    sink = sinks.astype(jnp.float32).reshape(ATTN_KV_HEADS, g)[:, :, None]
    m = jnp.maximum(scores.max(axis=-1), sink)
    pr = jnp.exp(scores - m[..., None])
    denom = pr.sum(axis=-1) + jnp.exp(sink - m)
    o = jnp.einsum('bnhgqk,bnkhd->bnqhgd', pr / denom[..., None], vv)
    return o.reshape(b, s, ATTN_HEADS * HEAD_DIM).astype(dtype)


def hgrn2(q, f_logit, i_in, g_out, lb, norm_w):
    dtype = q.dtype
    b, s, _ = q.shape
    nc = s // HGRN_CHUNK

    def to_chunks(t, d):
        t = t.astype(jnp.float32).reshape(b, nc, HGRN_CHUNK, HGRN_HEADS, d)
        return jnp.transpose(t, (1, 0, 3, 2, 4))

    qc = to_chunks(jax.nn.silu(q), HGRN_DK)
    z = to_chunks(f_logit, HGRN_DK)
    vc = to_chunks(i_in, HGRN_DV)
    lbh = lb.astype(jnp.float32).reshape(HGRN_HEADS, 1, HGRN_DK)
    log_lb = jnp.log(jnp.maximum(lbh, LB_FLOOR))
    log_f = jnp.logaddexp(jax.nn.log_sigmoid(z), log_lb + jax.nn.log_sigmoid(-z))
    kc = (1.0 - lbh) * jax.nn.sigmoid(-z)
    causal = jnp.tril(jnp.ones((HGRN_CHUNK, HGRN_CHUNK), dtype=bool))

    def step(state, xs):
        q_t, lf_t, k_t, v_t = xs
        a = jnp.cumsum(lf_t, axis=-2)
        o_inter = jnp.einsum('bhtk,bhkv->bhtv', q_t * jnp.exp(a), state)
        dec = jnp.where(causal[:, :, None], a[..., :, None, :] - a[..., None, :, :], NEG_BIG)
        att = jnp.einsum('bhtk,bhtsk,bhsk->bhts', q_t, jnp.exp(dec), k_t)
        o = o_inter + jnp.einsum('bhts,bhsv->bhtv', att, v_t)
        a_last = a[..., -1:, :]
        new_state = jnp.exp(a_last[..., 0, :])[..., None] * state + jnp.einsum(
            'bhsk,bhsv->bhkv', k_t * jnp.exp(a_last - a), v_t)
        return new_state, o

    s0 = jnp.zeros((b, HGRN_HEADS, HGRN_DK, HGRN_DV), jnp.float32)
    _, o = lax.scan(step, s0, (qc, log_f, kc, vc))
    o = jnp.transpose(o, (1, 0, 3, 2, 4)).reshape(b, s, HGRN_HEADS, HGRN_DV).astype(dtype)
    o = rmsnorm(o, norm_w).reshape(b, s, HGRN_HEADS * HGRN_DV)
    return o * jax.nn.silu(g_out)


def setup_inputs(seed: int = 0) -> dict:
    key = jax.random.key(seed)
    ks = jax.random.split(key, 25)
    f32 = jnp.float32

    def nrm(k, shape, scale):
        return scale * jax.random.normal(k, shape, f32)

    def gain(k, n):
        return 1.0 + 0.05 * jax.random.normal(k, (DEPTH, n), f32)

    return {
        "x": nrm(ks[0], (BATCH, SEQ, D_MODEL), 1.0),
        "p": nrm(ks[1], (DEPTH, BATCH, SEQ, PLE_DIM), 1.0),
        "ffn1_norm_pre": gain(ks[2], D_MODEL),
        "ffn1_w_gu": nrm(ks[3], (DEPTH, D_MODEL, 2 * D_FF), D_MODEL ** -0.5),
        "ffn1_w_down": nrm(ks[4], (DEPTH, D_FF, D_MODEL), D_FF ** -0.5),
        "ffn1_norm_post": gain(ks[5], D_MODEL),
        "mix_norm_pre": gain(ks[6], D_MODEL),
        "w_in": nrm(ks[7], (DEPTH, D_MODEL, D_IN), D_MODEL ** -0.5),
        "conv_w": nrm(ks[8], (DEPTH, CONV_K, CONV_WIDTH), CONV_K ** -0.5),
        "attn_sinks": nrm(ks[9], (DEPTH, ATTN_HEADS), 0.5),
        "hgrn_lb_logits": nrm(ks[10], (DEPTH, HGRN_HEADS * HGRN_DK), 0.5),
        "hgrn_norm": gain(ks[11], HGRN_DV),
        "w_branch_conv": nrm(ks[12], (DEPTH, CONV_WIDTH, D_MODEL), CONV_WIDTH ** -0.5),
        "w_branch_attn": nrm(ks[13], (DEPTH, ATTN_HEADS * HEAD_DIM, D_MODEL), (ATTN_HEADS * HEAD_DIM) ** -0.5),
        "w_branch_hgrn": nrm(ks[14], (DEPTH, HGRN_HEADS * HGRN_DV, D_MODEL), (HGRN_HEADS * HGRN_DV) ** -0.5),
        "w_o": nrm(ks[15], (DEPTH, D_MODEL, D_MODEL), D_MODEL ** -0.5),
        "mix_norm_post": gain(ks[16], D_MODEL),
        "ffn2_norm_pre": gain(ks[17], D_MODEL),
        "ffn2_w_gu": nrm(ks[18], (DEPTH, D_MODEL, 2 * D_FF), D_MODEL ** -0.5),
        "ffn2_w_down": nrm(ks[19], (DEPTH, D_FF, D_MODEL), D_FF ** -0.5),
        "ffn2_norm_post": gain(ks[20], D_MODEL),
        "ple_norm_pre": gain(ks[21], D_MODEL),
        "w_ple_gate": nrm(ks[22], (DEPTH, D_MODEL, D_MODEL), D_MODEL ** -0.5),
        "w_ple_proj": nrm(ks[23], (DEPTH, PLE_DIM, D_MODEL), PLE_DIM ** -0.5),
        "ple_norm_post": gain(ks[24], D_MODEL),
    }


def reference(x, p, ffn1_norm_pre, ffn1_w_gu, ffn1_w_down, ffn1_norm_post,
              mix_norm_pre, w_in, conv_w, attn_sinks, hgrn_lb_logits, hgrn_norm,
              w_branch_conv, w_branch_attn, w_branch_hgrn, w_o, mix_norm_post,
              ffn2_norm_pre, ffn2_w_gu, ffn2_w_down, ffn2_norm_post,
              ple_norm_pre, w_ple_gate, w_ple_proj, ple_norm_post):
    lb_p = jax.nn.softmax(hgrn_lb_logits.astype(jnp.float32), axis=0)
    lb_all = jnp.cumsum(lb_p, axis=0) - lb_p
    offsets = [int(o) for o in np.cumsum(IN_SPLITS)[:-1]]
    for l in range(DEPTH):
        x = swiglu_half_step(x, ffn1_norm_pre[l], ffn1_w_gu[l], ffn1_w_down[l], ffn1_norm_post[l])
        h = rmsnorm(x, mix_norm_pre[l])
        (c_x, c_b, c_c, a_q, a_k, a_v, r_q, r_f, r_i, r_g,
         g_conv, g_attn, g_hgrn) = jnp.split(h @ w_in[l], offsets, axis=-1)
        y_conv = short_conv(c_x, c_b, c_c, conv_w[l]) @ w_branch_conv[l]
        y_attn = swa_attention(a_q, a_k, a_v, attn_sinks[l]) @ w_branch_attn[l]
        y_hgrn = hgrn2(r_q, r_f, r_i, r_g, lb_all[l], hgrn_norm[l]) @ w_branch_hgrn[l]
        merged = (jax.nn.sigmoid(g_conv) * y_conv + jax.nn.sigmoid(g_attn) * y_attn
                  + jax.nn.sigmoid(g_hgrn) * y_hgrn)
        x = x + rmsnorm(merged @ w_o[l], mix_norm_post[l])
        x = swiglu_half_step(x, ffn2_norm_pre[l], ffn2_w_gu[l], ffn2_w_down[l], ffn2_norm_post[l])
        hp = rmsnorm(x, ple_norm_pre[l])
        ple = jax.nn.sigmoid(hp @ w_ple_gate[l]) * (p[l] @ w_ple_proj[l])
        x = x + rmsnorm(ple, ple_norm_post[l])
    return x
```

```cpp
#include <hip/hip_runtime.h>
#include <cstdio>
#include <cstdint>

#ifndef MK_CHECK
#define MK_CHECK 0
#endif
#ifndef MK_ONE_LAUNCH
#define MK_ONE_LAUNCH 1
#endif

namespace pg8 {
#define PG8_LAS __attribute__((address_space(3)))
typedef unsigned short bf16_t;
typedef short bf16x8 __attribute__((ext_vector_type(8)));
typedef float f32x4 __attribute__((ext_vector_type(4)));
typedef unsigned u32x4 __attribute__((ext_vector_type(4)));
constexpr int BM = 256, BK = 64, HALF = 128, HTB = HALF * BK * 2  , STAGE_BYTES = 8 * HTB, NXCD = 8, WGM = 8;

__host__ __device__ __forceinline__ int lds_byte(int r, int c) { const int st = (r >> 4) * 2 + (c >> 5), rr = r & 15, cc = c & 31, ob = rr * 64 + cc * 2; return st * 1024 + (ob ^ (((ob >> 9) & 1) << 5)); }
__host__ __device__ __forceinline__ void stage_rc(int b, int& R, int& C) { const int st = b / 1024, sb = b % 1024, swz = sb ^ (((sb >> 9) & 1) << 5); R = (st >> 1) * 16 + swz / 64; C = (st & 1) * 32 + (swz % 64) / 2; }
__host__ __device__ __forceinline__ int perm32(int rho) { const int n = rho >> 4, i = rho & 15; return 8 * (i >> 2) + 4 * n + (i & 3); }

struct Unit { int pm, pn; };
struct Gemm { const bf16_t* A; const bf16_t* Bt; int M, N, K; };

struct StaticOrder {
    int nM, nN, nwg, G, c;
    __host__ __device__ void init(int M, int N, int G_, int c_) { nM = M / BM; nN = N / BM; nwg = nM * nN; G = G_; c = c_; }
    __host__ __device__ bool next(int i, Unit& u) const {
        const long L = (long)i * G + c; if (L >= nwg) return false;
        int wgid = (int)L; { const int q = nwg / NXCD, r = nwg % NXCD, xcd = wgid % NXCD, off = wgid / NXCD; wgid = (xcd < r ? xcd * (q + 1) : r * (q + 1) + (xcd - r) * q) + off; }
        const int nig = WGM * nN, gid = wgid / nig, fm = gid * WGM, gsz = (nM - fm) < WGM ? (nM - fm) : WGM;
        u.pm = fm + ((wgid % nig) % gsz); u.pn = (wgid % nig) / gsz; return true;
    }
    __device__ __forceinline__ void a_ready(const Unit&) const {}
    __device__ __forceinline__ void done(const Unit&) const {}
};

typedef float f32x2_t __attribute__((ext_vector_type(2))); typedef __bf16 bf16x2_t __attribute__((ext_vector_type(2)));
__device__ __forceinline__ unsigned cvt_pk_bf16(float lo, float hi) { f32x2_t v = {lo, hi}; bf16x2_t b = __builtin_convertvector(v, bf16x2_t); return __builtin_bit_cast(unsigned, b); }
__device__ __forceinline__ float bf_lo(unsigned w) { return __uint_as_float(w << 16); }
__device__ __forceinline__ float bf_hi(unsigned w) { return __uint_as_float(w & 0xffff0000u); }
__device__ __forceinline__ float sigmoidf_(float v) { return __builtin_amdgcn_rcpf(1.0f + __builtin_amdgcn_exp2f(-1.4426950408889634f * v)); }

template <int ACT> struct EpiBf16 {
    static constexpr bool PERM = true, AFTER_DRAIN = false;
    bf16_t* O; int ldc;
    __device__ __forceinline__ void operator()(const f32x4 (&acc)[2][2][4][2], const Unit& u, int wr, int wc, int fr, int fq) const {
        const int row0 = u.pm * BM + wr * 64 + fr, col0 = u.pn * BM + wc * 32 + 8 * fq;
#pragma unroll
        for (int ai = 0; ai < 2; ++ai)
#pragma unroll
            for (int m = 0; m < 4; ++m) { bf16_t* rowp = O + (size_t)(row0 + ai * HALF + m * 16) * ldc + col0;
#pragma unroll
                for (int bj = 0; bj < 2; ++bj) { f32x4 v0 = acc[ai][bj][m][0], v1 = acc[ai][bj][m][1];
                    if (ACT == 2) {
#pragma unroll
                        for (int e = 0; e < 4; ++e) { v0[e] = sigmoidf_(v0[e]); v1[e] = sigmoidf_(v1[e]); } }
                    u32x4 w; w.x = cvt_pk_bf16(v0[0], v0[1]); w.y = cvt_pk_bf16(v0[2], v0[3]); w.z = cvt_pk_bf16(v1[0], v1[1]); w.w = cvt_pk_bf16(v1[2], v1[3]);
                    *(u32x4*)(rowp + bj * HALF) = w; } }
    }
};
struct EpiSwiglu {
    static constexpr bool PERM = true, AFTER_DRAIN = false;
    bf16_t* H; int ldh;
    __device__ __forceinline__ void operator()(const f32x4 (&acc)[2][2][4][2], const Unit& u, int wr, int wc, int fr, int fq) const {
        const int row0 = u.pm * BM + wr * 64 + fr, col0 = u.pn * HALF + wc * 32 + 8 * fq;
#pragma unroll
        for (int ai = 0; ai < 2; ++ai)
#pragma unroll
            for (int m = 0; m < 4; ++m) { bf16_t* rowp = H + (size_t)(row0 + ai * HALF + m * 16) * ldh + col0;
                f32x4 h0, h1;
#pragma unroll
                for (int e = 0; e < 4; ++e) { const float g0 = acc[ai][0][m][0][e], g1 = acc[ai][0][m][1][e];
                    h0[e] = g0 * sigmoidf_(g0) * acc[ai][1][m][0][e]; h1[e] = g1 * sigmoidf_(g1) * acc[ai][1][m][1][e]; }
                u32x4 w; w.x = cvt_pk_bf16(h0[0], h0[1]); w.y = cvt_pk_bf16(h0[2], h0[3]); w.z = cvt_pk_bf16(h1[0], h1[1]); w.w = cvt_pk_bf16(h1[2], h1[3]);
                *(u32x4*)rowp = w; }
    }
};
struct EpiGateMul {
    static constexpr bool PERM = true, AFTER_DRAIN = false;
    const bf16_t* G; int ldg; bf16_t* O; int ldc; int accum;
    __device__ __forceinline__ void operator()(const f32x4 (&acc)[2][2][4][2], const Unit& u, int wr, int wc, int fr, int fq) const {
        const int row0 = u.pm * BM + wr * 64 + fr, col0 = u.pn * BM + wc * 32 + 8 * fq;
#pragma unroll
        for (int ai = 0; ai < 2; ++ai)
#pragma unroll
            for (int m = 0; m < 4; ++m) { const size_t r = (size_t)(row0 + ai * HALF + m * 16);
#pragma unroll
                for (int bj = 0; bj < 2; ++bj) { const u32x4 gw = *(const u32x4*)(G + r * ldg + col0 + bj * HALF);
                    bf16_t* op = O + r * ldc + col0 + bj * HALF;
                    f32x4 v0 = acc[ai][bj][m][0], v1 = acc[ai][bj][m][1];
                    v0[0] *= bf_lo(gw.x); v0[1] *= bf_hi(gw.x); v0[2] *= bf_lo(gw.y); v0[3] *= bf_hi(gw.y);
                    v1[0] *= bf_lo(gw.z); v1[1] *= bf_hi(gw.z); v1[2] *= bf_lo(gw.w); v1[3] *= bf_hi(gw.w);
                    if (accum) { const u32x4 ow = *(const u32x4*)op;
                        v0[0] += bf_lo(ow.x); v0[1] += bf_hi(ow.x); v0[2] += bf_lo(ow.y); v0[3] += bf_hi(ow.y);
                        v1[0] += bf_lo(ow.z); v1[1] += bf_hi(ow.z); v1[2] += bf_lo(ow.w); v1[3] += bf_hi(ow.w); }
                    u32x4 w; w.x = cvt_pk_bf16(v0[0], v0[1]); w.y = cvt_pk_bf16(v0[2], v0[3]); w.z = cvt_pk_bf16(v1[0], v1[1]); w.w = cvt_pk_bf16(v1[2], v1[3]);
                    *(u32x4*)op = w; } }
    }
};

template <class Epi, class Sched, bool ALIGN_EPI = false, bool SP2 = false>
__device__ __forceinline__ void gemm_phase(PG8_LAS unsigned char* lds, const Gemm g, const Sched& S, const Epi& E) {
    int tid_ = threadIdx.x; asm volatile("" : "+v"(tid_));
    const int tid = tid_, wid = __builtin_amdgcn_readfirstlane(tid >> 6), lane = tid & 63, wr = wid >> 2, wc = wid & 3, fr = lane & 15, fq = lane >> 4;
    const int K = g.K, nt = K / BK;
    unsigned voffA[2], voffB[2];
#pragma unroll
    for (int i = 0; i < 2; ++i) { int R, C; stage_rc(tid * 16 + i * 8192, R, C); const int Rb = Epi::PERM ? ((R & ~31) + perm32(R & 31)) : R;
        voffA[i] = (unsigned)(R * K + C) * 2u; voffB[i] = (unsigned)(Rb * K + C) * 2u; }
    const size_t kstep = (size_t)(BK * 2);
    const size_t hstep = (size_t)HALF * K * 2;
    const size_t tstep = 2 * hstep;
    const unsigned ldsw = (unsigned)wid * 1024u;
    const int aoff = lds_byte(wr * 64 + fr, fq * 8), boff = lds_byte(wc * 32 + fr, fq * 8);
#define PG8_SA(b, h) (((b) * 2 + (h)) * HTB)
#define PG8_SB(b, h) ((4 + (b) * 2 + (h)) * HTB)
#define PG8_STAGE(bufoff, gbase, voff) do { _Pragma("unroll") for (int _i = 0; _i < 2; ++_i) \
        __builtin_amdgcn_global_load_lds((const unsigned*)((const char*)(gbase) + (voff)[_i]), (PG8_LAS unsigned*)(lds + (bufoff) + ldsw + _i * 8192), 16, 0, 0); } while (0)
#define PG8_LDA(dst, b, h) do { _Pragma("unroll") for (int m = 0; m < 4; ++m) _Pragma("unroll") for (int k = 0; k < 2; ++k) dst[m][k] = *(const PG8_LAS bf16x8*)(lds + PG8_SA(b, h) + aoff + m * 2048 + k * 1024); } while (0)
#define PG8_LDB(dst, b, h) do { _Pragma("unroll") for (int n = 0; n < 2; ++n) _Pragma("unroll") for (int k = 0; k < 2; ++k) dst[n][k] = *(const PG8_LAS bf16x8*)(lds + PG8_SB(b, h) + boff + n * 2048 + k * 1024); } while (0)
#define PG8_MMA(ai, bj, At, Bt) do { __builtin_amdgcn_s_setprio(1); _Pragma("unroll") for (int m = 0; m < 4; ++m) _Pragma("unroll") for (int n = 0; n < 2; ++n) _Pragma("unroll") for (int k = 0; k < 2; ++k) \
        acc[ai][bj][m][n] = __builtin_amdgcn_mfma_f32_16x16x32_bf16(Bt[n][k], At[m][k], acc[ai][bj][m][n], 0, 0, 0); __builtin_amdgcn_s_setprio(0); } while (0)
#define PG8_WAIT_V(n) asm volatile("s_waitcnt vmcnt(" #n ")" ::: "memory")
#define PG8_WAIT_L(n) asm volatile("s_waitcnt lgkmcnt(" #n ")" ::: "memory")
#define PG8_BAR __builtin_amdgcn_s_barrier()
#define PG8_SCHED __builtin_amdgcn_sched_barrier(0)
    Unit cur, nxt; int ui = 0;
    if (!S.next(0, cur)) return;
    f32x4 acc[2][2][4][2];
#pragma unroll
    for (int a = 0; a < 2; ++a)
#pragma unroll
        for (int b = 0; b < 2; ++b)
#pragma unroll
            for (int m = 0; m < 4; ++m)
#pragma unroll
                for (int n = 0; n < 2; ++n) acc[a][b][m][n] = (f32x4){0.f, 0.f, 0.f, 0.f};
    bf16x8 At[4][2], B0[2][2], B1[2][2];
    const char* cA = (const char*)g.A + (size_t)cur.pm * tstep; const char* cB = (const char*)g.Bt + (size_t)cur.pn * tstep;
    S.a_ready(cur);
    if constexpr (SP2) {
        PG8_STAGE(PG8_SB(0, 0), cB, voffB); PG8_STAGE(PG8_SB(0, 1), cB + hstep, voffB); PG8_STAGE(PG8_SA(0, 0), cA, voffA); PG8_STAGE(PG8_SA(0, 1), cA + hstep, voffA);
        if (wr == 1) PG8_BAR;
        PG8_WAIT_V(2); PG8_BAR;
        PG8_STAGE(PG8_SB(1, 0), cB + kstep, voffB); PG8_STAGE(PG8_SA(1, 0), cA + kstep, voffA); PG8_STAGE(PG8_SB(1, 1), cB + hstep + kstep, voffB);
        PG8_WAIT_V(6); PG8_BAR;
    } else {
        PG8_STAGE(PG8_SB(0, 0), cB, voffB); PG8_STAGE(PG8_SA(0, 0), cA, voffA); PG8_STAGE(PG8_SB(0, 1), cB + hstep, voffB); PG8_STAGE(PG8_SA(0, 1), cA + hstep, voffA);
        if (wr == 1) PG8_BAR;
        PG8_WAIT_V(4); PG8_BAR;
        PG8_STAGE(PG8_SB(1, 0), cB + kstep, voffB); PG8_STAGE(PG8_SA(1, 0), cA + kstep, voffA); PG8_STAGE(PG8_SB(1, 1), cB + hstep + kstep, voffB);
        PG8_WAIT_V(6); PG8_BAR;
    }
    for (;;) {
        const bool has_next = S.next(ui + 1, nxt);
        const char* nA = has_next ? (const char*)g.A + (size_t)nxt.pm * tstep : cA; const char* nB = has_next ? (const char*)g.Bt + (size_t)nxt.pn * tstep : cB;
        for (int t = 0; t < nt; t += 2) {
            const bool last = (t == nt - 2);
            const char* a1 = cA + (size_t)(t + 1) * kstep;
            const char* a2 = last ? nA : cA + (size_t)(t + 2) * kstep; const char* b2 = last ? nB : cB + (size_t)(t + 2) * kstep;
            const char* a3 = a2 + kstep; const char* b3 = b2 + kstep;
            if (last && has_next) S.a_ready(nxt);
            if constexpr (SP2) {
            PG8_LDB(B0, 0, 0); PG8_LDB(B1, 0, 1); PG8_SCHED; PG8_LDA(At, 0, 0); PG8_STAGE(PG8_SA(1, 1), a1 + hstep, voffA);
            PG8_WAIT_V(8); PG8_WAIT_L(0); PG8_BAR; PG8_MMA(0, 0, At, B0); PG8_MMA(0, 1, At, B1); PG8_BAR; PG8_SCHED;
            PG8_LDA(At, 0, 1); PG8_STAGE(PG8_SB(0, 0), b2, voffB); PG8_STAGE(PG8_SB(0, 1), b2 + hstep, voffB); PG8_STAGE(PG8_SA(0, 0), a2, voffA);
            PG8_WAIT_V(8); PG8_WAIT_L(0); PG8_BAR; PG8_MMA(1, 0, At, B0); PG8_MMA(1, 1, At, B1); PG8_BAR; PG8_SCHED;
            PG8_LDB(B0, 1, 0); PG8_LDB(B1, 1, 1); PG8_SCHED; PG8_LDA(At, 1, 0); PG8_STAGE(PG8_SA(0, 1), a2 + hstep, voffA);
            PG8_WAIT_V(8); PG8_WAIT_L(0); PG8_BAR; PG8_MMA(0, 0, At, B0); PG8_MMA(0, 1, At, B1); PG8_BAR; PG8_SCHED;
            PG8_LDA(At, 1, 1); PG8_STAGE(PG8_SB(1, 0), b3, voffB); PG8_STAGE(PG8_SB(1, 1), b3 + hstep, voffB); PG8_STAGE(PG8_SA(1, 0), a3, voffA);
            PG8_WAIT_V(8); PG8_WAIT_L(0); PG8_BAR; PG8_MMA(1, 0, At, B0); PG8_MMA(1, 1, At, B1); PG8_BAR; PG8_SCHED;
            } else {
            PG8_LDB(B0, 0, 0); PG8_SCHED; PG8_LDA(At, 0, 0); PG8_STAGE(PG8_SA(1, 1), a1 + hstep, voffA);
            PG8_WAIT_L(8); PG8_BAR; PG8_WAIT_L(0); PG8_MMA(0, 0, At, B0); PG8_BAR; PG8_SCHED;
            PG8_LDB(B1, 0, 1); PG8_STAGE(PG8_SB(0, 0), b2, voffB);
            PG8_BAR; PG8_WAIT_L(0); PG8_MMA(0, 1, At, B1); PG8_BAR;
            PG8_LDA(At, 0, 1); PG8_STAGE(PG8_SA(0, 0), a2, voffA);
            PG8_BAR; PG8_WAIT_L(0); PG8_MMA(1, 0, At, B0); PG8_BAR; PG8_SCHED;
            PG8_STAGE(PG8_SB(0, 1), b2 + hstep, voffB);
            PG8_WAIT_V(6); PG8_BAR; PG8_MMA(1, 1, At, B1); PG8_BAR;
            PG8_LDB(B0, 1, 0); PG8_SCHED; PG8_LDA(At, 1, 0); PG8_STAGE(PG8_SA(0, 1), a2 + hstep, voffA);
            PG8_WAIT_L(8); PG8_BAR; PG8_WAIT_L(0); PG8_MMA(0, 0, At, B0); PG8_BAR; PG8_SCHED;
            PG8_LDB(B1, 1, 1); PG8_STAGE(PG8_SB(1, 0), b3, voffB);
            PG8_BAR; PG8_WAIT_L(0); PG8_MMA(0, 1, At, B1); PG8_BAR;
            PG8_LDA(At, 1, 1); PG8_STAGE(PG8_SA(1, 0), a3, voffA);
            PG8_BAR; PG8_WAIT_L(0); PG8_MMA(1, 0, At, B0); PG8_BAR; PG8_SCHED;
            PG8_STAGE(PG8_SB(1, 1), b3 + hstep, voffB);
            PG8_WAIT_V(6); PG8_BAR; PG8_MMA(1, 1, At, B1); PG8_BAR;
            }
        }
        if constexpr (ALIGN_EPI) { if (wr == 0) PG8_BAR; }
        if constexpr (!Epi::AFTER_DRAIN) { E(acc, cur, wr, wc, fr, fq); S.done(cur); }
        if (!has_next) break;
#pragma unroll
        for (int a = 0; a < 2; ++a)
#pragma unroll
            for (int b = 0; b < 2; ++b)
#pragma unroll
                for (int m = 0; m < 4; ++m)
#pragma unroll
                    for (int n = 0; n < 2; ++n) acc[a][b][m][n] = (f32x4){0.f, 0.f, 0.f, 0.f};
        cur = nxt; cA = nA; cB = nB; ++ui;
        if constexpr (ALIGN_EPI) { if (wr == 1) PG8_BAR; }
    }
    PG8_WAIT_V(0);
    if constexpr (!ALIGN_EPI) { if (wr == 0) PG8_BAR; }
    PG8_BAR;
#undef PG8_SA
#undef PG8_SB
#undef PG8_STAGE
#undef PG8_LDA
#undef PG8_LDB
#undef PG8_MMA
#undef PG8_WAIT_V
#undef PG8_WAIT_L
#undef PG8_BAR
#undef PG8_SCHED
}
}

#define PG8_SP2 true
#define PG8_ALIGN true

constexpr int NWAVES = 8, NTHR = NWAVES * 64;
constexpr int D_MODEL = 2048, BATCH = 2, SEQ = 16384, DEPTH = 2, PLE_DIM = 256, D_FF = 5632, CONV_WIDTH = 512;
constexpr int NHEAD = 16, NKV = 2, HEAD_DIM = 64, WINDOW = 128;
constexpr int HG_H = 8, HG_DK = 128, HG_DV = 64, HG_C = 64, HG_NC = SEQ / HG_C;
constexpr int M = BATCH * SEQ;
constexpr int D_IN = 12032, N_MAIN = 5888, N_GATES = 6144;
constexpr int C_CX = 0, C_CB = 512, C_CC = 1024, C_AQ = 1536, C_AK = 2560, C_AV = 2688, C_RQ = 2816, C_RF = 3840, C_RI = 4864, C_RG = 5376;
constexpr float NORM_EPS = 1e-6f;
constexpr int NPH = 18;
constexpr int NPHASES = DEPTH * NPH;

constexpr size_t MiB = 1u << 20;
constexpr size_t WS_CTL = 0, CTL_ZERO_BYTES = 1 * MiB;
constexpr size_t WS_GU1 = 2 * MiB, WS_D1 = 46 * MiB, WS_WIN = 68 * MiB, WS_BC = 115 * MiB, WS_BA = 117 * MiB, WS_BH = 121 * MiB, WS_WO = 123 * MiB,
                 WS_GU2 = 131 * MiB, WS_D2 = 175 * MiB, WS_PG = 197 * MiB, WS_PP = 205 * MiB, WS_PB = 206 * MiB;
constexpr size_t WS_XN = 222 * MiB;
constexpr size_t WS_Y = 350 * MiB;
constexpr size_t WS_FC = WS_Y, WS_FA = WS_Y + 32 * MiB, WS_FH = WS_Y + 96 * MiB;
constexpr size_t WS_BIG = 478 * MiB;
constexpr size_t WS_UT = WS_BIG + 368 * MiB;
constexpr size_t WS_DD = WS_UT + 128 * MiB;
constexpr size_t WS_END = WS_DD + 2 * MiB;
constexpr int CW_BAR = 4096;

constexpr int RING_BYTES = 131072;
constexpr int LDS_X_OFF = RING_BYTES;
constexpr int MISC_OFF = RING_BYTES + 8192;
constexpr int LDS_BYTES = 147456;

#define GAS __attribute__((address_space(1)))
#define LAS __attribute__((address_space(3)))
typedef unsigned short bf16;
typedef unsigned v4u __attribute__((ext_vector_type(4)));
typedef float f32x4 __attribute__((ext_vector_type(4)));
typedef GAS unsigned gu32;
#define LDS_WAIT() asm volatile("s_waitcnt lgkmcnt(0)" ::: "memory")
__device__ __forceinline__ unsigned f2bf(float f) { unsigned u = __builtin_bit_cast(unsigned, f); return (u + 0x7fffu + ((u >> 16) & 1u)) >> 16; }
__device__ __forceinline__ unsigned pk2(float lo, float hi) { return f2bf(lo) | (f2bf(hi) << 16); }
__device__ __forceinline__ float bf2f(bf16 b) { return __uint_as_float((unsigned)b << 16); }
__device__ __forceinline__ float blo(unsigned w) { return __uint_as_float(w << 16); }
__device__ __forceinline__ float bhi(unsigned w) { return __uint_as_float(w & 0xffff0000u); }
__device__ __forceinline__ float sigm(float v) { return 1.0f / (1.0f + __expf(-v)); }

#define XB_TMO      128
#define XB_XCNT(j)  (256  + 64 * (j))
#define XB_XSUB(j)  (1280 + 64 * (j))
#define XB_XGEN(j)  (2304 + 64 * (j))
#define XB_TOP      3328
#define XB_TOPGEN   3392
#define XCD_BAR_WORDS 3456
#define XB_SPIN_CAP (1u << 18)
__device__ __forceinline__ unsigned xb_ld(unsigned* p)              { return __hip_atomic_load(p, __ATOMIC_RELAXED, __HIP_MEMORY_SCOPE_AGENT); }
__device__ __forceinline__ unsigned xb_add(unsigned* p, unsigned v) { return __hip_atomic_fetch_add(p, v, __ATOMIC_RELAXED, __HIP_MEMORY_SCOPE_AGENT); }
__device__ __forceinline__ unsigned xb_xcc_id() { return (unsigned)__builtin_amdgcn_s_getreg((3 << 11) | 20) & 0xFu; }
#define XB_SPIN(cond, bar) do { unsigned _sp = 0; while (cond) { __builtin_amdgcn_s_sleep(1); \
    if ((++_sp & 255u) == 0u) { if (xb_ld(&(bar)[XB_TMO])) break; if (_sp > XB_SPIN_CAP) { atomicAdd(&(bar)[XB_TMO], 1u); break; } } } } while (0)
struct XcdBarrier { unsigned* bar; unsigned x; volatile LAS unsigned* st; };
__device__ __forceinline__ XcdBarrier xcd_barrier_post(unsigned* bar, volatile LAS unsigned* st) {
    XcdBarrier b; b.bar = bar; b.x = xb_xcc_id(); b.st = st;
    if (threadIdx.x == 0) (void)xb_add(&bar[XB_XCNT(b.x)], 1u);
    return b;
}
__device__ __forceinline__ void xcd_barrier_complete(unsigned* bar, unsigned x, unsigned& nloc, unsigned& nx) {
    const unsigned G = gridDim.x * gridDim.y * gridDim.z;
    unsigned sum, cnt, mine, sp = 0u;
    for (;;) {
        sum = 0u; cnt = 0u; mine = 0u;
#pragma unroll
        for (unsigned j = 0; j < 16; ++j) { const unsigned c = xb_ld(&bar[XB_XCNT(j)]); sum += c; cnt += (c > 0u) ? 1u : 0u; mine = (j == x) ? c : mine; }
        if (sum == G) break;
        __builtin_amdgcn_s_sleep(1);
        if ((++sp & 255u) == 0u) { if (xb_ld(&bar[XB_TMO])) break; if (sp > XB_SPIN_CAP) { atomicAdd(&bar[XB_TMO], 1u); break; } }
    }
    nloc = mine > 0u ? mine : 1u; nx = cnt > 0u ? cnt : 1u;
}
__device__ __forceinline__ void xcd_barrier(const XcdBarrier& b) {
    asm volatile("s_waitcnt vmcnt(0)" ::: "memory");
    __syncthreads();
    if (threadIdx.x == 0) {
        unsigned* bar = b.bar;
        __builtin_amdgcn_s_waitcnt(0);
        unsigned nloc = b.st[0], nx = b.st[1];
        if (nloc == 0u) { xcd_barrier_complete(bar, b.x, nloc, nx); b.st[0] = nloc; b.st[1] = nx; }
        const unsigned old = xb_add(&bar[XB_XSUB(b.x)], 1u);
        const unsigned gen = old / nloc;
        if (old + 1u == (gen + 1u) * nloc) {
            __builtin_amdgcn_fence(__ATOMIC_RELEASE, "agent");
            asm volatile("s_waitcnt vmcnt(0)" ::: "memory");
            const unsigned og = xb_add(&bar[XB_TOP], 1u);
            const unsigned tg = og / nx;
            if (og + 1u == (tg + 1u) * nx) xb_add(&bar[XB_TOPGEN], 1u);
            else XB_SPIN(xb_ld(&bar[XB_TOPGEN]) == tg, bar);
            __builtin_amdgcn_fence(__ATOMIC_ACQUIRE, "agent");
            xb_add(&bar[XB_XGEN(b.x)], 1u);
            asm volatile("s_waitcnt vmcnt(0)" ::: "memory");
        } else {
            XB_SPIN(xb_ld(&bar[XB_XGEN(b.x)]) == gen, bar);
            __builtin_amdgcn_fence(__ATOMIC_ACQUIRE, "agent");
            asm volatile("s_waitcnt vmcnt(0)" ::: "memory");
        }
    }
    __syncthreads();
}

struct Args { const float* in[25]; float* out; unsigned char* ws; int ph_lo, ph_hi; };
struct Frame {
    LAS unsigned char* lds;
    int G, bid;
    const float* const* in;
    float* out; unsigned char* ws;
};
#define PHASE_TID() int tid_ = threadIdx.x; asm volatile("" : "+v"(tid_)); const int tid = tid_, lane = tid & 63, wave = __builtin_amdgcn_readfirstlane(tid >> 6); (void)lane; (void)wave
__device__ __forceinline__ float wave_sum(float v) {
#pragma unroll
    for (int o = 1; o < 64; o <<= 1) v += __shfl_xor(v, o);
    return v;
}
__device__ __forceinline__ float wave_max(float v) {
#pragma unroll
    for (int o = 1; o < 64; o <<= 1) v = fmaxf(v, __shfl_xor(v, o));
    return v;
}

__device__ __forceinline__ void transpose_item(const float* W, int K, int N, bf16* WT, LAS float* scr, int item, int lane, bool gu) {
    const int nblk = N / 32, kb = item / nblk, nb = item % nblk, k0 = 64 * kb, nd0 = 32 * nb;
    int ns0 = nd0;
    if (gu) { const int pn = nb >> 3, j = nb & 7; ns0 = ((j & 4) ? D_FF : 0) + 128 * pn + 32 * (j & 3); }
#pragma unroll 8
    for (int i = 0; i < 32; ++i) { const int kk = 2 * i + (lane >> 5); scr[kk * 33 + (lane & 31)] = W[(size_t)(k0 + kk) * N + ns0 + (lane & 31)]; }
    LDS_WAIT(); asm volatile("" ::: "memory");
    const int c = lane & 7;
#pragma unroll
    for (int j = 0; j < 4; ++j) { const int n = (lane >> 3) + 8 * j; const LAS float* s = scr + (8 * c) * 33 + n;
        v4u o; o.x = pk2(s[0 * 33], s[1 * 33]); o.y = pk2(s[2 * 33], s[3 * 33]); o.z = pk2(s[4 * 33], s[5 * 33]); o.w = pk2(s[6 * 33], s[7 * 33]);
        *(GAS v4u*)(WT + (size_t)(nd0 + n) * K + k0 + 8 * c) = o; }
    LDS_WAIT(); asm volatile("" ::: "memory");
}
__device__ __forceinline__ void rms_row_to_bf16(int lane, const float* xrow, const float* w, bf16* orow) {
    f32x4 v[4][2]; float ss = 0.f;
#pragma unroll
    for (int j = 0; j < 4; ++j)
#pragma unroll
        for (int h = 0; h < 2; ++h) { v[j][h] = *(const f32x4*)(xrow + 8 * lane + 512 * j + 4 * h); ss += (v[j][h].x * v[j][h].x + v[j][h].y * v[j][h].y) + (v[j][h].z * v[j][h].z + v[j][h].w * v[j][h].w); }
    const float rstd = 1.0f / sqrtf(wave_sum(ss) * (1.0f / D_MODEL) + NORM_EPS);
#pragma unroll
    for (int j = 0; j < 4; ++j) { const f32x4 w0 = *(const f32x4*)(w + 8 * lane + 512 * j), w1 = *(const f32x4*)(w + 8 * lane + 512 * j + 4);
        const f32x4 a = v[j][0] * rstd * w0, b = v[j][1] * rstd * w1;
        v4u o; o.x = pk2(a.x, a.y); o.y = pk2(a.z, a.w); o.z = pk2(b.x, b.y); o.w = pk2(b.z, b.w);
        *(v4u*)(orow + 8 * lane + 512 * j) = o; }
}

__device__ __forceinline__ void phase_convert(Frame& F, int l) {
    PHASE_TID();
    LAS float* scr = (LAS float*)(F.lds + wave * 16384);
    const int gw = F.bid * NWAVES + wave, NGW = F.G * NWAVES;
    unsigned char* ws = F.ws;
    constexpr int I_GU = (D_MODEL / 64) * (2 * D_FF / 32), I_D = (D_FF / 64) * (D_MODEL / 32), I_WIN = (D_MODEL / 64) * (D_IN / 32),
                  I_BC = (CONV_WIDTH / 64) * (D_MODEL / 32), I_BA = (1024 / 64) * (D_MODEL / 32), I_BH = (512 / 64) * (D_MODEL / 32),
                  I_SQ = (D_MODEL / 64) * (D_MODEL / 32), I_PP = (PLE_DIM / 64) * (D_MODEL / 32);
    constexpr int NITEMS = 2 * I_GU + 2 * I_D + I_WIN + I_BC + I_BA + I_BH + 2 * I_SQ + I_PP;
    for (int it = gw; it < NITEMS; it += NGW) {
        int r = it;
        if (r < I_GU) { transpose_item(F.in[3] + (size_t)l * D_MODEL * 2 * D_FF, D_MODEL, 2 * D_FF, (bf16*)(ws + WS_GU1), scr, r, lane, true); continue; } r -= I_GU;
        if (r < I_D) { transpose_item(F.in[4] + (size_t)l * D_FF * D_MODEL, D_FF, D_MODEL, (bf16*)(ws + WS_D1), scr, r, lane, false); continue; } r -= I_D;
        if (r < I_WIN) { transpose_item(F.in[7] + (size_t)l * D_MODEL * D_IN, D_MODEL, D_IN, (bf16*)(ws + WS_WIN), scr, r, lane, false); continue; } r -= I_WIN;
        if (r < I_BC) { transpose_item(F.in[12] + (size_t)l * CONV_WIDTH * D_MODEL, CONV_WIDTH, D_MODEL, (bf16*)(ws + WS_BC), scr, r, lane, false); continue; } r -= I_BC;
        if (r < I_BA) { transpose_item(F.in[13] + (size_t)l * 1024 * D_MODEL, 1024, D_MODEL, (bf16*)(ws + WS_BA), scr, r, lane, false); continue; } r -= I_BA;
        if (r < I_BH) { transpose_item(F.in[14] + (size_t)l * 512 * D_MODEL, 512, D_MODEL, (bf16*)(ws + WS_BH), scr, r, lane, false); continue; } r -= I_BH;
        if (r < I_SQ) { transpose_item(F.in[15] + (size_t)l * D_MODEL * D_MODEL, D_MODEL, D_MODEL, (bf16*)(ws + WS_WO), scr, r, lane, false); continue; } r -= I_SQ;
        if (r < I_GU) { transpose_item(F.in[18] + (size_t)l * D_MODEL * 2 * D_FF, D_MODEL, 2 * D_FF, (bf16*)(ws + WS_GU2), scr, r, lane, true); continue; } r -= I_GU;
        if (r < I_D) { transpose_item(F.in[19] + (size_t)l * D_FF * D_MODEL, D_FF, D_MODEL, (bf16*)(ws + WS_D2), scr, r, lane, false); continue; } r -= I_D;
        if (r < I_SQ) { transpose_item(F.in[22] + (size_t)l * D_MODEL * D_MODEL, D_MODEL, D_MODEL, (bf16*)(ws + WS_PG), scr, r, lane, false); continue; } r -= I_SQ;
        transpose_item(F.in[23] + (size_t)l * PLE_DIM * D_MODEL, PLE_DIM, D_MODEL, (bf16*)(ws + WS_PP), scr, r, lane, false);
    }
    { const float* p = F.in[1] + (size_t)l * M * PLE_DIM; bf16* pb = (bf16*)(ws + WS_PB);
      const size_t n8 = (size_t)M * PLE_DIM / 8;
      for (size_t i = (size_t)F.bid * NTHR + tid; i < n8; i += (size_t)F.G * NTHR) {
          const f32x4 a = *(const f32x4*)(p + 8 * i), b = *(const f32x4*)(p + 8 * i + 4);
          v4u o; o.x = pk2(a.x, a.y); o.y = pk2(a.z, a.w); o.z = pk2(b.x, b.y); o.w = pk2(b.z, b.w);
          *(v4u*)(pb + 8 * i) = o; } }
    if (l == 0) {
        for (int m = gw; m < M; m += NGW) rms_row_to_bf16(lane, F.in[0] + (size_t)m * D_MODEL, F.in[2], (bf16*)(ws + WS_XN) + (size_t)m * D_MODEL);
    }
}

__device__ __forceinline__ void phase_norm(Frame& F, const float* xin, float alpha, const float* wpost, const float* wpre, int ph = 0) {
    PHASE_TID();
    const int gw = F.bid * NWAVES + wave, NGW = F.G * NWAVES;
    const bf16* Y = (const bf16*)(F.ws + WS_Y); bf16* XN = (bf16*)(F.ws + WS_XN);
    for (int m = gw; m < M; m += NGW) {
        const bf16* yrow = Y + (size_t)m * D_MODEL; const float* xr = xin + (size_t)m * D_MODEL; float* xo = F.out + (size_t)m * D_MODEL;
        float y[4][8]; float ss = 0.f;
#pragma unroll
        for (int j = 0; j < 4; ++j) { const v4u w = *(const v4u*)(yrow + 8 * lane + 512 * j);
            y[j][0] = blo(w.x); y[j][1] = bhi(w.x); y[j][2] = blo(w.y); y[j][3] = bhi(w.y); y[j][4] = blo(w.z); y[j][5] = bhi(w.z); y[j][6] = blo(w.w); y[j][7] = bhi(w.w);
#pragma unroll
            for (int e = 0; e < 8; ++e) ss += y[j][e] * y[j][e]; }
        const float rstd = alpha / sqrtf(wave_sum(ss) * (1.0f / D_MODEL) + NORM_EPS);
#if MK_CHECK
        { float mxv = 0.f;
#pragma unroll
          for (int j = 0; j < 4; ++j)
#pragma unroll
              for (int e = 0; e < 8; ++e) mxv = fmaxf(mxv, fabsf(y[j][e]));
          mxv = wave_max(mxv) * rstd / alpha;
          if (mxv > 20.0f && lane == 0) { atomicMax((unsigned*)(F.ws + WS_CTL) + 65, (unsigned)(NPHASES - ph)); atomicAdd((unsigned*)(F.ws + WS_CTL) + 128 + ph, 1u); } }
#endif
        float ss2 = 0.f;
#pragma unroll
        for (int j = 0; j < 4; ++j) {
#pragma unroll
            for (int h = 0; h < 2; ++h) { const int c = 8 * lane + 512 * j + 4 * h;
                const f32x4 xv = *(const f32x4*)(xr + c), wp = *(const f32x4*)(wpost + c);
                f32x4 nv;
                nv.x = xv.x + y[j][4 * h + 0] * rstd * wp.x; nv.y = xv.y + y[j][4 * h + 1] * rstd * wp.y; nv.z = xv.z + y[j][4 * h + 2] * rstd * wp.z; nv.w = xv.w + y[j][4 * h + 3] * rstd * wp.w;
                *(f32x4*)(xo + c) = nv;
                y[j][4 * h + 0] = nv.x; y[j][4 * h + 1] = nv.y; y[j][4 * h + 2] = nv.z; y[j][4 * h + 3] = nv.w;
                ss2 += (nv.x * nv.x + nv.y * nv.y) + (nv.z * nv.z + nv.w * nv.w); } }
        if (wpre) {
            const float rstd2 = 1.0f / sqrtf(wave_sum(ss2) * (1.0f / D_MODEL) + NORM_EPS);
#pragma unroll
            for (int j = 0; j < 4; ++j) { const int c = 8 * lane + 512 * j;
                const f32x4 w0 = *(const f32x4*)(wpre + c), w1 = *(const f32x4*)(wpre + c + 4);
                v4u o; o.x = pk2(y[j][0] * rstd2 * w0.x, y[j][1] * rstd2 * w0.y); o.y = pk2(y[j][2] * rstd2 * w0.z, y[j][3] * rstd2 * w0.w);
                o.z = pk2(y[j][4] * rstd2 * w1.x, y[j][5] * rstd2 * w1.y); o.w = pk2(y[j][6] * rstd2 * w1.z, y[j][7] * rstd2 * w1.w);
                *(v4u*)(XN + (size_t)m * D_MODEL + c) = o; }
        }
    }
}

__device__ __forceinline__ void phase_conv(Frame& F, int l) {
    PHASE_TID();
    const bf16* main_ = (const bf16*)(F.ws + WS_BIG); bf16* FC = (bf16*)(F.ws + WS_FC);
    const float* cw = F.in[8] + (size_t)l * 3 * CONV_WIDTH;
    for (int it = F.bid * NTHR + tid; it < M * 64; it += F.G * NTHR) {
        const int row = it >> 6, cg = it & 63, t = row & (SEQ - 1);
        float acc[8];
#pragma unroll
        for (int e = 0; e < 8; ++e) acc[e] = 0.f;
#pragma unroll
        for (int j = 0; j < 3; ++j) {
            if (t - j >= 0) {
                const bf16* rp = main_ + (size_t)(row - j) * N_MAIN;
                const v4u xv = *(const v4u*)(rp + C_CX + 8 * cg), cv = *(const v4u*)(rp + C_CC + 8 * cg);
                const float* wj = cw + (2 - j) * CONV_WIDTH + 8 * cg;
                const f32x4 w0 = *(const f32x4*)wj, w1 = *(const f32x4*)(wj + 4);
                acc[0] += w0.x * blo(xv.x) * blo(cv.x); acc[1] += w0.y * bhi(xv.x) * bhi(cv.x); acc[2] += w0.z * blo(xv.y) * blo(cv.y); acc[3] += w0.w * bhi(xv.y) * bhi(cv.y);
                acc[4] += w1.x * blo(xv.z) * blo(cv.z); acc[5] += w1.y * bhi(xv.z) * bhi(cv.z); acc[6] += w1.z * blo(xv.w) * blo(cv.w); acc[7] += w1.w * bhi(xv.w) * bhi(cv.w);
            }
        }
        const v4u bv = *(const v4u*)(main_ + (size_t)row * N_MAIN + C_CB + 8 * cg);
        v4u o; o.x = pk2(acc[0] * blo(bv.x), acc[1] * bhi(bv.x)); o.y = pk2(acc[2] * blo(bv.y), acc[3] * bhi(bv.y));
        o.z = pk2(acc[4] * blo(bv.z), acc[5] * bhi(bv.z)); o.w = pk2(acc[6] * blo(bv.w), acc[7] * bhi(bv.w));
        *(v4u*)(FC + (size_t)row * CONV_WIDTH + 8 * cg) = o;
    }
}
__device__ __forceinline__ void phase_attn_simple(Frame& F, int l) {
    PHASE_TID();
    const bf16* main_ = (const bf16*)(F.ws + WS_BIG); bf16* FA = (bf16*)(F.ws + WS_FA);
    const float* sinks = F.in[9] + (size_t)l * NHEAD;
    const int gw = F.bid * NWAVES + wave, NGW = F.G * NWAVES;
    for (int task = gw; task < M * NHEAD; task += NGW) {
        const int row = task >> 4, h = task & 15, hk = h >> 3, t = row & (SEQ - 1);
        const float slope = exp2f(-0.5f * (float)(h + 1)), sink = sinks[h];
        const bf16* qp = main_ + (size_t)row * N_MAIN + C_AQ + h * 64;
        v4u q[8];
#pragma unroll
        for (int i = 0; i < 8; ++i) q[i] = *(const v4u*)(qp + 8 * i);
        float s[2];
#pragma unroll
        for (int jj = 0; jj < 2; ++jj) {
            const int j = lane + 64 * jj;
            float d = 0.f;
            if (t - j >= 0) {
                const bf16* kp = main_ + (size_t)(row - j) * N_MAIN + C_AK + hk * 64;
#pragma unroll
                for (int i = 0; i < 8; ++i) { const v4u kv = *(const v4u*)(kp + 8 * i);
                    d += blo(q[i].x) * blo(kv.x) + bhi(q[i].x) * bhi(kv.x) + blo(q[i].y) * blo(kv.y) + bhi(q[i].y) * bhi(kv.y)
                       + blo(q[i].z) * blo(kv.z) + bhi(q[i].z) * bhi(kv.z) + blo(q[i].w) * blo(kv.w) + bhi(q[i].w) * bhi(kv.w); }
                s[jj] = d * 0.125f - slope * (float)j;
            } else s[jj] = -1e30f;
        }
        const float mx = fmaxf(wave_max(fmaxf(s[0], s[1])), sink);
        const float p0 = __expf(s[0] - mx), p1 = __expf(s[1] - mx);
        const float denom = wave_sum(p0 + p1) + __expf(sink - mx);
        float acc = 0.f;
        const int jmax = t < (WINDOW - 1) ? t : (WINDOW - 1);
        const bf16* vp = main_ + (size_t)row * N_MAIN + C_AV + hk * 64 + lane;
        for (int j = 0; j <= jmax; ++j) {
            const float pj = __shfl(j < 64 ? p0 : p1, j & 63);
            acc += pj * bf2f(vp[-(ptrdiff_t)j * N_MAIN]);
        }
        FA[(size_t)row * 1024 + h * 64 + lane] = (bf16)f2bf(acc / denom);
    }
}

__device__ __forceinline__ float hgrn_lb(const float* logits, int l, int ch) {
    float mx = -1e30f;
#pragma unroll
    for (int i = 0; i < DEPTH; ++i) mx = fmaxf(mx, logits[i * (HG_H * HG_DK) + ch]);
    float den = 0.f, num = 0.f;
#pragma unroll
    for (int i = 0; i < DEPTH; ++i) { const float e = __expf(logits[i * (HG_H * HG_DK) + ch] - mx); den += e; if (i < l) num += e; }
    return num / den;
}
template <bool WITH_Q>
__device__ __forceinline__ void hgrn_front(Frame& F, int l, int unit, int tid) {
    LAS float* L = (LAS float*)F.lds;
    LAS float* A_ = L; LAS float* KC = L + 8192; LAS float* Q = L + 16384; LAS float* V = L + 24576; LAS float* QT = L + 32768;
    const bf16* main_ = (const bf16*)(F.ws + WS_BIG);
    const int c = unit & (HG_NC - 1), bh = unit >> 8, h = bh & 7, b = bh >> 3;
    const size_t row0 = (size_t)b * SEQ + (size_t)c * HG_C;
    const int k = tid & 127, tq = tid >> 7;
    const float lb = hgrn_lb(F.in[10], l, h * HG_DK + k), lbe = fmaxf(lb, 1e-20f);
    float run = 0.f;
#pragma unroll 4
    for (int tt = 0; tt < 16; ++tt) { const int t = tq * 16 + tt;
        const bf16* rp = main_ + (row0 + t) * N_MAIN;
        const float z = bf2f(rp[C_RF + h * HG_DK + k]);
        const float sg = sigm(z);
        const float f = lbe + (1.0f - lbe) * sg;
        run += __logf(f);
        A_[t * 128 + k] = run; KC[t * 128 + k] = (1.0f - lb) * (1.0f - sg);
        if (WITH_Q) { const float qv = bf2f(rp[C_RQ + h * HG_DK + k]); Q[t * 128 + k] = qv * sigm(qv); }
    }
    QT[tq * 128 + k] = run;
    { const int t = tid >> 3, v8 = (tid & 7) * 8;
      const v4u w = *(const v4u*)(main_ + (row0 + t) * N_MAIN + C_RI + h * HG_DV + v8);
      LAS float* vp = V + t * 64 + v8;
      vp[0] = blo(w.x); vp[1] = bhi(w.x); vp[2] = blo(w.y); vp[3] = bhi(w.y); vp[4] = blo(w.z); vp[5] = bhi(w.z); vp[6] = blo(w.w); vp[7] = bhi(w.w); }
    __syncthreads();
    float off = 0.f;
    for (int q = 0; q < tq; ++q) off += QT[q * 128 + k];
#pragma unroll 4
    for (int tt = 0; tt < 16; ++tt) A_[(tq * 16 + tt) * 128 + k] += off;
    __syncthreads();
}
__device__ __forceinline__ void phase_hgrn_a(Frame& F, int l) {
    PHASE_TID();
    LAS float* L = (LAS float*)F.lds;
    LAS float* A_ = L; LAS float* KC = L + 8192; LAS float* V = L + 24576;
    float* UT = (float*)(F.ws + WS_UT); float* DD = (float*)(F.ws + WS_DD);
    const int k = tid & 127, tq = tid >> 7;
    for (int unit = F.bid; unit < BATCH * HG_H * HG_NC; unit += F.G) {
        hgrn_front<false>(F, l, unit, tid);
        const float alast = A_[63 * 128 + k];
#pragma unroll 4
        for (int tt = 0; tt < 16; ++tt) { const int t = tq * 16 + tt; KC[t * 128 + k] *= __expf(alast - A_[t * 128 + k]); }
        __syncthreads();
        float acc[16];
#pragma unroll
        for (int j = 0; j < 16; ++j) acc[j] = 0.f;
        for (int s = 0; s < 64; ++s) { const float kd = KC[s * 128 + k];
#pragma unroll
            for (int j = 0; j < 16; ++j) acc[j] += kd * V[s * 64 + tq * 16 + j]; }
#pragma unroll
        for (int j = 0; j < 16; ++j) UT[(size_t)unit * 8192 + (tq * 16 + j) * 128 + k] = acc[j];
        if (tq == 0) DD[(size_t)unit * 128 + k] = __expf(alast);
        __syncthreads();
    }
}
__device__ __forceinline__ void phase_hgrn_scan(Frame& F) {
    PHASE_TID();
    float* UT = (float*)(F.ws + WS_UT); const float* DD = (const float*)(F.ws + WS_DD);
    for (int e = F.bid * NTHR + tid; e < BATCH * HG_H * 8192; e += F.G * NTHR) {
        const int bh = e >> 13, vk = e & 8191, k = vk & 127;
        float s = 0.f;
        float* up = UT + (size_t)bh * HG_NC * 8192 + vk; const float* dp = DD + (size_t)bh * HG_NC * 128 + k;
        for (int c = 0; c < HG_NC; c += 8) {
            float u[8], d[8];
#pragma unroll
            for (int i = 0; i < 8; ++i) { u[i] = up[(size_t)(c + i) * 8192]; d[i] = dp[(size_t)(c + i) * 128]; }
#pragma unroll
            for (int i = 0; i < 8; ++i) { up[(size_t)(c + i) * 8192] = s; s = d[i] * s + u[i]; }
        }
    }
}
__device__ __forceinline__ void phase_hgrn_c(Frame& F, int l) {
    PHASE_TID();
    LAS float* L = (LAS float*)F.lds;
    LAS float* A_ = L; LAS float* KC = L + 8192; LAS float* Q = L + 16384; LAS float* V = L + 24576; LAS float* ATT = L + 28672;
    const float* UT = (const float*)(F.ws + WS_UT);
    const bf16* main_ = (const bf16*)(F.ws + WS_BIG); bf16* FH = (bf16*)(F.ws + WS_FH);
    const float* nw = F.in[11] + (size_t)l * HG_DV;
    const int k = tid & 127, tq = tid >> 7, w = wave;
    for (int unit = F.bid; unit < BATCH * HG_H * HG_NC; unit += F.G) {
        hgrn_front<true>(F, l, unit, tid);
        const int c = unit & (HG_NC - 1), bh = unit >> 8, h = bh & 7, b = bh >> 3;
        const size_t row0 = (size_t)b * SEQ + (size_t)c * HG_C;
        for (int p = w; p < 4096; p += NWAVES) { const int t = p >> 6, s = p & 63;
            if (s <= t) {
                float v = Q[t * 128 + lane] * __expf(A_[t * 128 + lane] - A_[s * 128 + lane]) * KC[s * 128 + lane]
                        + Q[t * 128 + 64 + lane] * __expf(A_[t * 128 + 64 + lane] - A_[s * 128 + 64 + lane]) * KC[s * 128 + 64 + lane];
                v = wave_sum(v);
                if (lane == 0) ATT[t * 64 + s] = v;
            }
        }
        __syncthreads();
#pragma unroll 4
        for (int tt = 0; tt < 16; ++tt) { const int t = tq * 16 + tt; Q[t * 128 + k] *= __expf(A_[t * 128 + k]); }
        __syncthreads();
        float acc[8];
#pragma unroll
        for (int i = 0; i < 8; ++i) acc[i] = 0.f;
        for (int s = 0; s < 8 * w + 8; ++s) { const float vv = V[s * 64 + lane];
#pragma unroll
            for (int i = 0; i < 8; ++i) { const int t = 8 * w + i; if (s <= t) acc[i] += ATT[t * 64 + s] * vv; } }
        const float* st = UT + (size_t)unit * 8192 + lane * 128;
        for (int k4 = 0; k4 < 128; k4 += 4) { const f32x4 sv = *(const f32x4*)(st + k4);
#pragma unroll
            for (int i = 0; i < 8; ++i) { const LAS float* qp = Q + (8 * w + i) * 128 + k4; acc[i] += qp[0] * sv.x + qp[1] * sv.y + qp[2] * sv.z + qp[3] * sv.w; } }
        const float nwv = nw[lane];
#pragma unroll
        for (int i = 0; i < 8; ++i) { const int t = 8 * w + i;
            const float ss = wave_sum(acc[i] * acc[i]);
            const float o = acc[i] * (1.0f / sqrtf(ss * (1.0f / HG_DV) + NORM_EPS)) * nwv;
            const float gv = bf2f(main_[(row0 + t) * N_MAIN + C_RG + h * HG_DV + lane]);
            FH[(row0 + t) * 512 + h * HG_DV + lane] = (bf16)f2bf(o * gv * sigm(gv)); }
        __syncthreads();
    }
}


#if MK_CHECK
constexpr int CW_CHK = 64;
__device__ __forceinline__ float bfr(float f) { return __uint_as_float(f2bf(f) << 16); }
__device__ __forceinline__ float dot_ar_wc(const bf16* arow, const float* W, int K, int N, int c) {
    float s = 0.f;
#pragma unroll 8
    for (int k = 0; k < K; ++k) s += bf2f(arow[k]) * bfr(W[(size_t)k * N + c]);
    return s;
}
__device__ __forceinline__ bool chk_bad(float got, float ref) { return !(fabsf(got - ref) <= 0.04f + 0.03f * fabsf(ref)); }
__device__ __forceinline__ void chk_report(Frame& F, int ph, bool fail) { if (fail) atomicMax((unsigned*)(F.ws + WS_CTL) + CW_CHK, (unsigned)(NPHASES - ph)); }
__device__ __forceinline__ void chk_rc(int tid, int ph, int N, int& r, int& c) {
    unsigned h1 = ((unsigned)tid + 1u) * 2654435761u + (unsigned)ph * 40503u; h1 ^= h1 >> 15; h1 *= 0x85ebca6bu; h1 ^= h1 >> 13;
    unsigned h2 = ((unsigned)tid + 77u) * 0x9E3779B1u + (unsigned)ph * 7919u; h2 ^= h2 >> 16; h2 *= 0xc2b2ae35u; h2 ^= h2 >> 13;
    r = (int)(h1 % (unsigned)M); c = (int)(h2 % (unsigned)N);
    if (tid == 0) r = 0; if (tid == 1) r = M - 1; if (tid == 2) r = SEQ - 1; if (tid == 3) r = SEQ; if (tid == 4) r = M - 300; if (tid == 5) r = 31500;
}
__device__ __forceinline__ float chk_rstd_bf(const bf16* row) { float ss = 0.f; for (int k = 0; k < D_MODEL; ++k) { const float v = bf2f(row[k]); ss += v * v; } return 1.0f / sqrtf(ss * (1.0f / D_MODEL) + NORM_EPS); }
__device__ __forceinline__ float chk_rstd_f(const float* row) { float ss = 0.f; for (int k = 0; k < D_MODEL; ++k) { const float v = row[k]; ss += v * v; } return 1.0f / sqrtf(ss * (1.0f / D_MODEL) + NORM_EPS); }
__device__ __forceinline__ void chk_xn(Frame& F, int ph, const float* x, const float* w) {
    PHASE_TID(); int r, c; chk_rc(tid, ph, D_MODEL, r, c);
    const float ref = x[(size_t)r * D_MODEL + c] * chk_rstd_f(x + (size_t)r * D_MODEL) * w[c];
    chk_report(F, ph, chk_bad(bf2f(((const bf16*)(F.ws + WS_XN))[(size_t)r * D_MODEL + c]), ref));
}
__device__ __forceinline__ void chk_gu(Frame& F, int ph, const float* Wgu) {
    PHASE_TID(); int r, j; chk_rc(tid, ph, D_FF, r, j);
    const bf16* a = (const bf16*)(F.ws + WS_XN) + (size_t)r * D_MODEL;
    const float g = dot_ar_wc(a, Wgu, D_MODEL, 2 * D_FF, j), u = dot_ar_wc(a, Wgu, D_MODEL, 2 * D_FF, D_FF + j);
    chk_report(F, ph, chk_bad(bf2f(((const bf16*)(F.ws + WS_BIG))[(size_t)r * D_FF + j]), g * sigm(g) * u));
}
__device__ __forceinline__ void chk_plain(Frame& F, int ph, const bf16* A, int K, const float* W, int NW, int coff, const bf16* OUT, int N, int act) {
    PHASE_TID(); int r, c; chk_rc(tid, ph, N, r, c);
    float ref = dot_ar_wc(A + (size_t)r * K, W, K, NW, coff + c); if (act == 2) ref = sigm(ref);
    chk_report(F, ph, chk_bad(bf2f(OUT[(size_t)r * N + c]), ref));
}
__device__ __forceinline__ void chk_norm(Frame& F, int ph, const float* xin, float alpha, const float* wpost, const float* wpre) {
    PHASE_TID(); int r, c; chk_rc(tid, ph, D_MODEL, r, c);
    const float* xo = F.out + (size_t)r * D_MODEL; bool fail = false;
    { const bf16* y = (const bf16*)(F.ws + WS_Y) + (size_t)r * D_MODEL;
        const float xi = xin ? xin[(size_t)r * D_MODEL + c] : ((const float*)(F.ws + WS_END))[tid];
        const float ref = xi + alpha * bf2f(y[c]) * chk_rstd_bf(y) * wpost[c]; fail = !(fabsf(xo[c] - ref) <= 0.01f + 0.01f * fabsf(ref)); }
    if (wpre) { const float ref = xo[c] * chk_rstd_f(xo) * wpre[c]; fail = fail || chk_bad(bf2f(((const bf16*)(F.ws + WS_XN))[(size_t)r * D_MODEL + c]), ref); }
    chk_report(F, ph, fail);
}
__device__ __forceinline__ void chk_save(Frame& F, int ph) {
    PHASE_TID(); int r, c; chk_rc(tid, ph, D_MODEL, r, c);
    ((float*)(F.ws + WS_END))[tid] = F.out[(size_t)r * D_MODEL + c];
}
__device__ __forceinline__ void chk_conv(Frame& F, int ph, int l) {
    PHASE_TID(); int r, c; chk_rc(tid, ph, CONV_WIDTH, r, c);
    const bf16* mn = (const bf16*)(F.ws + WS_BIG); const float* cw = F.in[8] + (size_t)l * 3 * CONV_WIDTH; const int t = r & (SEQ - 1);
    float y = 0.f;
    for (int j = 0; j < 3; ++j) if (t - j >= 0) { const bf16* rp = mn + (size_t)(r - j) * N_MAIN; y += cw[(2 - j) * CONV_WIDTH + c] * bf2f(rp[C_CC + c]) * bf2f(rp[C_CX + c]); }
    const float ref = bf2f(mn[(size_t)r * N_MAIN + C_CB + c]) * y;
    chk_report(F, ph, chk_bad(bf2f(((const bf16*)(F.ws + WS_FC))[(size_t)r * CONV_WIDTH + c]), ref));
}
__device__ __forceinline__ void chk_attn(Frame& F, int ph, int l) {
    PHASE_TID(); int r, c; chk_rc(tid, ph, 1024, r, c);
    const bf16* mn = (const bf16*)(F.ws + WS_BIG); const int h = c >> 6, d = c & 63, hk = h >> 3, t = r & (SEQ - 1);
    const float slope = exp2f(-0.5f * (float)(h + 1)), sink = F.in[9][l * NHEAD + h];
    const bf16* qp = mn + (size_t)r * N_MAIN + C_AQ + h * 64; const int jmax = t < 127 ? t : 127;
    float mx = sink;
    for (int j = 0; j <= jmax; ++j) { const bf16* kp = mn + (size_t)(r - j) * N_MAIN + C_AK + hk * 64; float s = 0.f; for (int e = 0; e < 64; ++e) s += bf2f(qp[e]) * bf2f(kp[e]); s = s * 0.125f - slope * (float)j; mx = fmaxf(mx, s); }
    float den = expf(sink - mx), acc = 0.f;
    for (int j = 0; j <= jmax; ++j) { const bf16* kp = mn + (size_t)(r - j) * N_MAIN + C_AK + hk * 64; float s = 0.f; for (int e = 0; e < 64; ++e) s += bf2f(qp[e]) * bf2f(kp[e]); s = s * 0.125f - slope * (float)j;
        const float p = expf(s - mx); den += p; acc += p * bf2f(mn[(size_t)(r - j) * N_MAIN + C_AV + hk * 64 + d]); }
    chk_report(F, ph, chk_bad(bf2f(((const bf16*)(F.ws + WS_FA))[(size_t)r * 1024 + c]), acc / den));
}
__device__ __forceinline__ void chk_hgrn(Frame& F, int ph, int l, int b, int h, int c0) {
    PHASE_TID();
    LAS float* L = (LAS float*)F.lds; LAS float* S = L; LAS float* PO = L + 8192;
    const bf16* mn = (const bf16*)(F.ws + WS_BIG); const bf16* FH = (const bf16*)(F.ws + WS_FH);
    const int v = tid & 63, kg = tid >> 6;
    for (int kk = 0; kk < 16; ++kk) { const int k = kg * 16 + kk; S[k * 64 + v] = c0 ? ((const float*)(F.ws + WS_UT))[(size_t)(((b * HG_H + h) << 8) + c0) * 8192 + v * 128 + k] : 0.f; }
    __syncthreads();
    bool fail = false;
    for (int t = 0; t < 200; ++t) {
        const size_t row = (size_t)b * SEQ + (size_t)c0 * HG_C + t; const bf16* rp = mn + row * N_MAIN;
        const float iv = bf2f(rp[C_RI + h * 64 + v]); float po = 0.f;
        for (int kk = 0; kk < 16; ++kk) { const int k = kg * 16 + kk;
            const float lb = hgrn_lb(F.in[10], l, h * HG_DK + k), lbe = fmaxf(lb, 1e-20f);
            const float z = bf2f(rp[C_RF + h * HG_DK + k]), sg = 1.0f / (1.0f + expf(-z));
            const float f = lbe + (1.0f - lbe) * sg, kc = (1.0f - lb) * (1.0f - sg);
            const float qr = bf2f(rp[C_RQ + h * HG_DK + k]), qv = qr / (1.0f + expf(-qr));
            const float s = f * S[k * 64 + v] + kc * iv; S[k * 64 + v] = s; po += s * qv; }
        PO[kg * 64 + v] = po;
        __syncthreads();
        if (tid < 64) { float o = 0.f; for (int q = 0; q < 8; ++q) o += PO[q * 64 + tid];
            const float ss = wave_sum(o * o); const float gv = bf2f(rp[C_RG + h * 64 + tid]);
            const float ref = o * (1.0f / sqrtf(ss * (1.0f / 64.0f) + NORM_EPS)) * F.in[11][l * HG_DV + tid] * gv / (1.0f + expf(-gv));
            fail = fail || chk_bad(bf2f(FH[row * 512 + h * 64 + tid]), ref); }
        __syncthreads();
    }
    chk_report(F, ph, fail);
}
__device__ __forceinline__ void chk_merge(Frame& F, int ph, int l) {
    PHASE_TID(); int r, c; chk_rc(tid, ph, D_MODEL, r, c);
    const bf16* G = (const bf16*)(F.ws + WS_BIG) + (size_t)r * N_GATES;
    const float y0 = dot_ar_wc((const bf16*)(F.ws + WS_FC) + (size_t)r * 512, F.in[12] + (size_t)l * 512 * D_MODEL, 512, D_MODEL, c);
    const float y1 = dot_ar_wc((const bf16*)(F.ws + WS_FA) + (size_t)r * 1024, F.in[13] + (size_t)l * 1024 * D_MODEL, 1024, D_MODEL, c);
    const float y2 = dot_ar_wc((const bf16*)(F.ws + WS_FH) + (size_t)r * 512, F.in[14] + (size_t)l * 512 * D_MODEL, 512, D_MODEL, c);
    const float ref = bf2f(G[c]) * y0 + bf2f(G[D_MODEL + c]) * y1 + bf2f(G[2 * D_MODEL + c]) * y2;
    chk_report(F, ph, chk_bad(bf2f(((const bf16*)(F.ws + WS_XN))[(size_t)r * D_MODEL + c]), ref));
}
__device__ __forceinline__ void chk_ple(Frame& F, int ph, int l) {
    PHASE_TID(); int r, c; chk_rc(tid, ph, D_MODEL, r, c);
    const float y = dot_ar_wc((const bf16*)(F.ws + WS_PB) + (size_t)r * PLE_DIM, F.in[23] + (size_t)l * PLE_DIM * D_MODEL, PLE_DIM, D_MODEL, c);
    const float ref = bf2f(((const bf16*)(F.ws + WS_BIG))[(size_t)r * D_MODEL + c]) * y;
    chk_report(F, ph, chk_bad(bf2f(((const bf16*)(F.ws + WS_Y))[(size_t)r * D_MODEL + c]), ref));
}
#endif

__global__ void __launch_bounds__(NTHR, 2) fwd(Args args) {
    extern __shared__ __attribute__((aligned(16))) unsigned char lds[];
    Frame F;
    F.lds = (LAS unsigned char*)lds;
    F.G = gridDim.x; F.bid = blockIdx.x; F.in = args.in; F.out = args.out; F.ws = args.ws;
    unsigned char* ws = args.ws;
    volatile LAS unsigned* MISC = (volatile LAS unsigned*)(F.lds + MISC_OFF);
    if (threadIdx.x < 32) MISC[threadIdx.x] = 0u;
    __syncthreads();
#if MK_ONE_LAUNCH
    XcdBarrier bar = xcd_barrier_post((unsigned*)(ws + WS_CTL) + CW_BAR, MISC + 8);
#define GRID_BAR() xcd_barrier(bar)
#else
#define GRID_BAR() do {} while (0)
#endif
    const int lo = args.ph_lo, hi = args.ph_hi;
#define IN(k) (lo <= (k) && (k) < hi)
#if MK_CHECK
#define SEAM(k) do { if (IN(k)) GRID_BAR(); } while (0)
#define CHK(k, stmt) do { if (IN(k)) { if (F.bid == 0) { stmt; } GRID_BAR(); } } while (0)
#define CHKSAVE(k) do { if (F.bid == 0) chk_save(F, (k)); GRID_BAR(); } while (0)
#else
#define CHKSAVE(k) do {} while (0)
#define SEAM(k) do { if (IN(k) && IN((k) + 1)) GRID_BAR(); } while (0)
#define CHK(k, stmt) do {} while (0)
#endif
    bf16* XN = (bf16*)(ws + WS_XN); bf16* Y = (bf16*)(ws + WS_Y); bf16* BIG = (bf16*)(ws + WS_BIG);
    using pg8::Gemm; using pg8::StaticOrder;

    for (int l = 0; l < DEPTH; ++l) {
        const int P = l * NPH;
        const float* in_x = (l == 0) ? F.in[0] : F.out;
        if (IN(P + 0)) { phase_convert(F, l); } SEAM(P + 0); CHK(P + 0, if (l == 0) chk_xn(F, P + 0, F.in[0], F.in[2]));
        if (IN(P + 1)) { Gemm g{XN, (const bf16*)(ws + WS_GU1), M, 2 * D_FF, D_MODEL}; StaticOrder S; S.init(M, 2 * D_FF, F.G, F.bid);
            pg8::EpiSwiglu E{BIG, D_FF}; pg8::gemm_phase<pg8::EpiSwiglu, StaticOrder, PG8_ALIGN, PG8_SP2>(F.lds, g, S, E); } SEAM(P + 1); CHK(P + 1, chk_gu(F, P + 1, F.in[3] + (size_t)l * D_MODEL * 2 * D_FF));
        if (IN(P + 2)) { Gemm g{BIG, (const bf16*)(ws + WS_D1), M, D_MODEL, D_FF}; StaticOrder S; S.init(M, D_MODEL, F.G, F.bid);
            pg8::EpiBf16<0> E{Y, D_MODEL}; pg8::gemm_phase<pg8::EpiBf16<0>, StaticOrder, PG8_ALIGN, PG8_SP2>(F.lds, g, S, E); } SEAM(P + 2); CHK(P + 2, chk_plain(F, P + 2, BIG, D_FF, F.in[4] + (size_t)l * D_FF * D_MODEL, D_MODEL, 0, Y, D_MODEL, 0));
        if (IN(P + 3)) { if (l > 0) { CHKSAVE(P + 3); } phase_norm(F, in_x, 0.5f, F.in[5] + l * D_MODEL, F.in[6] + l * D_MODEL, P + 3); } SEAM(P + 3); CHK(P + 3, chk_norm(F, P + 3, (l == 0) ? F.in[0] : nullptr, 0.5f, F.in[5] + l * D_MODEL, F.in[6] + l * D_MODEL));
        if (IN(P + 4)) { Gemm g{XN, (const bf16*)(ws + WS_WIN), M, N_MAIN, D_MODEL}; StaticOrder S; S.init(M, N_MAIN, F.G, F.bid);
            pg8::EpiBf16<0> E{BIG, N_MAIN}; pg8::gemm_phase<pg8::EpiBf16<0>, StaticOrder, PG8_ALIGN, PG8_SP2>(F.lds, g, S, E); } SEAM(P + 4); CHK(P + 4, chk_plain(F, P + 4, XN, D_MODEL, F.in[7] + (size_t)l * D_MODEL * D_IN, D_IN, 0, BIG, N_MAIN, 0));
        if (IN(P + 5)) { phase_conv(F, l); phase_attn_simple(F, l); phase_hgrn_a(F, l); } SEAM(P + 5); CHK(P + 5, chk_conv(F, P + 5, l); chk_attn(F, P + 5, l));
        if (IN(P + 6)) { phase_hgrn_scan(F); } SEAM(P + 6);
        if (IN(P + 7)) { phase_hgrn_c(F, l); } SEAM(P + 7); CHK(P + 7, chk_hgrn(F, P + 7, l, 1, 5, 0); chk_hgrn(F, P + 7, l, 0, 2, 100); chk_hgrn(F, P + 7, l, 1, 7, 252));
        if (IN(P + 8)) { Gemm g{XN, (const bf16*)(ws + WS_WIN) + (size_t)N_MAIN * D_MODEL, M, N_GATES, D_MODEL}; StaticOrder S; S.init(M, N_GATES, F.G, F.bid);
            pg8::EpiBf16<2> E{BIG, N_GATES}; pg8::gemm_phase<pg8::EpiBf16<2>, StaticOrder, PG8_ALIGN, PG8_SP2>(F.lds, g, S, E); } SEAM(P + 8); CHK(P + 8, chk_plain(F, P + 8, XN, D_MODEL, F.in[7] + (size_t)l * D_MODEL * D_IN, D_IN, N_MAIN, BIG, N_GATES, 2));
        if (IN(P + 9)) {
            StaticOrder S; S.init(M, D_MODEL, F.G, F.bid);
            { Gemm g{(const bf16*)(ws + WS_FC), (const bf16*)(ws + WS_BC), M, D_MODEL, CONV_WIDTH};
              pg8::EpiGateMul E{BIG, N_GATES, XN, D_MODEL, 0}; pg8::gemm_phase<pg8::EpiGateMul, StaticOrder, PG8_ALIGN, PG8_SP2>(F.lds, g, S, E); }
            { Gemm g{(const bf16*)(ws + WS_FA), (const bf16*)(ws + WS_BA), M, D_MODEL, 1024};
              pg8::EpiGateMul E{BIG + D_MODEL, N_GATES, XN, D_MODEL, 1}; pg8::gemm_phase<pg8::EpiGateMul, StaticOrder, PG8_ALIGN, PG8_SP2>(F.lds, g, S, E); }
            { Gemm g{(const bf16*)(ws + WS_FH), (const bf16*)(ws + WS_BH), M, D_MODEL, 512};
              pg8::EpiGateMul E{BIG + 2 * D_MODEL, N_GATES, XN, D_MODEL, 1}; pg8::gemm_phase<pg8::EpiGateMul, StaticOrder, PG8_ALIGN, PG8_SP2>(F.lds, g, S, E); }
        } SEAM(P + 9); CHK(P + 9, chk_merge(F, P + 9, l));
        if (IN(P + 10)) { Gemm g{XN, (const bf16*)(ws + WS_WO), M, D_MODEL, D_MODEL}; StaticOrder S; S.init(M, D_MODEL, F.G, F.bid);
            pg8::EpiBf16<0> E{Y, D_MODEL}; pg8::gemm_phase<pg8::EpiBf16<0>, StaticOrder, PG8_ALIGN, PG8_SP2>(F.lds, g, S, E); } SEAM(P + 10); CHK(P + 10, chk_plain(F, P + 10, XN, D_MODEL, F.in[15] + (size_t)l * D_MODEL * D_MODEL, D_MODEL, 0, Y, D_MODEL, 0));
        if (IN(P + 11)) { CHKSAVE(P + 11); phase_norm(F, F.out, 1.0f, F.in[16] + l * D_MODEL, F.in[17] + l * D_MODEL, P + 11); } SEAM(P + 11); CHK(P + 11, chk_norm(F, P + 11, nullptr, 1.0f, F.in[16] + l * D_MODEL, F.in[17] + l * D_MODEL));
        if (IN(P + 12)) { Gemm g{XN, (const bf16*)(ws + WS_GU2), M, 2 * D_FF, D_MODEL}; StaticOrder S; S.init(M, 2 * D_FF, F.G, F.bid);
            pg8::EpiSwiglu E{BIG, D_FF}; pg8::gemm_phase<pg8::EpiSwiglu, StaticOrder, PG8_ALIGN, PG8_SP2>(F.lds, g, S, E); } SEAM(P + 12); CHK(P + 12, chk_gu(F, P + 12, F.in[18] + (size_t)l * D_MODEL * 2 * D_FF));
        if (IN(P + 13)) { Gemm g{BIG, (const bf16*)(ws + WS_D2), M, D_MODEL, D_FF}; StaticOrder S; S.init(M, D_MODEL, F.G, F.bid);
            pg8::EpiBf16<0> E{Y, D_MODEL}; pg8::gemm_phase<pg8::EpiBf16<0>, StaticOrder, PG8_ALIGN, PG8_SP2>(F.lds, g, S, E); } SEAM(P + 13); CHK(P + 13, chk_plain(F, P + 13, BIG, D_FF, F.in[19] + (size_t)l * D_FF * D_MODEL, D_MODEL, 0, Y, D_MODEL, 0));
        if (IN(P + 14)) { CHKSAVE(P + 14); phase_norm(F, F.out, 0.5f, F.in[20] + l * D_MODEL, F.in[21] + l * D_MODEL, P + 14); } SEAM(P + 14); CHK(P + 14, chk_norm(F, P + 14, nullptr, 0.5f, F.in[20] + l * D_MODEL, F.in[21] + l * D_MODEL));
        if (IN(P + 15)) { Gemm g{XN, (const bf16*)(ws + WS_PG), M, D_MODEL, D_MODEL}; StaticOrder S; S.init(M, D_MODEL, F.G, F.bid);
            pg8::EpiBf16<2> E{BIG, D_MODEL}; pg8::gemm_phase<pg8::EpiBf16<2>, StaticOrder, PG8_ALIGN, PG8_SP2>(F.lds, g, S, E); } SEAM(P + 15); CHK(P + 15, chk_plain(F, P + 15, XN, D_MODEL, F.in[22] + (size_t)l * D_MODEL * D_MODEL, D_MODEL, 0, BIG, D_MODEL, 2));
        if (IN(P + 16)) { Gemm g{(const bf16*)(ws + WS_PB), (const bf16*)(ws + WS_PP), M, D_MODEL, PLE_DIM}; StaticOrder S; S.init(M, D_MODEL, F.G, F.bid);
            pg8::EpiGateMul E{BIG, D_MODEL, Y, D_MODEL, 0}; pg8::gemm_phase<pg8::EpiGateMul, StaticOrder, PG8_ALIGN, PG8_SP2>(F.lds, g, S, E); } SEAM(P + 16); CHK(P + 16, chk_ple(F, P + 16, l));
        if (IN(P + 17)) { CHKSAVE(P + 17); phase_norm(F, F.out, 1.0f, F.in[24] + l * D_MODEL, (l + 1 < DEPTH) ? F.in[2] + (l + 1) * D_MODEL : nullptr, P + 17); } SEAM(P + 17); CHK(P + 17, chk_norm(F, P + 17, nullptr, 1.0f, F.in[24] + l * D_MODEL, (l + 1 < DEPTH) ? F.in[2] + (l + 1) * D_MODEL : nullptr));
    }
#if MK_CHECK
    if (F.bid == 0 && threadIdx.x == 0) { const unsigned v = __hip_atomic_load((unsigned*)(ws + WS_CTL) + CW_CHK, __ATOMIC_RELAXED, __HIP_MEMORY_SCOPE_AGENT); if (v) F.out[0] = 1000.0f * (float)v;
        const unsigned v2 = __hip_atomic_load((unsigned*)(ws + WS_CTL) + 65, __ATOMIC_RELAXED, __HIP_MEMORY_SCOPE_AGENT);
        if (v2 && !v) { const unsigned n = __hip_atomic_load((unsigned*)(ws + WS_CTL) + 128 + (NPHASES - v2), __ATOMIC_RELAXED, __HIP_MEMORY_SCOPE_AGENT); F.out[1] = 100.0f + (float)n; } }
#endif
#undef IN
#undef SEAM
}

extern "C" void kernel_launch(void* const* d_in, const int* in_sizes, int n_in, void* d_out, int out_size, void* d_ws, size_t ws_size, hipStream_t stream) {
    static int grid = 0;
    if (grid == 0) {
        if (n_in != 25 || in_sizes[0] != M * D_MODEL || out_size != M * D_MODEL || ws_size < WS_END) {
            fprintf(stderr, "kernel_launch: unexpected shapes (n_in %d, in0 %d, out %d, ws %zu < %zu); nothing launched\n", n_in, n_in > 0 ? in_sizes[0] : -1, out_size, ws_size, (size_t)WS_END); grid = -1; return; }
        int dev = 0, cus = 0, per_cu = 0;
        if (hipGetDevice(&dev) != hipSuccess || hipDeviceGetAttribute(&cus, hipDeviceAttributeMultiprocessorCount, dev) != hipSuccess) { grid = -1; return; }
        if (hipFuncSetAttribute((const void*)fwd, hipFuncAttributeMaxDynamicSharedMemorySize, LDS_BYTES) != hipSuccess) { fprintf(stderr, "kernel_launch: hipFuncSetAttribute failed\n"); grid = -1; return; }
        if (hipOccupancyMaxActiveBlocksPerMultiprocessor(&per_cu, (const void*)fwd, NTHR, LDS_BYTES) != hipSuccess || per_cu < 1)
            fprintf(stderr, "kernel_launch: note: occupancy query reports %d workgroups per CU\n", per_cu);
        (void)hipGetLastError();
        grid = cus;
    }
    if (grid < 0) return;
    if (hipMemsetAsync((char*)d_ws + WS_CTL, 0, CTL_ZERO_BYTES, stream) != hipSuccess) { fprintf(stderr, "kernel_launch: memset failed\n"); return; }
    Args a{};
    for (int i = 0; i < 25; ++i) a.in[i] = (const float*)d_in[i];
    a.out = (float*)d_out; a.ws = (unsigned char*)d_ws;
#if MK_ONE_LAUNCH
    a.ph_lo = 0; a.ph_hi = NPHASES;
    hipLaunchKernelGGL(fwd, dim3(grid), dim3(NTHR), LDS_BYTES, stream, a);
#else
    for (int ph = 0; ph < NPHASES; ++ph) {
        a.ph_lo = ph; a.ph_hi = ph + 1;
        hipLaunchKernelGGL(fwd, dim3(grid), dim3(NTHR), LDS_BYTES, stream, a);
    }
#endif
    const hipError_t le = hipPeekAtLastError();
    if (le != hipSuccess) fprintf(stderr, "kernel_launch: launch failed: %s\n", hipGetErrorName(le));
}
```

```cpp
#include <hip/hip_runtime.h>
#include <cstdio>
#include <cstdint>

#ifndef MK_CHECK
#define MK_CHECK 0
#endif
#ifndef MK_ONE_LAUNCH
#define MK_ONE_LAUNCH 1
#endif

namespace pg8 {
#define PG8_LAS __attribute__((address_space(3)))
typedef unsigned short bf16_t;
typedef short bf16x8 __attribute__((ext_vector_type(8)));
typedef float f32x4 __attribute__((ext_vector_type(4)));
typedef unsigned u32x4 __attribute__((ext_vector_type(4)));
constexpr int BM = 256, BK = 64, HALF = 128, HTB = HALF * BK * 2  , STAGE_BYTES = 8 * HTB, NXCD = 8, WGM = 8;

__host__ __device__ __forceinline__ int lds_byte(int r, int c) { const int st = (r >> 4) * 2 + (c >> 5), rr = r & 15, cc = c & 31, ob = rr * 64 + cc * 2; return st * 1024 + (ob ^ (((ob >> 9) & 1) << 5)); }
__host__ __device__ __forceinline__ void stage_rc(int b, int& R, int& C) { const int st = b / 1024, sb = b % 1024, swz = sb ^ (((sb >> 9) & 1) << 5); R = (st >> 1) * 16 + swz / 64; C = (st & 1) * 32 + (swz % 64) / 2; }
__host__ __device__ __forceinline__ int perm32(int rho) { const int n = rho >> 4, i = rho & 15; return 8 * (i >> 2) + 4 * n + (i & 3); }

struct Unit { int pm, pn; };
struct Gemm { const bf16_t* A; const bf16_t* Bt; int M, N, K; };

struct StaticOrder {
    int nM, nN, nwg, G, c;
    __host__ __device__ void init(int M, int N, int G_, int c_) { nM = M / BM; nN = N / BM; nwg = nM * nN; G = G_; c = c_; }
    __host__ __device__ bool next(int i, Unit& u) const {
        const long L = (long)i * G + c; if (L >= nwg) return false;
        int wgid = (int)L; { const int q = nwg / NXCD, r = nwg % NXCD, xcd = wgid % NXCD, off = wgid / NXCD; wgid = (xcd < r ? xcd * (q + 1) : r * (q + 1) + (xcd - r) * q) + off; }
        const int nig = WGM * nN, gid = wgid / nig, fm = gid * WGM, gsz = (nM - fm) < WGM ? (nM - fm) : WGM;
        u.pm = fm + ((wgid % nig) % gsz); u.pn = (wgid % nig) / gsz; return true;
    }
    __device__ __forceinline__ void a_ready(const Unit&) const {}
    __device__ __forceinline__ void done(const Unit&) const {}
};

typedef float f32x2_t __attribute__((ext_vector_type(2))); typedef __bf16 bf16x2_t __attribute__((ext_vector_type(2)));
__device__ __forceinline__ unsigned cvt_pk_bf16(float lo, float hi) { f32x2_t v = {lo, hi}; bf16x2_t b = __builtin_convertvector(v, bf16x2_t); return __builtin_bit_cast(unsigned, b); }
__device__ __forceinline__ float bf_lo(unsigned w) { return __uint_as_float(w << 16); }
__device__ __forceinline__ float bf_hi(unsigned w) { return __uint_as_float(w & 0xffff0000u); }
__device__ __forceinline__ float sigmoidf_(float v) { return __builtin_amdgcn_rcpf(1.0f + __builtin_amdgcn_exp2f(-1.4426950408889634f * v)); }

template <int ACT> struct EpiBf16 {
    static constexpr bool PERM = true, AFTER_DRAIN = false;
    bf16_t* O; int ldc;
    __device__ __forceinline__ void operator()(const f32x4 (&acc)[2][2][4][2], const Unit& u, int wr, int wc, int fr, int fq) const {
        const int row0 = u.pm * BM + wr * 64 + fr, col0 = u.pn * BM + wc * 32 + 8 * fq;
#pragma unroll
        for (int ai = 0; ai < 2; ++ai)
#pragma unroll
            for (int m = 0; m < 4; ++m) { bf16_t* rowp = O + (size_t)(row0 + ai * HALF + m * 16) * ldc + col0;
#pragma unroll
                for (int bj = 0; bj < 2; ++bj) { f32x4 v0 = acc[ai][bj][m][0], v1 = acc[ai][bj][m][1];
                    if (ACT == 2) {
#pragma unroll
                        for (int e = 0; e < 4; ++e) { v0[e] = sigmoidf_(v0[e]); v1[e] = sigmoidf_(v1[e]); } }
                    u32x4 w; w.x = cvt_pk_bf16(v0[0], v0[1]); w.y = cvt_pk_bf16(v0[2], v0[3]); w.z = cvt_pk_bf16(v1[0], v1[1]); w.w = cvt_pk_bf16(v1[2], v1[3]);
                    *(u32x4*)(rowp + bj * HALF) = w; } }
    }
};
struct EpiSwiglu {
    static constexpr bool PERM = true, AFTER_DRAIN = false;
    bf16_t* H; int ldh;
    __device__ __forceinline__ void operator()(const f32x4 (&acc)[2][2][4][2], const Unit& u, int wr, int wc, int fr, int fq) const {
        const int row0 = u.pm * BM + wr * 64 + fr, col0 = u.pn * HALF + wc * 32 + 8 * fq;
#pragma unroll
        for (int ai = 0; ai < 2; ++ai)
#pragma unroll
            for (int m = 0; m < 4; ++m) { bf16_t* rowp = H + (size_t)(row0 + ai * HALF + m * 16) * ldh + col0;
                f32x4 h0, h1;
#pragma unroll
                for (int e = 0; e < 4; ++e) { const float g0 = acc[ai][0][m][0][e], g1 = acc[ai][0][m][1][e];
                    h0[e] = g0 * sigmoidf_(g0) * acc[ai][1][m][0][e]; h1[e] = g1 * sigmoidf_(g1) * acc[ai][1][m][1][e]; }
                u32x4 w; w.x = cvt_pk_bf16(h0[0], h0[1]); w.y = cvt_pk_bf16(h0[2], h0[3]); w.z = cvt_pk_bf16(h1[0], h1[1]); w.w = cvt_pk_bf16(h1[2], h1[3]);
                *(u32x4*)rowp = w; }
    }
};
struct EpiGateMul {
    static constexpr bool PERM = true, AFTER_DRAIN = false;
    const bf16_t* G; int ldg; bf16_t* O; int ldc; int accum;
    __device__ __forceinline__ void operator()(const f32x4 (&acc)[2][2][4][2], const Unit& u, int wr, int wc, int fr, int fq) const {
        const int row0 = u.pm * BM + wr * 64 + fr, col0 = u.pn * BM + wc * 32 + 8 * fq;
#pragma unroll
        for (int ai = 0; ai < 2; ++ai)
#pragma unroll
            for (int m = 0; m < 4; ++m) { const size_t r = (size_t)(row0 + ai * HALF + m * 16);
#pragma unroll
                for (int bj = 0; bj < 2; ++bj) { const u32x4 gw = *(const u32x4*)(G + r * ldg + col0 + bj * HALF);
                    bf16_t* op = O + r * ldc + col0 + bj * HALF;
                    f32x4 v0 = acc[ai][bj][m][0], v1 = acc[ai][bj][m][1];
                    v0[0] *= bf_lo(gw.x); v0[1] *= bf_hi(gw.x); v0[2] *= bf_lo(gw.y); v0[3] *= bf_hi(gw.y);
                    v1[0] *= bf_lo(gw.z); v1[1] *= bf_hi(gw.z); v1[2] *= bf_lo(gw.w); v1[3] *= bf_hi(gw.w);
                    if (accum) { const u32x4 ow = *(const u32x4*)op;
                        v0[0] += bf_lo(ow.x); v0[1] += bf_hi(ow.x); v0[2] += bf_lo(ow.y); v0[3] += bf_hi(ow.y);
                        v1[0] += bf_lo(ow.z); v1[1] += bf_hi(ow.z); v1[2] += bf_lo(ow.w); v1[3] += bf_hi(ow.w); }
                    u32x4 w; w.x = cvt_pk_bf16(v0[0], v0[1]); w.y = cvt_pk_bf16(v0[2], v0[3]); w.z = cvt_pk_bf16(v1[0], v1[1]); w.w = cvt_pk_bf16(v1[2], v1[3]);
                    *(u32x4*)op = w; } }
    }
};

template <class Epi, class Sched, bool ALIGN_EPI = false, bool SP2 = false>
__device__ __forceinline__ void gemm_phase(PG8_LAS unsigned char* lds, const Gemm g, const Sched& S, const Epi& E) {
    int tid_ = threadIdx.x; asm volatile("" : "+v"(tid_));
    const int tid = tid_, wid = __builtin_amdgcn_readfirstlane(tid >> 6), lane = tid & 63, wr = wid >> 2, wc = wid & 3, fr = lane & 15, fq = lane >> 4;
    const int K = g.K, nt = K / BK;
    unsigned voffA[2], voffB[2];
#pragma unroll
    for (int i = 0; i < 2; ++i) { int R, C; stage_rc(tid * 16 + i * 8192, R, C); const int Rb = Epi::PERM ? ((R & ~31) + perm32(R & 31)) : R;
        voffA[i] = (unsigned)(R * K + C) * 2u; voffB[i] = (unsigned)(Rb * K + C) * 2u; }
    const size_t kstep = (size_t)(BK * 2);
    const size_t hstep = (size_t)HALF * K * 2;
    const size_t tstep = 2 * hstep;
    const unsigned ldsw = (unsigned)wid * 1024u;
    const int aoff = lds_byte(wr * 64 + fr, fq * 8), boff = lds_byte(wc * 32 + fr, fq * 8);
#define PG8_SA(b, h) (((b) * 2 + (h)) * HTB)
#define PG8_SB(b, h) ((4 + (b) * 2 + (h)) * HTB)
#define PG8_STAGE(bufoff, gbase, voff) do { _Pragma("unroll") for (int _i = 0; _i < 2; ++_i) \
        __builtin_amdgcn_global_load_lds((const unsigned*)((const char*)(gbase) + (voff)[_i]), (PG8_LAS unsigned*)(lds + (bufoff) + ldsw + _i * 8192), 16, 0, 0); } while (0)
#define PG8_LDA(dst, b, h) do { _Pragma("unroll") for (int m = 0; m < 4; ++m) _Pragma("unroll") for (int k = 0; k < 2; ++k) dst[m][k] = *(const PG8_LAS bf16x8*)(lds + PG8_SA(b, h) + aoff + m * 2048 + k * 1024); } while (0)
#define PG8_LDB(dst, b, h) do { _Pragma("unroll") for (int n = 0; n < 2; ++n) _Pragma("unroll") for (int k = 0; k < 2; ++k) dst[n][k] = *(const PG8_LAS bf16x8*)(lds + PG8_SB(b, h) + boff + n * 2048 + k * 1024); } while (0)
#define PG8_MMA(ai, bj, At, Bt) do { __builtin_amdgcn_s_setprio(1); _Pragma("unroll") for (int m = 0; m < 4; ++m) _Pragma("unroll") for (int n = 0; n < 2; ++n) _Pragma("unroll") for (int k = 0; k < 2; ++k) \
        acc[ai][bj][m][n] = __builtin_amdgcn_mfma_f32_16x16x32_bf16(Bt[n][k], At[m][k], acc[ai][bj][m][n], 0, 0, 0); __builtin_amdgcn_s_setprio(0); } while (0)
#define PG8_WAIT_V(n) asm volatile("s_waitcnt vmcnt(" #n ")" ::: "memory")
#define PG8_WAIT_L(n) asm volatile("s_waitcnt lgkmcnt(" #n ")" ::: "memory")
#define PG8_BAR __builtin_amdgcn_s_barrier()
#define PG8_SCHED __builtin_amdgcn_sched_barrier(0)
    Unit cur, nxt; int ui = 0;
    if (!S.next(0, cur)) return;
    f32x4 acc[2][2][4][2];
#pragma unroll
    for (int a = 0; a < 2; ++a)
#pragma unroll
        for (int b = 0; b < 2; ++b)
#pragma unroll
            for (int m = 0; m < 4; ++m)
#pragma unroll
                for (int n = 0; n < 2; ++n) acc[a][b][m][n] = (f32x4){0.f, 0.f, 0.f, 0.f};
    bf16x8 At[4][2], B0[2][2], B1[2][2];
    const char* cA = (const char*)g.A + (size_t)cur.pm * tstep; const char* cB = (const char*)g.Bt + (size_t)cur.pn * tstep;
    S.a_ready(cur);
    if constexpr (SP2) {
        PG8_STAGE(PG8_SB(0, 0), cB, voffB); PG8_STAGE(PG8_SB(0, 1), cB + hstep, voffB); PG8_STAGE(PG8_SA(0, 0), cA, voffA); PG8_STAGE(PG8_SA(0, 1), cA + hstep, voffA);
        if (wr == 1) PG8_BAR;
        PG8_WAIT_V(2); PG8_BAR;
        PG8_STAGE(PG8_SB(1, 0), cB + kstep, voffB); PG8_STAGE(PG8_SA(1, 0), cA + kstep, voffA); PG8_STAGE(PG8_SB(1, 1), cB + hstep + kstep, voffB);
        PG8_WAIT_V(6); PG8_BAR;
    } else {
        PG8_STAGE(PG8_SB(0, 0), cB, voffB); PG8_STAGE(PG8_SA(0, 0), cA, voffA); PG8_STAGE(PG8_SB(0, 1), cB + hstep, voffB); PG8_STAGE(PG8_SA(0, 1), cA + hstep, voffA);
        if (wr == 1) PG8_BAR;
        PG8_WAIT_V(4); PG8_BAR;
        PG8_STAGE(PG8_SB(1, 0), cB + kstep, voffB); PG8_STAGE(PG8_SA(1, 0), cA + kstep, voffA); PG8_STAGE(PG8_SB(1, 1), cB + hstep + kstep, voffB);
        PG8_WAIT_V(6); PG8_BAR;
    }
    for (;;) {
        const bool has_next = S.next(ui + 1, nxt);
        const char* nA = has_next ? (const char*)g.A + (size_t)nxt.pm * tstep : cA; const char* nB = has_next ? (const char*)g.Bt + (size_t)nxt.pn * tstep : cB;
        for (int t = 0; t < nt; t += 2) {
            const bool last = (t == nt - 2);
            const char* a1 = cA + (size_t)(t + 1) * kstep;
            const char* a2 = last ? nA : cA + (size_t)(t + 2) * kstep; const char* b2 = last ? nB : cB + (size_t)(t + 2) * kstep;
            const char* a3 = a2 + kstep; const char* b3 = b2 + kstep;
            if (last && has_next) S.a_ready(nxt);
            if constexpr (SP2) {
            PG8_LDB(B0, 0, 0); PG8_LDB(B1, 0, 1); PG8_SCHED; PG8_LDA(At, 0, 0); PG8_STAGE(PG8_SA(1, 1), a1 + hstep, voffA);
            PG8_WAIT_V(8); PG8_WAIT_L(0); PG8_BAR; PG8_MMA(0, 0, At, B0); PG8_MMA(0, 1, At, B1); PG8_BAR; PG8_SCHED;
            PG8_LDA(At, 0, 1); PG8_STAGE(PG8_SB(0, 0), b2, voffB); PG8_STAGE(PG8_SB(0, 1), b2 + hstep, voffB); PG8_STAGE(PG8_SA(0, 0), a2, voffA);
            PG8_WAIT_V(8); PG8_WAIT_L(0); PG8_BAR; PG8_MMA(1, 0, At, B0); PG8_MMA(1, 1, At, B1); PG8_BAR; PG8_SCHED;
            PG8_LDB(B0, 1, 0); PG8_LDB(B1, 1, 1); PG8_SCHED; PG8_LDA(At, 1, 0); PG8_STAGE(PG8_SA(0, 1), a2 + hstep, voffA);
            PG8_WAIT_V(8); PG8_WAIT_L(0); PG8_BAR; PG8_MMA(0, 0, At, B0); PG8_MMA(0, 1, At, B1); PG8_BAR; PG8_SCHED;
            PG8_LDA(At, 1, 1); PG8_STAGE(PG8_SB(1, 0), b3, voffB); PG8_STAGE(PG8_SB(1, 1), b3 + hstep, voffB); PG8_STAGE(PG8_SA(1, 0), a3, voffA);
            PG8_WAIT_V(8); PG8_WAIT_L(0); PG8_BAR; PG8_MMA(1, 0, At, B0); PG8_MMA(1, 1, At, B1); PG8_BAR; PG8_SCHED;
            } else {
            PG8_LDB(B0, 0, 0); PG8_SCHED; PG8_LDA(At, 0, 0); PG8_STAGE(PG8_SA(1, 1), a1 + hstep, voffA);
            PG8_WAIT_L(8); PG8_BAR; PG8_WAIT_L(0); PG8_MMA(0, 0, At, B0); PG8_BAR; PG8_SCHED;
            PG8_LDB(B1, 0, 1); PG8_STAGE(PG8_SB(0, 0), b2, voffB);
            PG8_BAR; PG8_WAIT_L(0); PG8_MMA(0, 1, At, B1); PG8_BAR;
            PG8_LDA(At, 0, 1); PG8_STAGE(PG8_SA(0, 0), a2, voffA);
            PG8_BAR; PG8_WAIT_L(0); PG8_MMA(1, 0, At, B0); PG8_BAR; PG8_SCHED;
            PG8_STAGE(PG8_SB(0, 1), b2 + hstep, voffB);
            PG8_WAIT_V(6); PG8_BAR; PG8_MMA(1, 1, At, B1); PG8_BAR;
            PG8_LDB(B0, 1, 0); PG8_SCHED; PG8_LDA(At, 1, 0); PG8_STAGE(PG8_SA(0, 1), a2 + hstep, voffA);
            PG8_WAIT_L(8); PG8_BAR; PG8_WAIT_L(0); PG8_MMA(0, 0, At, B0); PG8_BAR; PG8_SCHED;
            PG8_LDB(B1, 1, 1); PG8_STAGE(PG8_SB(1, 0), b3, voffB);
            PG8_BAR; PG8_WAIT_L(0); PG8_MMA(0, 1, At, B1); PG8_BAR;
            PG8_LDA(At, 1, 1); PG8_STAGE(PG8_SA(1, 0), a3, voffA);
            PG8_BAR; PG8_WAIT_L(0); PG8_MMA(1, 0, At, B0); PG8_BAR; PG8_SCHED;
            PG8_STAGE(PG8_SB(1, 1), b3 + hstep, voffB);
            PG8_WAIT_V(6); PG8_BAR; PG8_MMA(1, 1, At, B1); PG8_BAR;
            }
        }
        if constexpr (ALIGN_EPI) { if (wr == 0) PG8_BAR; }
        if constexpr (!Epi::AFTER_DRAIN) { E(acc, cur, wr, wc, fr, fq); S.done(cur); }
        if (!has_next) break;
#pragma unroll
        for (int a = 0; a < 2; ++a)
#pragma unroll
            for (int b = 0; b < 2; ++b)
#pragma unroll
                for (int m = 0; m < 4; ++m)
#pragma unroll
                    for (int n = 0; n < 2; ++n) acc[a][b][m][n] = (f32x4){0.f, 0.f, 0.f, 0.f};
        cur = nxt; cA = nA; cB = nB; ++ui;
        if constexpr (ALIGN_EPI) { if (wr == 1) PG8_BAR; }
    }
    PG8_WAIT_V(0);
    if constexpr (!ALIGN_EPI) { if (wr == 0) PG8_BAR; }
    PG8_BAR;
#undef PG8_SA
#undef PG8_SB
#undef PG8_STAGE
#undef PG8_LDA
#undef PG8_LDB
#undef PG8_MMA
#undef PG8_WAIT_V
#undef PG8_WAIT_L
#undef PG8_BAR
#undef PG8_SCHED
}
}

#define PG8_SP2 true
#define PG8_ALIGN true

constexpr int NWAVES = 8, NTHR = NWAVES * 64;
constexpr int D_MODEL = 2048, BATCH = 2, SEQ = 16384, DEPTH = 2, PLE_DIM = 256, D_FF = 5632, CONV_WIDTH = 512;
constexpr int NHEAD = 16, NKV = 2, HEAD_DIM = 64, WINDOW = 128;
constexpr int HG_H = 8, HG_DK = 128, HG_DV = 64, HG_C = 64, HG_NC = SEQ / HG_C;
constexpr int M = BATCH * SEQ;
constexpr int D_IN = 12032, N_MAIN = 5888, N_GATES = 6144;
constexpr int C_CX = 0, C_CB = 512, C_CC = 1024, C_AQ = 1536, C_AK = 2560, C_AV = 2688, C_RQ = 2816, C_RF = 3840, C_RI = 4864, C_RG = 5376;
constexpr float NORM_EPS = 1e-6f;
constexpr int NPH = 18;
constexpr int NPHASES = DEPTH * NPH;

constexpr size_t MiB = 1u << 20;
constexpr size_t WS_CTL = 0, CTL_ZERO_BYTES = 1 * MiB;
constexpr size_t WS_GU1 = 2 * MiB, WS_D1 = 46 * MiB, WS_WIN = 68 * MiB, WS_BC = 115 * MiB, WS_BA = 117 * MiB, WS_BH = 121 * MiB, WS_WO = 123 * MiB,
                 WS_GU2 = 131 * MiB, WS_D2 = 175 * MiB, WS_PG = 197 * MiB, WS_PP = 205 * MiB, WS_PB = 206 * MiB;
constexpr size_t WS_XN = 222 * MiB;
constexpr size_t WS_Y = 350 * MiB;
constexpr size_t WS_FC = WS_Y, WS_FA = WS_Y + 32 * MiB, WS_FH = WS_Y + 96 * MiB;
constexpr size_t WS_BIG = 478 * MiB;
constexpr size_t WS_UT = WS_BIG + 368 * MiB;
constexpr size_t WS_DD = WS_UT + 128 * MiB;
constexpr size_t WS_END = WS_DD + 2 * MiB;
constexpr int CW_BAR = 4096;

constexpr int RING_BYTES = 131072;
constexpr int LDS_X_OFF = RING_BYTES;
constexpr int MISC_OFF = RING_BYTES + 8192;
constexpr int LDS_BYTES = 147456;

#define GAS __attribute__((address_space(1)))
#define LAS __attribute__((address_space(3)))
typedef unsigned short bf16;
typedef unsigned v4u __attribute__((ext_vector_type(4)));
typedef float f32x4 __attribute__((ext_vector_type(4)));
typedef GAS unsigned gu32;
#define LDS_WAIT() asm volatile("s_waitcnt lgkmcnt(0)" ::: "memory")
__device__ __forceinline__ unsigned f2bf(float f) { unsigned u = __builtin_bit_cast(unsigned, f); return (u + 0x7fffu + ((u >> 16) & 1u)) >> 16; }
__device__ __forceinline__ unsigned pk2(float lo, float hi) { return f2bf(lo) | (f2bf(hi) << 16); }
__device__ __forceinline__ float bf2f(bf16 b) { return __uint_as_float((unsigned)b << 16); }
__device__ __forceinline__ float blo(unsigned w) { return __uint_as_float(w << 16); }
__device__ __forceinline__ float bhi(unsigned w) { return __uint_as_float(w & 0xffff0000u); }
__device__ __forceinline__ float sigm(float v) { return 1.0f / (1.0f + __expf(-v)); }

#define XB_TMO      128
#define XB_XCNT(j)  (256  + 64 * (j))
#define XB_XSUB(j)  (1280 + 64 * (j))
#define XB_XGEN(j)  (2304 + 64 * (j))
#define XB_TOP      3328
#define XB_TOPGEN   3392
#define XCD_BAR_WORDS 3456
#define XB_SPIN_CAP (1u << 18)
__device__ __forceinline__ unsigned xb_ld(unsigned* p)              { return __hip_atomic_load(p, __ATOMIC_RELAXED, __HIP_MEMORY_SCOPE_AGENT); }
__device__ __forceinline__ unsigned xb_add(unsigned* p, unsigned v) { return __hip_atomic_fetch_add(p, v, __ATOMIC_RELAXED, __HIP_MEMORY_SCOPE_AGENT); }
__device__ __forceinline__ unsigned xb_xcc_id() { return (unsigned)__builtin_amdgcn_s_getreg((3 << 11) | 20) & 0xFu; }
#define XB_SPIN(cond, bar) do { unsigned _sp = 0; while (cond) { __builtin_amdgcn_s_sleep(1); \
    if ((++_sp & 255u) == 0u) { if (xb_ld(&(bar)[XB_TMO])) break; if (_sp > XB_SPIN_CAP) { atomicAdd(&(bar)[XB_TMO], 1u); break; } } } } while (0)
struct XcdBarrier { unsigned* bar; unsigned x; volatile LAS unsigned* st; };
__device__ __forceinline__ XcdBarrier xcd_barrier_post(unsigned* bar, volatile LAS unsigned* st) {
    XcdBarrier b; b.bar = bar; b.x = xb_xcc_id(); b.st = st;
    if (threadIdx.x == 0) (void)xb_add(&bar[XB_XCNT(b.x)], 1u);
    return b;
}
__device__ __forceinline__ void xcd_barrier_complete(unsigned* bar, unsigned x, unsigned& nloc, unsigned& nx) {
    const unsigned G = gridDim.x * gridDim.y * gridDim.z;
    unsigned sum, cnt, mine, sp = 0u;
    for (;;) {
        sum = 0u; cnt = 0u; mine = 0u;
#pragma unroll
        for (unsigned j = 0; j < 16; ++j) { const unsigned c = xb_ld(&bar[XB_XCNT(j)]); sum += c; cnt += (c > 0u) ? 1u : 0u; mine = (j == x) ? c : mine; }
        if (sum == G) break;
        __builtin_amdgcn_s_sleep(1);
        if ((++sp & 255u) == 0u) { if (xb_ld(&bar[XB_TMO])) break; if (sp > XB_SPIN_CAP) { atomicAdd(&bar[XB_TMO], 1u); break; } }
    }
    nloc = mine > 0u ? mine : 1u; nx = cnt > 0u ? cnt : 1u;
}
__device__ __forceinline__ void xcd_barrier(const XcdBarrier& b) {
    asm volatile("s_waitcnt vmcnt(0)" ::: "memory");
    __syncthreads();
    if (threadIdx.x == 0) {
        unsigned* bar = b.bar;
        __builtin_amdgcn_s_waitcnt(0);
        unsigned nloc = b.st[0], nx = b.st[1];
        if (nloc == 0u) { xcd_barrier_complete(bar, b.x, nloc, nx); b.st[0] = nloc; b.st[1] = nx; }
        const unsigned old = xb_add(&bar[XB_XSUB(b.x)], 1u);
        const unsigned gen = old / nloc;
        if (old + 1u == (gen + 1u) * nloc) {
            __builtin_amdgcn_fence(__ATOMIC_RELEASE, "agent");
            asm volatile("s_waitcnt vmcnt(0)" ::: "memory");
            const unsigned og = xb_add(&bar[XB_TOP], 1u);
            const unsigned tg = og / nx;
            if (og + 1u == (tg + 1u) * nx) xb_add(&bar[XB_TOPGEN], 1u);
            else XB_SPIN(xb_ld(&bar[XB_TOPGEN]) == tg, bar);
            __builtin_amdgcn_fence(__ATOMIC_ACQUIRE, "agent");
            xb_add(&bar[XB_XGEN(b.x)], 1u);
            asm volatile("s_waitcnt vmcnt(0)" ::: "memory");
        } else {
            XB_SPIN(xb_ld(&bar[XB_XGEN(b.x)]) == gen, bar);
            __builtin_amdgcn_fence(__ATOMIC_ACQUIRE, "agent");
            asm volatile("s_waitcnt vmcnt(0)" ::: "memory");
        }
    }
    __syncthreads();
}

struct Args { const float* in[25]; float* out; unsigned char* ws; int ph_lo, ph_hi; };
struct Frame {
    LAS unsigned char* lds;
    int G, bid;
    const float* const* in;
    float* out; unsigned char* ws;
};
#define PHASE_TID() int tid_ = threadIdx.x; asm volatile("" : "+v"(tid_)); const int tid = tid_, lane = tid & 63, wave = __builtin_amdgcn_readfirstlane(tid >> 6); (void)lane; (void)wave
__device__ __forceinline__ float wave_sum(float v) {
#pragma unroll
    for (int o = 1; o < 64; o <<= 1) v += __shfl_xor(v, o);
    return v;
}
__device__ __forceinline__ float wave_max(float v) {
#pragma unroll
    for (int o = 1; o < 64; o <<= 1) v = fmaxf(v, __shfl_xor(v, o));
    return v;
}

__device__ __forceinline__ void transpose_item(const float* W, int K, int N, bf16* WT, LAS float* scr, int item, int lane, bool gu) {
    const int nblk = N / 32, kb = item / nblk, nb = item % nblk, k0 = 64 * kb, nd0 = 32 * nb;
    int ns0 = nd0;
    if (gu) { const int pn = nb >> 3, j = nb & 7; ns0 = ((j & 4) ? D_FF : 0) + 128 * pn + 32 * (j & 3); }
#pragma unroll 8
    for (int i = 0; i < 32; ++i) { const int kk = 2 * i + (lane >> 5); scr[kk * 33 + (lane & 31)] = W[(size_t)(k0 + kk) * N + ns0 + (lane & 31)]; }
    LDS_WAIT(); asm volatile("" ::: "memory");
    const int c = lane & 7;
#pragma unroll
    for (int j = 0; j < 4; ++j) { const int n = (lane >> 3) + 8 * j; const LAS float* s = scr + (8 * c) * 33 + n;
        v4u o; o.x = pk2(s[0 * 33], s[1 * 33]); o.y = pk2(s[2 * 33], s[3 * 33]); o.z = pk2(s[4 * 33], s[5 * 33]); o.w = pk2(s[6 * 33], s[7 * 33]);
        *(GAS v4u*)(WT + (size_t)(nd0 + n) * K + k0 + 8 * c) = o; }
    LDS_WAIT(); asm volatile("" ::: "memory");
}
__device__ __forceinline__ void rms_row_to_bf16(int lane, const float* xrow, const float* w, bf16* orow) {
    f32x4 v[4][2]; float ss = 0.f;
#pragma unroll
    for (int j = 0; j < 4; ++j)
#pragma unroll
        for (int h = 0; h < 2; ++h) { v[j][h] = *(const f32x4*)(xrow + 8 * lane + 512 * j + 4 * h); ss += (v[j][h].x * v[j][h].x + v[j][h].y * v[j][h].y) + (v[j][h].z * v[j][h].z + v[j][h].w * v[j][h].w); }
    const float rstd = 1.0f / sqrtf(wave_sum(ss) * (1.0f / D_MODEL) + NORM_EPS);
#pragma unroll
    for (int j = 0; j < 4; ++j) { const f32x4 w0 = *(const f32x4*)(w + 8 * lane + 512 * j), w1 = *(const f32x4*)(w + 8 * lane + 512 * j + 4);
        const f32x4 a = v[j][0] * rstd * w0, b = v[j][1] * rstd * w1;
        v4u o; o.x = pk2(a.x, a.y); o.y = pk2(a.z, a.w); o.z = pk2(b.x, b.y); o.w = pk2(b.z, b.w);
        *(v4u*)(orow + 8 * lane + 512 * j) = o; }
}

__device__ __forceinline__ void phase_convert(Frame& F, int l) {
    PHASE_TID();
    LAS float* scr = (LAS float*)(F.lds + wave * 16384);
    const int gw = F.bid * NWAVES + wave, NGW = F.G * NWAVES;
    unsigned char* ws = F.ws;
    constexpr int I_GU = (D_MODEL / 64) * (2 * D_FF / 32), I_D = (D_FF / 64) * (D_MODEL / 32), I_WIN = (D_MODEL / 64) * (D_IN / 32),
                  I_BC = (CONV_WIDTH / 64) * (D_MODEL / 32), I_BA = (1024 / 64) * (D_MODEL / 32), I_BH = (512 / 64) * (D_MODEL / 32),
                  I_SQ = (D_MODEL / 64) * (D_MODEL / 32), I_PP = (PLE_DIM / 64) * (D_MODEL / 32);
    constexpr int NITEMS = 2 * I_GU + 2 * I_D + I_WIN + I_BC + I_BA + I_BH + 2 * I_SQ + I_PP;
    for (int it = gw; it < NITEMS; it += NGW) {
        int r = it;
        if (r < I_GU) { transpose_item(F.in[3] + (size_t)l * D_MODEL * 2 * D_FF, D_MODEL, 2 * D_FF, (bf16*)(ws + WS_GU1), scr, r, lane, true); continue; } r -= I_GU;
        if (r < I_D) { transpose_item(F.in[4] + (size_t)l * D_FF * D_MODEL, D_FF, D_MODEL, (bf16*)(ws + WS_D1), scr, r, lane, false); continue; } r -= I_D;
        if (r < I_WIN) { transpose_item(F.in[7] + (size_t)l * D_MODEL * D_IN, D_MODEL, D_IN, (bf16*)(ws + WS_WIN), scr, r, lane, false); continue; } r -= I_WIN;
        if (r < I_BC) { transpose_item(F.in[12] + (size_t)l * CONV_WIDTH * D_MODEL, CONV_WIDTH, D_MODEL, (bf16*)(ws + WS_BC), scr, r, lane, false); continue; } r -= I_BC;
        if (r < I_BA) { transpose_item(F.in[13] + (size_t)l * 1024 * D_MODEL, 1024, D_MODEL, (bf16*)(ws + WS_BA), scr, r, lane, false); continue; } r -= I_BA;
        if (r < I_BH) { transpose_item(F.in[14] + (size_t)l * 512 * D_MODEL, 512, D_MODEL, (bf16*)(ws + WS_BH), scr, r, lane, false); continue; } r -= I_BH;
        if (r < I_SQ) { transpose_item(F.in[15] + (size_t)l * D_MODEL * D_MODEL, D_MODEL, D_MODEL, (bf16*)(ws + WS_WO), scr, r, lane, false); continue; } r -= I_SQ;
        if (r < I_GU) { transpose_item(F.in[18] + (size_t)l * D_MODEL * 2 * D_FF, D_MODEL, 2 * D_FF, (bf16*)(ws + WS_GU2), scr, r, lane, true); continue; } r -= I_GU;
        if (r < I_D) { transpose_item(F.in[19] + (size_t)l * D_FF * D_MODEL, D_FF, D_MODEL, (bf16*)(ws + WS_D2), scr, r, lane, false); continue; } r -= I_D;
        if (r < I_SQ) { transpose_item(F.in[22] + (size_t)l * D_MODEL * D_MODEL, D_MODEL, D_MODEL, (bf16*)(ws + WS_PG), scr, r, lane, false); continue; } r -= I_SQ;
        transpose_item(F.in[23] + (size_t)l * PLE_DIM * D_MODEL, PLE_DIM, D_MODEL, (bf16*)(ws + WS_PP), scr, r, lane, false);
    }
    { const float* p = F.in[1] + (size_t)l * M * PLE_DIM; bf16* pb = (bf16*)(ws + WS_PB);
      const size_t n8 = (size_t)M * PLE_DIM / 8;
      for (size_t i = (size_t)F.bid * NTHR + tid; i < n8; i += (size_t)F.G * NTHR) {
          const f32x4 a = *(const f32x4*)(p + 8 * i), b = *(const f32x4*)(p + 8 * i + 4);
          v4u o; o.x = pk2(a.x, a.y); o.y = pk2(a.z, a.w); o.z = pk2(b.x, b.y); o.w = pk2(b.z, b.w);
          *(v4u*)(pb + 8 * i) = o; } }
    if (l == 0) {
        for (int m = gw; m < M; m += NGW) rms_row_to_bf16(lane, F.in[0] + (size_t)m * D_MODEL, F.in[2], (bf16*)(ws + WS_XN) + (size_t)m * D_MODEL);
    }
}

__device__ __forceinline__ void phase_norm(Frame& F, const float* xin, float alpha, const float* wpost, const float* wpre, int ph = 0) {
    PHASE_TID();
    const int gw = F.bid * NWAVES + wave, NGW = F.G * NWAVES;
    const bf16* Y = (const bf16*)(F.ws + WS_Y); bf16* XN = (bf16*)(F.ws + WS_XN);
    for (int m = gw; m < M; m += NGW) {
        const bf16* yrow = Y + (size_t)m * D_MODEL; const float* xr = xin + (size_t)m * D_MODEL; float* xo = F.out + (size_t)m * D_MODEL;
        float y[4][8]; float ss = 0.f;
#pragma unroll
        for (int j = 0; j < 4; ++j) { const v4u w = *(const v4u*)(yrow + 8 * lane + 512 * j);
            y[j][0] = blo(w.x); y[j][1] = bhi(w.x); y[j][2] = blo(w.y); y[j][3] = bhi(w.y); y[j][4] = blo(w.z); y[j][5] = bhi(w.z); y[j][6] = blo(w.w); y[j][7] = bhi(w.w);
#pragma unroll
            for (int e = 0; e < 8; ++e) ss += y[j][e] * y[j][e]; }
        const float rstd = alpha / sqrtf(wave_sum(ss) * (1.0f / D_MODEL) + NORM_EPS);
#if MK_CHECK
        { float mxv = 0.f;
#pragma unroll
          for (int j = 0; j < 4; ++j)
#pragma unroll
              for (int e = 0; e < 8; ++e) mxv = fmaxf(mxv, fabsf(y[j][e]));
          mxv = wave_max(mxv) * rstd / alpha;
          if (mxv > 20.0f && lane == 0) { atomicMax((unsigned*)(F.ws + WS_CTL) + 65, (unsigned)(NPHASES - ph)); atomicAdd((unsigned*)(F.ws + WS_CTL) + 128 + ph, 1u); } }
#endif
        float ss2 = 0.f;
#pragma unroll
        for (int j = 0; j < 4; ++j) {
#pragma unroll
            for (int h = 0; h < 2; ++h) { const int c = 8 * lane + 512 * j + 4 * h;
                const f32x4 xv = *(const f32x4*)(xr + c), wp = *(const f32x4*)(wpost + c);
                f32x4 nv;
                nv.x = xv.x + y[j][4 * h + 0] * rstd * wp.x; nv.y = xv.y + y[j][4 * h + 1] * rstd * wp.y; nv.z = xv.z + y[j][4 * h + 2] * rstd * wp.z; nv.w = xv.w + y[j][4 * h + 3] * rstd * wp.w;
                *(f32x4*)(xo + c) = nv;
                y[j][4 * h + 0] = nv.x; y[j][4 * h + 1] = nv.y; y[j][4 * h + 2] = nv.z; y[j][4 * h + 3] = nv.w;
                ss2 += (nv.x * nv.x + nv.y * nv.y) + (nv.z * nv.z + nv.w * nv.w); } }
        if (wpre) {
            const float rstd2 = 1.0f / sqrtf(wave_sum(ss2) * (1.0f / D_MODEL) + NORM_EPS);
#pragma unroll
            for (int j = 0; j < 4; ++j) { const int c = 8 * lane + 512 * j;
                const f32x4 w0 = *(const f32x4*)(wpre + c), w1 = *(const f32x4*)(wpre + c + 4);
                v4u o; o.x = pk2(y[j][0] * rstd2 * w0.x, y[j][1] * rstd2 * w0.y); o.y = pk2(y[j][2] * rstd2 * w0.z, y[j][3] * rstd2 * w0.w);
                o.z = pk2(y[j][4] * rstd2 * w1.x, y[j][5] * rstd2 * w1.y); o.w = pk2(y[j][6] * rstd2 * w1.z, y[j][7] * rstd2 * w1.w);
                *(v4u*)(XN + (size_t)m * D_MODEL + c) = o; }
        }
    }
}

__device__ __forceinline__ void phase_conv(Frame& F, int l) {
    PHASE_TID();
    const bf16* main_ = (const bf16*)(F.ws + WS_BIG); bf16* FC = (bf16*)(F.ws + WS_FC);
    const float* cw = F.in[8] + (size_t)l * 3 * CONV_WIDTH;
    for (int it = F.bid * NTHR + tid; it < M * 64; it += F.G * NTHR) {
        const int row = it >> 6, cg = it & 63, t = row & (SEQ - 1);
        float acc[8];
#pragma unroll
        for (int e = 0; e < 8; ++e) acc[e] = 0.f;
#pragma unroll
        for (int j = 0; j < 3; ++j) {
            if (t - j >= 0) {
                const bf16* rp = main_ + (size_t)(row - j) * N_MAIN;
                const v4u xv = *(const v4u*)(rp + C_CX + 8 * cg), cv = *(const v4u*)(rp + C_CC + 8 * cg);
                const float* wj = cw + (2 - j) * CONV_WIDTH + 8 * cg;
                const f32x4 w0 = *(const f32x4*)wj, w1 = *(const f32x4*)(wj + 4);
                acc[0] += w0.x * blo(xv.x) * blo(cv.x); acc[1] += w0.y * bhi(xv.x) * bhi(cv.x); acc[2] += w0.z * blo(xv.y) * blo(cv.y); acc[3] += w0.w * bhi(xv.y) * bhi(cv.y);
                acc[4] += w1.x * blo(xv.z) * blo(cv.z); acc[5] += w1.y * bhi(xv.z) * bhi(cv.z); acc[6] += w1.z * blo(xv.w) * blo(cv.w); acc[7] += w1.w * bhi(xv.w) * bhi(cv.w);
            }
        }
        const v4u bv = *(const v4u*)(main_ + (size_t)row * N_MAIN + C_CB + 8 * cg);
        v4u o; o.x = pk2(acc[0] * blo(bv.x), acc[1] * bhi(bv.x)); o.y = pk2(acc[2] * blo(bv.y), acc[3] * bhi(bv.y));
        o.z = pk2(acc[4] * blo(bv.z), acc[5] * bhi(bv.z)); o.w = pk2(acc[6] * blo(bv.w), acc[7] * bhi(bv.w));
        *(v4u*)(FC + (size_t)row * CONV_WIDTH + 8 * cg) = o;
    }
}
__device__ __forceinline__ void phase_attn_simple(Frame& F, int l) {
    PHASE_TID();
    const bf16* main_ = (const bf16*)(F.ws + WS_BIG); bf16* FA = (bf16*)(F.ws + WS_FA);
    const float* sinks = F.in[9] + (size_t)l * NHEAD;
    const int gw = F.bid * NWAVES + wave, NGW = F.G * NWAVES;
    for (int task = gw; task < M * NHEAD; task += NGW) {
        const int row = task >> 4, h = task & 15, hk = h >> 3, t = row & (SEQ - 1);
        const float slope = exp2f(-0.5f * (float)(h + 1)), sink = sinks[h];
        const bf16* qp = main_ + (size_t)row * N_MAIN + C_AQ + h * 64;
        v4u q[8];
#pragma unroll
        for (int i = 0; i < 8; ++i) q[i] = *(const v4u*)(qp + 8 * i);
        float s[2];
#pragma unroll
        for (int jj = 0; jj < 2; ++jj) {
            const int j = lane + 64 * jj;
            float d = 0.f;
            if (t - j >= 0) {
                const bf16* kp = main_ + (size_t)(row - j) * N_MAIN + C_AK + hk * 64;
#pragma unroll
                for (int i = 0; i < 8; ++i) { const v4u kv = *(const v4u*)(kp + 8 * i);
                    d += blo(q[i].x) * blo(kv.x) + bhi(q[i].x) * bhi(kv.x) + blo(q[i].y) * blo(kv.y) + bhi(q[i].y) * bhi(kv.y)
                       + blo(q[i].z) * blo(kv.z) + bhi(q[i].z) * bhi(kv.z) + blo(q[i].w) * blo(kv.w) + bhi(q[i].w) * bhi(kv.w); }
                s[jj] = d * 0.125f - slope * (float)j;
            } else s[jj] = -1e30f;
        }
        const float mx = fmaxf(wave_max(fmaxf(s[0], s[1])), sink);
        const float p0 = __expf(s[0] - mx), p1 = __expf(s[1] - mx);
        const float denom = wave_sum(p0 + p1) + __expf(sink - mx);
        float acc = 0.f;
        const int jmax = t < (WINDOW - 1) ? t : (WINDOW - 1);
        const bf16* vp = main_ + (size_t)row * N_MAIN + C_AV + hk * 64 + lane;
        for (int j = 0; j <= jmax; ++j) {
            const float pj = __shfl(j < 64 ? p0 : p1, j & 63);
            acc += pj * bf2f(vp[-(ptrdiff_t)j * N_MAIN]);
        }
        FA[(size_t)row * 1024 + h * 64 + lane] = (bf16)f2bf(acc / denom);
    }
}


typedef float f32x16 __attribute__((ext_vector_type(16)));
typedef short s16x8 __attribute__((ext_vector_type(8)));
typedef short s16x4 __attribute__((ext_vector_type(4)));
typedef unsigned u32x2 __attribute__((ext_vector_type(2)));
constexpr int AT_KP = 144, AT_VP = 520, AT_VOFF = 256 * AT_KP;
__device__ __forceinline__ void phase_attn_mfma(Frame& F, int l) {
    PHASE_TID();
    const bf16* main_ = (const bf16*)(F.ws + WS_BIG); bf16* FA = (bf16*)(F.ws + WS_FA);
    LAS unsigned char* KL = F.lds; LAS unsigned char* VL = F.lds + AT_VOFF;
    const int r32 = lane & 31, hi = lane >> 5;
    constexpr float L2E = 1.4426950408889634f, NEG = -1e30f;
    for (int unit = F.bid; unit < BATCH * (SEQ / 128) * NKV; unit += F.G) {
        const int hk = unit & 1, n = (unit >> 1) & 127, b = unit >> 8;
        const size_t row0 = (size_t)b * SEQ + (size_t)n * 128;
#pragma unroll
        for (int i = 0; i < 4; ++i) { const int idx = tid + NTHR * i, key = idx & 255, dg = idx >> 8;
            v4u kv = (v4u){0u, 0u, 0u, 0u}, vv = (v4u){0u, 0u, 0u, 0u};
            if (n > 0 || key >= 128) { const bf16* rp = main_ + (row0 - 128 + key) * N_MAIN + hk * 64 + dg * 8; kv = *(const v4u*)(rp + C_AK); vv = *(const v4u*)(rp + C_AV); }
            *(LAS v4u*)(KL + key * AT_KP + dg * 16) = kv;
            LAS unsigned short* vp = (LAS unsigned short*)(VL + (dg * 8) * AT_VP + key * 2);
            vp[0 * (AT_VP / 2)] = (unsigned short)(vv.x & 0xffffu); vp[1 * (AT_VP / 2)] = (unsigned short)(vv.x >> 16);
            vp[2 * (AT_VP / 2)] = (unsigned short)(vv.y & 0xffffu); vp[3 * (AT_VP / 2)] = (unsigned short)(vv.y >> 16);
            vp[4 * (AT_VP / 2)] = (unsigned short)(vv.z & 0xffffu); vp[5 * (AT_VP / 2)] = (unsigned short)(vv.z >> 16);
            vp[6 * (AT_VP / 2)] = (unsigned short)(vv.w & 0xffffu); vp[7 * (AT_VP / 2)] = (unsigned short)(vv.w >> 16); }
        __syncthreads();
        const int h = hk * 8 + wave;
        const float slope2 = exp2f(-0.5f * (float)(h + 1)) * L2E, sink2 = F.in[9][l * NHEAD + h] * L2E;
        const float nsb2 = -slope2 * (float)(r32 + 128 - 4 * hi);
        for (int c = 0; c < 4; ++c) {
            const size_t qrow = row0 + 32 * c + r32;
            s16x8 qf[4];
#pragma unroll
            for (int ks = 0; ks < 4; ++ks) qf[ks] = *(const s16x8*)(main_ + qrow * N_MAIN + C_AQ + h * 64 + 16 * ks + 8 * hi);
            f32x16 S[5];
            float mx = NEG;
#pragma unroll
            for (int d = 0; d < 5; ++d) {
                const int kt = c + d;
                if (n == 0 && kt < 4) {
#pragma unroll
                    for (int r = 0; r < 16; ++r) S[d][r] = NEG;
                } else {
                    f32x16 acc;
#pragma unroll
                    for (int r = 0; r < 16; ++r) acc[r] = 0.f;
#pragma unroll
                    for (int ks = 0; ks < 4; ++ks) { const s16x8 a = *(const LAS s16x8*)(KL + (32 * kt + r32) * AT_KP + (16 * ks + 8 * hi) * 2);
                        acc = __builtin_amdgcn_mfma_f32_32x32x16_bf16(a, qf[ks], acc, 0, 0, 0); }
#pragma unroll
                    for (int r = 0; r < 16; ++r) { const int cr = (r & 3) + 8 * (r >> 2);
                        float s = fmaf(slope2, (float)(32 * d + cr), fmaf(acc[r], 0.125f * L2E, nsb2));
                        if (d == 0) { if (!(r32 - 4 * hi - cr < 0)) s = NEG; }
                        if (d == 4) { if (!(r32 - 4 * hi - cr >= 0)) s = NEG; }
                        S[d][r] = s; mx = fmaxf(mx, s); }
                }
            }
            mx = fmaxf(mx, __shfl_xor(mx, 32));
            mx = fmaxf(mx, sink2);
            float sum = 0.f;
            f32x16 O0, O1;
#pragma unroll
            for (int r = 0; r < 16; ++r) { O0[r] = 0.f; O1[r] = 0.f; }
#pragma unroll
            for (int d = 0; d < 5; ++d) {
                const int kt = c + d;
                if (n == 0 && kt < 4) continue;
#pragma unroll
                for (int r = 0; r < 16; ++r) { const float p = __builtin_amdgcn_exp2f(S[d][r] - mx); S[d][r] = p; sum += p; }
#pragma unroll
                for (int s = 0; s < 2; ++s) {
                    v4u pw; pw.x = pg8::cvt_pk_bf16(S[d][8 * s + 0], S[d][8 * s + 1]); pw.y = pg8::cvt_pk_bf16(S[d][8 * s + 2], S[d][8 * s + 3]);
                    pw.z = pg8::cvt_pk_bf16(S[d][8 * s + 4], S[d][8 * s + 5]); pw.w = pg8::cvt_pk_bf16(S[d][8 * s + 6], S[d][8 * s + 7]);
                    const s16x8 pf = __builtin_bit_cast(s16x8, pw);
                    const int kb = (32 * kt + 16 * s + 4 * hi) * 2;
                    { const s16x4 lo = *(const LAS s16x4*)(VL + r32 * AT_VP + kb), hh = *(const LAS s16x4*)(VL + r32 * AT_VP + kb + 16);
                      const s16x8 a = __builtin_shufflevector(lo, hh, 0, 1, 2, 3, 4, 5, 6, 7); O0 = __builtin_amdgcn_mfma_f32_32x32x16_bf16(a, pf, O0, 0, 0, 0); }
                    { const s16x4 lo = *(const LAS s16x4*)(VL + (32 + r32) * AT_VP + kb), hh = *(const LAS s16x4*)(VL + (32 + r32) * AT_VP + kb + 16);
                      const s16x8 a = __builtin_shufflevector(lo, hh, 0, 1, 2, 3, 4, 5, 6, 7); O1 = __builtin_amdgcn_mfma_f32_32x32x16_bf16(a, pf, O1, 0, 0, 0); }
                }
            }
            sum += __shfl_xor(sum, 32);
            const float inv = 1.0f / (sum + __builtin_amdgcn_exp2f(sink2 - mx));
            bf16* op = FA + qrow * 1024 + h * 64 + 4 * hi;
#pragma unroll
            for (int rg = 0; rg < 4; ++rg) {
                u32x2 w0; w0.x = pg8::cvt_pk_bf16(O0[4 * rg] * inv, O0[4 * rg + 1] * inv); w0.y = pg8::cvt_pk_bf16(O0[4 * rg + 2] * inv, O0[4 * rg + 3] * inv);
                u32x2 w1; w1.x = pg8::cvt_pk_bf16(O1[4 * rg] * inv, O1[4 * rg + 1] * inv); w1.y = pg8::cvt_pk_bf16(O1[4 * rg + 2] * inv, O1[4 * rg + 3] * inv);
                *(u32x2*)(op + 8 * rg) = w0; *(u32x2*)(op + 32 + 8 * rg) = w1; }
        }
        __syncthreads();
    }
}

__device__ __forceinline__ float hgrn_lb(const float* logits, int l, int ch) {
    float mx = -1e30f;
#pragma unroll
    for (int i = 0; i < DEPTH; ++i) mx = fmaxf(mx, logits[i * (HG_H * HG_DK) + ch]);
    float den = 0.f, num = 0.f;
#pragma unroll
    for (int i = 0; i < DEPTH; ++i) { const float e = __expf(logits[i * (HG_H * HG_DK) + ch] - mx); den += e; if (i < l) num += e; }
    return num / den;
}
template <bool WITH_Q>
__device__ __forceinline__ void hgrn_front(Frame& F, int l, int unit, int tid) {
    LAS float* L = (LAS float*)F.lds;
    LAS float* A_ = L; LAS float* KC = L + 8192; LAS float* Q = L + 16384; LAS float* V = L + 24576; LAS float* QT = L + 32768;
    const bf16* main_ = (const bf16*)(F.ws + WS_BIG);
    const int c = unit & (HG_NC - 1), bh = unit >> 8, h = bh & 7, b = bh >> 3;
    const size_t row0 = (size_t)b * SEQ + (size_t)c * HG_C;
    const int k = tid & 127, tq = tid >> 7;
    const float lb = hgrn_lb(F.in[10], l, h * HG_DK + k), lbe = fmaxf(lb, 1e-20f);
    float run = 0.f;
#pragma unroll 4
    for (int tt = 0; tt < 16; ++tt) { const int t = tq * 16 + tt;
        const bf16* rp = main_ + (row0 + t) * N_MAIN;
        const float z = bf2f(rp[C_RF + h * HG_DK + k]);
        const float sg = sigm(z);
        const float f = lbe + (1.0f - lbe) * sg;
        run += __logf(f);
        A_[t * 128 + k] = run; KC[t * 128 + k] = (1.0f - lb) * (1.0f - sg);
        if (WITH_Q) { const float qv = bf2f(rp[C_RQ + h * HG_DK + k]); Q[t * 128 + k] = qv * sigm(qv); }
    }
    QT[tq * 128 + k] = run;
    { const int t = tid >> 3, v8 = (tid & 7) * 8;
      const v4u w = *(const v4u*)(main_ + (row0 + t) * N_MAIN + C_RI + h * HG_DV + v8);
      LAS float* vp = V + t * 64 + v8;
      vp[0] = blo(w.x); vp[1] = bhi(w.x); vp[2] = blo(w.y); vp[3] = bhi(w.y); vp[4] = blo(w.z); vp[5] = bhi(w.z); vp[6] = blo(w.w); vp[7] = bhi(w.w); }
    __syncthreads();
    float off = 0.f;
    for (int q = 0; q < tq; ++q) off += QT[q * 128 + k];
#pragma unroll 4
    for (int tt = 0; tt < 16; ++tt) A_[(tq * 16 + tt) * 128 + k] += off;
    __syncthreads();
}
__device__ __forceinline__ void phase_hgrn_a(Frame& F, int l) {
    PHASE_TID();
    LAS float* L = (LAS float*)F.lds;
    LAS float* A_ = L; LAS float* KC = L + 8192; LAS float* V = L + 24576;
    float* UT = (float*)(F.ws + WS_UT); float* DD = (float*)(F.ws + WS_DD);
    const int k = tid & 127, tq = tid >> 7;
    for (int unit = F.bid; unit < BATCH * HG_H * HG_NC; unit += F.G) {
        hgrn_front<false>(F, l, unit, tid);
        const float alast = A_[63 * 128 + k];
#pragma unroll 4
        for (int tt = 0; tt < 16; ++tt) { const int t = tq * 16 + tt; KC[t * 128 + k] *= __expf(alast - A_[t * 128 + k]); }
        __syncthreads();
        float acc[16];
#pragma unroll
        for (int j = 0; j < 16; ++j) acc[j] = 0.f;
        for (int s = 0; s < 64; ++s) { const float kd = KC[s * 128 + k];
#pragma unroll
            for (int j = 0; j < 16; ++j) acc[j] += kd * V[s * 64 + tq * 16 + j]; }
#pragma unroll
        for (int j = 0; j < 16; ++j) UT[(size_t)unit * 8192 + (tq * 16 + j) * 128 + k] = acc[j];
        if (tq == 0) DD[(size_t)unit * 128 + k] = __expf(alast);
        __syncthreads();
    }
}
__device__ __forceinline__ void phase_hgrn_scan(Frame& F) {
    PHASE_TID();
    float* UT = (float*)(F.ws + WS_UT); const float* DD = (const float*)(F.ws + WS_DD);
    for (int e = F.bid * NTHR + tid; e < BATCH * HG_H * 8192; e += F.G * NTHR) {
        const int bh = e >> 13, vk = e & 8191, k = vk & 127;
        float s = 0.f;
        float* up = UT + (size_t)bh * HG_NC * 8192 + vk; const float* dp = DD + (size_t)bh * HG_NC * 128 + k;
        for (int c = 0; c < HG_NC; c += 8) {
            float u[8], d[8];
#pragma unroll
            for (int i = 0; i < 8; ++i) { u[i] = up[(size_t)(c + i) * 8192]; d[i] = dp[(size_t)(c + i) * 128]; }
#pragma unroll
            for (int i = 0; i < 8; ++i) { up[(size_t)(c + i) * 8192] = s; s = d[i] * s + u[i]; }
        }
    }
}
__device__ __forceinline__ void phase_hgrn_c(Frame& F, int l) {
    PHASE_TID();
    LAS float* L = (LAS float*)F.lds;
    LAS float* A_ = L; LAS float* KC = L + 8192; LAS float* Q = L + 16384; LAS float* V = L + 24576; LAS float* ATT = L + 28672;
    const float* UT = (const float*)(F.ws + WS_UT);
    const bf16* main_ = (const bf16*)(F.ws + WS_BIG); bf16* FH = (bf16*)(F.ws + WS_FH);
    const float* nw = F.in[11] + (size_t)l * HG_DV;
    const int k = tid & 127, tq = tid >> 7, w = wave;
    for (int unit = F.bid; unit < BATCH * HG_H * HG_NC; unit += F.G) {
        hgrn_front<true>(F, l, unit, tid);
        const int c = unit & (HG_NC - 1), bh = unit >> 8, h = bh & 7, b = bh >> 3;
        const size_t row0 = (size_t)b * SEQ + (size_t)c * HG_C;
        for (int p = w; p < 4096; p += NWAVES) { const int t = p >> 6, s = p & 63;
            if (s <= t) {
                float v = Q[t * 128 + lane] * __expf(A_[t * 128 + lane] - A_[s * 128 + lane]) * KC[s * 128 + lane]
                        + Q[t * 128 + 64 + lane] * __expf(A_[t * 128 + 64 + lane] - A_[s * 128 + 64 + lane]) * KC[s * 128 + 64 + lane];
                v = wave_sum(v);
                if (lane == 0) ATT[t * 64 + s] = v;
            }
        }
        __syncthreads();
#pragma unroll 4
        for (int tt = 0; tt < 16; ++tt) { const int t = tq * 16 + tt; Q[t * 128 + k] *= __expf(A_[t * 128 + k]); }
        __syncthreads();
        float acc[8];
#pragma unroll
        for (int i = 0; i < 8; ++i) acc[i] = 0.f;
        for (int s = 0; s < 8 * w + 8; ++s) { const float vv = V[s * 64 + lane];
#pragma unroll
            for (int i = 0; i < 8; ++i) { const int t = 8 * w + i; if (s <= t) acc[i] += ATT[t * 64 + s] * vv; } }
        const float* st = UT + (size_t)unit * 8192 + lane * 128;
        for (int k4 = 0; k4 < 128; k4 += 4) { const f32x4 sv = *(const f32x4*)(st + k4);
#pragma unroll
            for (int i = 0; i < 8; ++i) { const LAS float* qp = Q + (8 * w + i) * 128 + k4; acc[i] += qp[0] * sv.x + qp[1] * sv.y + qp[2] * sv.z + qp[3] * sv.w; } }
        const float nwv = nw[lane];
#pragma unroll
        for (int i = 0; i < 8; ++i) { const int t = 8 * w + i;
            const float ss = wave_sum(acc[i] * acc[i]);
            const float o = acc[i] * (1.0f / sqrtf(ss * (1.0f / HG_DV) + NORM_EPS)) * nwv;
            const float gv = bf2f(main_[(row0 + t) * N_MAIN + C_RG + h * HG_DV + lane]);
            FH[(row0 + t) * 512 + h * HG_DV + lane] = (bf16)f2bf(o * gv * sigm(gv)); }
        __syncthreads();
    }
}


#if MK_CHECK
constexpr int CW_CHK = 64;
__device__ __forceinline__ float bfr(float f) { return __uint_as_float(f2bf(f) << 16); }
__device__ __forceinline__ float dot_ar_wc(const bf16* arow, const float* W, int K, int N, int c) {
    float s = 0.f;
#pragma unroll 8
    for (int k = 0; k < K; ++k) s += bf2f(arow[k]) * bfr(W[(size_t)k * N + c]);
    return s;
}
__device__ __forceinline__ bool chk_bad(float got, float ref) { return !(fabsf(got - ref) <= 0.04f + 0.03f * fabsf(ref)); }
__device__ __forceinline__ void chk_report(Frame& F, int ph, bool fail) { if (fail) atomicMax((unsigned*)(F.ws + WS_CTL) + CW_CHK, (unsigned)(NPHASES - ph)); }
__device__ __forceinline__ void chk_rc(int tid, int ph, int N, int& r, int& c) {
    unsigned h1 = ((unsigned)tid + 1u) * 2654435761u + (unsigned)ph * 40503u; h1 ^= h1 >> 15; h1 *= 0x85ebca6bu; h1 ^= h1 >> 13;
    unsigned h2 = ((unsigned)tid + 77u) * 0x9E3779B1u + (unsigned)ph * 7919u; h2 ^= h2 >> 16; h2 *= 0xc2b2ae35u; h2 ^= h2 >> 13;
    r = (int)(h1 % (unsigned)M); c = (int)(h2 % (unsigned)N);
    if (tid == 0) r = 0; if (tid == 1) r = M - 1; if (tid == 2) r = SEQ - 1; if (tid == 3) r = SEQ; if (tid == 4) r = M - 300; if (tid == 5) r = 31500;
}
__device__ __forceinline__ float chk_rstd_bf(const bf16* row) { float ss = 0.f; for (int k = 0; k < D_MODEL; ++k) { const float v = bf2f(row[k]); ss += v * v; } return 1.0f / sqrtf(ss * (1.0f / D_MODEL) + NORM_EPS); }
__device__ __forceinline__ float chk_rstd_f(const float* row) { float ss = 0.f; for (int k = 0; k < D_MODEL; ++k) { const float v = row[k]; ss += v * v; } return 1.0f / sqrtf(ss * (1.0f / D_MODEL) + NORM_EPS); }
__device__ __forceinline__ void chk_xn(Frame& F, int ph, const float* x, const float* w) {
    PHASE_TID(); int r, c; chk_rc(tid, ph, D_MODEL, r, c);
    const float ref = x[(size_t)r * D_MODEL + c] * chk_rstd_f(x + (size_t)r * D_MODEL) * w[c];
    chk_report(F, ph, chk_bad(bf2f(((const bf16*)(F.ws + WS_XN))[(size_t)r * D_MODEL + c]), ref));
}
__device__ __forceinline__ void chk_gu(Frame& F, int ph, const float* Wgu) {
    PHASE_TID(); int r, j; chk_rc(tid, ph, D_FF, r, j);
    const bf16* a = (const bf16*)(F.ws + WS_XN) + (size_t)r * D_MODEL;
    const float g = dot_ar_wc(a, Wgu, D_MODEL, 2 * D_FF, j), u = dot_ar_wc(a, Wgu, D_MODEL, 2 * D_FF, D_FF + j);
    chk_report(F, ph, chk_bad(bf2f(((const bf16*)(F.ws + WS_BIG))[(size_t)r * D_FF + j]), g * sigm(g) * u));
}
__device__ __forceinline__ void chk_plain(Frame& F, int ph, const bf16* A, int K, const float* W, int NW, int coff, const bf16* OUT, int N, int act) {
    PHASE_TID(); int r, c; chk_rc(tid, ph, N, r, c);
    float ref = dot_ar_wc(A + (size_t)r * K, W, K, NW, coff + c); if (act == 2) ref = sigm(ref);
    chk_report(F, ph, chk_bad(bf2f(OUT[(size_t)r * N + c]), ref));
}
__device__ __forceinline__ void chk_norm(Frame& F, int ph, const float* xin, float alpha, const float* wpost, const float* wpre) {
    PHASE_TID(); int r, c; chk_rc(tid, ph, D_MODEL, r, c);
    const float* xo = F.out + (size_t)r * D_MODEL; bool fail = false;
    { const bf16* y = (const bf16*)(F.ws + WS_Y) + (size_t)r * D_MODEL;
        const float xi = xin ? xin[(size_t)r * D_MODEL + c] : ((const float*)(F.ws + WS_END))[tid];
        const float ref = xi + alpha * bf2f(y[c]) * chk_rstd_bf(y) * wpost[c]; fail = !(fabsf(xo[c] - ref) <= 0.01f + 0.01f * fabsf(ref)); }
    if (wpre) { const float ref = xo[c] * chk_rstd_f(xo) * wpre[c]; fail = fail || chk_bad(bf2f(((const bf16*)(F.ws + WS_XN))[(size_t)r * D_MODEL + c]), ref); }
    chk_report(F, ph, fail);
}
__device__ __forceinline__ void chk_save(Frame& F, int ph) {
    PHASE_TID(); int r, c; chk_rc(tid, ph, D_MODEL, r, c);
    ((float*)(F.ws + WS_END))[tid] = F.out[(size_t)r * D_MODEL + c];
}
__device__ __forceinline__ void chk_conv(Frame& F, int ph, int l) {
    PHASE_TID(); int r, c; chk_rc(tid, ph, CONV_WIDTH, r, c);
    const bf16* mn = (const bf16*)(F.ws + WS_BIG); const float* cw = F.in[8] + (size_t)l * 3 * CONV_WIDTH; const int t = r & (SEQ - 1);
    float y = 0.f;
    for (int j = 0; j < 3; ++j) if (t - j >= 0) { const bf16* rp = mn + (size_t)(r - j) * N_MAIN; y += cw[(2 - j) * CONV_WIDTH + c] * bf2f(rp[C_CC + c]) * bf2f(rp[C_CX + c]); }
    const float ref = bf2f(mn[(size_t)r * N_MAIN + C_CB + c]) * y;
    chk_report(F, ph, chk_bad(bf2f(((const bf16*)(F.ws + WS_FC))[(size_t)r * CONV_WIDTH + c]), ref));
}
__device__ __forceinline__ void chk_attn(Frame& F, int ph, int l) {
    PHASE_TID(); int r, c; chk_rc(tid, ph, 1024, r, c);
    const bf16* mn = (const bf16*)(F.ws + WS_BIG); const int h = c >> 6, d = c & 63, hk = h >> 3, t = r & (SEQ - 1);
    const float slope = exp2f(-0.5f * (float)(h + 1)), sink = F.in[9][l * NHEAD + h];
    const bf16* qp = mn + (size_t)r * N_MAIN + C_AQ + h * 64; const int jmax = t < 127 ? t : 127;
    float mx = sink;
    for (int j = 0; j <= jmax; ++j) { const bf16* kp = mn + (size_t)(r - j) * N_MAIN + C_AK + hk * 64; float s = 0.f; for (int e = 0; e < 64; ++e) s += bf2f(qp[e]) * bf2f(kp[e]); s = s * 0.125f - slope * (float)j; mx = fmaxf(mx, s); }
    float den = expf(sink - mx), acc = 0.f;
    for (int j = 0; j <= jmax; ++j) { const bf16* kp = mn + (size_t)(r - j) * N_MAIN + C_AK + hk * 64; float s = 0.f; for (int e = 0; e < 64; ++e) s += bf2f(qp[e]) * bf2f(kp[e]); s = s * 0.125f - slope * (float)j;
        const float p = expf(s - mx); den += p; acc += p * bf2f(mn[(size_t)(r - j) * N_MAIN + C_AV + hk * 64 + d]); }
    chk_report(F, ph, chk_bad(bf2f(((const bf16*)(F.ws + WS_FA))[(size_t)r * 1024 + c]), acc / den));
}
__device__ __forceinline__ void chk_hgrn(Frame& F, int ph, int l, int b, int h, int c0) {
    PHASE_TID();
    LAS float* L = (LAS float*)F.lds; LAS float* S = L; LAS float* PO = L + 8192;
    const bf16* mn = (const bf16*)(F.ws + WS_BIG); const bf16* FH = (const bf16*)(F.ws + WS_FH);
    const int v = tid & 63, kg = tid >> 6;
    for (int kk = 0; kk < 16; ++kk) { const int k = kg * 16 + kk; S[k * 64 + v] = c0 ? ((const float*)(F.ws + WS_UT))[(size_t)(((b * HG_H + h) << 8) + c0) * 8192 + v * 128 + k] : 0.f; }
    __syncthreads();
    bool fail = false;
    for (int t = 0; t < 200; ++t) {
        const size_t row = (size_t)b * SEQ + (size_t)c0 * HG_C + t; const bf16* rp = mn + row * N_MAIN;
        const float iv = bf2f(rp[C_RI + h * 64 + v]); float po = 0.f;
        for (int kk = 0; kk < 16; ++kk) { const int k = kg * 16 + kk;
            const float lb = hgrn_lb(F.in[10], l, h * HG_DK + k), lbe = fmaxf(lb, 1e-20f);
            const float z = bf2f(rp[C_RF + h * HG_DK + k]), sg = 1.0f / (1.0f + expf(-z));
            const float f = lbe + (1.0f - lbe) * sg, kc = (1.0f - lb) * (1.0f - sg);
            const float qr = bf2f(rp[C_RQ + h * HG_DK + k]), qv = qr / (1.0f + expf(-qr));
            const float s = f * S[k * 64 + v] + kc * iv; S[k * 64 + v] = s; po += s * qv; }
        PO[kg * 64 + v] = po;
        __syncthreads();
        if (tid < 64) { float o = 0.f; for (int q = 0; q < 8; ++q) o += PO[q * 64 + tid];
            const float ss = wave_sum(o * o); const float gv = bf2f(rp[C_RG + h * 64 + tid]);
            const float ref = o * (1.0f / sqrtf(ss * (1.0f / 64.0f) + NORM_EPS)) * F.in[11][l * HG_DV + tid] * gv / (1.0f + expf(-gv));
            fail = fail || chk_bad(bf2f(FH[row * 512 + h * 64 + tid]), ref); }
        __syncthreads();
    }
    chk_report(F, ph, fail);
}
__device__ __forceinline__ void chk_merge(Frame& F, int ph, int l) {
    PHASE_TID(); int r, c; chk_rc(tid, ph, D_MODEL, r, c);
    const bf16* G = (const bf16*)(F.ws + WS_BIG) + (size_t)r * N_GATES;
    const float y0 = dot_ar_wc((const bf16*)(F.ws + WS_FC) + (size_t)r * 512, F.in[12] + (size_t)l * 512 * D_MODEL, 512, D_MODEL, c);
    const float y1 = dot_ar_wc((const bf16*)(F.ws + WS_FA) + (size_t)r * 1024, F.in[13] + (size_t)l * 1024 * D_MODEL, 1024, D_MODEL, c);
    const float y2 = dot_ar_wc((const bf16*)(F.ws + WS_FH) + (size_t)r * 512, F.in[14] + (size_t)l * 512 * D_MODEL, 512, D_MODEL, c);
    const float ref = bf2f(G[c]) * y0 + bf2f(G[D_MODEL + c]) * y1 + bf2f(G[2 * D_MODEL + c]) * y2;
    chk_report(F, ph, chk_bad(bf2f(((const bf16*)(F.ws + WS_XN))[(size_t)r * D_MODEL + c]), ref));
}
__device__ __forceinline__ void chk_ple(Frame& F, int ph, int l) {
    PHASE_TID(); int r, c; chk_rc(tid, ph, D_MODEL, r, c);
    const float y = dot_ar_wc((const bf16*)(F.ws + WS_PB) + (size_t)r * PLE_DIM, F.in[23] + (size_t)l * PLE_DIM * D_MODEL, PLE_DIM, D_MODEL, c);
    const float ref = bf2f(((const bf16*)(F.ws + WS_BIG))[(size_t)r * D_MODEL + c]) * y;
    chk_report(F, ph, chk_bad(bf2f(((const bf16*)(F.ws + WS_Y))[(size_t)r * D_MODEL + c]), ref));
}
#endif

__global__ void __launch_bounds__(NTHR, 2) fwd(Args args) {
    extern __shared__ __attribute__((aligned(16))) unsigned char lds[];
    Frame F;
    F.lds = (LAS unsigned char*)lds;
    F.G = gridDim.x; F.bid = blockIdx.x; F.in = args.in; F.out = args.out; F.ws = args.ws;
    unsigned char* ws = args.ws;
    volatile LAS unsigned* MISC = (volatile LAS unsigned*)(F.lds + MISC_OFF);
    if (threadIdx.x < 32) MISC[threadIdx.x] = 0u;
    __syncthreads();
#if MK_ONE_LAUNCH
    XcdBarrier bar = xcd_barrier_post((unsigned*)(ws + WS_CTL) + CW_BAR, MISC + 8);
#define GRID_BAR() xcd_barrier(bar)
#else
#define GRID_BAR() do {} while (0)
#endif
    const int lo = args.ph_lo, hi = args.ph_hi;
#define IN(k) (lo <= (k) && (k) < hi)
#if MK_CHECK
#define SEAM(k) do { if (IN(k)) GRID_BAR(); } while (0)
#define CHK(k, stmt) do { if (IN(k)) { if (F.bid == 0) { stmt; } GRID_BAR(); } } while (0)
#define CHKSAVE(k) do { if (F.bid == 0) chk_save(F, (k)); GRID_BAR(); } while (0)
#else
#define CHKSAVE(k) do {} while (0)
#define SEAM(k) do { if (IN(k) && IN((k) + 1)) GRID_BAR(); } while (0)
#define CHK(k, stmt) do {} while (0)
#endif
    bf16* XN = (bf16*)(ws + WS_XN); bf16* Y = (bf16*)(ws + WS_Y); bf16* BIG = (bf16*)(ws + WS_BIG);
    using pg8::Gemm; using pg8::StaticOrder;

    for (int l = 0; l < DEPTH; ++l) {
        const int P = l * NPH;
        const float* in_x = (l == 0) ? F.in[0] : F.out;
        if (IN(P + 0)) { phase_convert(F, l); } SEAM(P + 0); CHK(P + 0, if (l == 0) chk_xn(F, P + 0, F.in[0], F.in[2]));
        if (IN(P + 1)) { Gemm g{XN, (const bf16*)(ws + WS_GU1), M, 2 * D_FF, D_MODEL}; StaticOrder S; S.init(M, 2 * D_FF, F.G, F.bid);
            pg8::EpiSwiglu E{BIG, D_FF}; pg8::gemm_phase<pg8::EpiSwiglu, StaticOrder, PG8_ALIGN, PG8_SP2>(F.lds, g, S, E); } SEAM(P + 1); CHK(P + 1, chk_gu(F, P + 1, F.in[3] + (size_t)l * D_MODEL * 2 * D_FF));
        if (IN(P + 2)) { Gemm g{BIG, (const bf16*)(ws + WS_D1), M, D_MODEL, D_FF}; StaticOrder S; S.init(M, D_MODEL, F.G, F.bid);
            pg8::EpiBf16<0> E{Y, D_MODEL}; pg8::gemm_phase<pg8::EpiBf16<0>, StaticOrder, PG8_ALIGN, PG8_SP2>(F.lds, g, S, E); } SEAM(P + 2); CHK(P + 2, chk_plain(F, P + 2, BIG, D_FF, F.in[4] + (size_t)l * D_FF * D_MODEL, D_MODEL, 0, Y, D_MODEL, 0));
        if (IN(P + 3)) { if (l > 0) { CHKSAVE(P + 3); } phase_norm(F, in_x, 0.5f, F.in[5] + l * D_MODEL, F.in[6] + l * D_MODEL, P + 3); } SEAM(P + 3); CHK(P + 3, chk_norm(F, P + 3, (l == 0) ? F.in[0] : nullptr, 0.5f, F.in[5] + l * D_MODEL, F.in[6] + l * D_MODEL));
        if (IN(P + 4)) { Gemm g{XN, (const bf16*)(ws + WS_WIN), M, N_MAIN, D_MODEL}; StaticOrder S; S.init(M, N_MAIN, F.G, F.bid);
            pg8::EpiBf16<0> E{BIG, N_MAIN}; pg8::gemm_phase<pg8::EpiBf16<0>, StaticOrder, PG8_ALIGN, PG8_SP2>(F.lds, g, S, E); } SEAM(P + 4); CHK(P + 4, chk_plain(F, P + 4, XN, D_MODEL, F.in[7] + (size_t)l * D_MODEL * D_IN, D_IN, 0, BIG, N_MAIN, 0));
        if (IN(P + 5)) { phase_conv(F, l); phase_attn_mfma(F, l); phase_hgrn_a(F, l); } SEAM(P + 5); CHK(P + 5, chk_conv(F, P + 5, l); chk_attn(F, P + 5, l));
        if (IN(P + 6)) { phase_hgrn_scan(F); } SEAM(P + 6);
        if (IN(P + 7)) { phase_hgrn_c(F, l); } SEAM(P + 7); CHK(P + 7, chk_hgrn(F, P + 7, l, 1, 5, 0); chk_hgrn(F, P + 7, l, 0, 2, 100); chk_hgrn(F, P + 7, l, 1, 7, 252));
        if (IN(P + 8)) { Gemm g{XN, (const bf16*)(ws + WS_WIN) + (size_t)N_MAIN * D_MODEL, M, N_GATES, D_MODEL}; StaticOrder S; S.init(M, N_GATES, F.G, F.bid);
            pg8::EpiBf16<2> E{BIG, N_GATES}; pg8::gemm_phase<pg8::EpiBf16<2>, StaticOrder, PG8_ALIGN, PG8_SP2>(F.lds, g, S, E); } SEAM(P + 8); CHK(P + 8, chk_plain(F, P + 8, XN, D_MODEL, F.in[7] + (size_t)l * D_MODEL * D_IN, D_IN, N_MAIN, BIG, N_GATES, 2));
        if (IN(P + 9)) {
            StaticOrder S; S.init(M, D_MODEL, F.G, F.bid);
            { Gemm g{(const bf16*)(ws + WS_FC), (const bf16*)(ws + WS_BC), M, D_MODEL, CONV_WIDTH};
              pg8::EpiGateMul E{BIG, N_GATES, XN, D_MODEL, 0}; pg8::gemm_phase<pg8::EpiGateMul, StaticOrder, PG8_ALIGN, PG8_SP2>(F.lds, g, S, E); }
            { Gemm g{(const bf16*)(ws + WS_FA), (const bf16*)(ws + WS_BA), M, D_MODEL, 1024};
              pg8::EpiGateMul E{BIG + D_MODEL, N_GATES, XN, D_MODEL, 1}; pg8::gemm_phase<pg8::EpiGateMul, StaticOrder, PG8_ALIGN, PG8_SP2>(F.lds, g, S, E); }
            { Gemm g{(const bf16*)(ws + WS_FH), (const bf16*)(ws + WS_BH), M, D_MODEL, 512};
              pg8::EpiGateMul E{BIG + 2 * D_MODEL, N_GATES, XN, D_MODEL, 1}; pg8::gemm_phase<pg8::EpiGateMul, StaticOrder, PG8_ALIGN, PG8_SP2>(F.lds, g, S, E); }
        } SEAM(P + 9); CHK(P + 9, chk_merge(F, P + 9, l));
        if (IN(P + 10)) { Gemm g{XN, (const bf16*)(ws + WS_WO), M, D_MODEL, D_MODEL}; StaticOrder S; S.init(M, D_MODEL, F.G, F.bid);
            pg8::EpiBf16<0> E{Y, D_MODEL}; pg8::gemm_phase<pg8::EpiBf16<0>, StaticOrder, PG8_ALIGN, PG8_SP2>(F.lds, g, S, E); } SEAM(P + 10); CHK(P + 10, chk_plain(F, P + 10, XN, D_MODEL, F.in[15] + (size_t)l * D_MODEL * D_MODEL, D_MODEL, 0, Y, D_MODEL, 0));
        if (IN(P + 11)) { CHKSAVE(P + 11); phase_norm(F, F.out, 1.0f, F.in[16] + l * D_MODEL, F.in[17] + l * D_MODEL, P + 11); } SEAM(P + 11); CHK(P + 11, chk_norm(F, P + 11, nullptr, 1.0f, F.in[16] + l * D_MODEL, F.in[17] + l * D_MODEL));
        if (IN(P + 12)) { Gemm g{XN, (const bf16*)(ws + WS_GU2), M, 2 * D_FF, D_MODEL}; StaticOrder S; S.init(M, 2 * D_FF, F.G, F.bid);
            pg8::EpiSwiglu E{BIG, D_FF}; pg8::gemm_phase<pg8::EpiSwiglu, StaticOrder, PG8_ALIGN, PG8_SP2>(F.lds, g, S, E); } SEAM(P + 12); CHK(P + 12, chk_gu(F, P + 12, F.in[18] + (size_t)l * D_MODEL * 2 * D_FF));
        if (IN(P + 13)) { Gemm g{BIG, (const bf16*)(ws + WS_D2), M, D_MODEL, D_FF}; StaticOrder S; S.init(M, D_MODEL, F.G, F.bid);
            pg8::EpiBf16<0> E{Y, D_MODEL}; pg8::gemm_phase<pg8::EpiBf16<0>, StaticOrder, PG8_ALIGN, PG8_SP2>(F.lds, g, S, E); } SEAM(P + 13); CHK(P + 13, chk_plain(F, P + 13, BIG, D_FF, F.in[19] + (size_t)l * D_FF * D_MODEL, D_MODEL, 0, Y, D_MODEL, 0));
        if (IN(P + 14)) { CHKSAVE(P + 14); phase_norm(F, F.out, 0.5f, F.in[20] + l * D_MODEL, F.in[21] + l * D_MODEL, P + 14); } SEAM(P + 14); CHK(P + 14, chk_norm(F, P + 14, nullptr, 0.5f, F.in[20] + l * D_MODEL, F.in[21] + l * D_MODEL));
        if (IN(P + 15)) { Gemm g{XN, (const bf16*)(ws + WS_PG), M, D_MODEL, D_MODEL}; StaticOrder S; S.init(M, D_MODEL, F.G, F.bid);
            pg8::EpiBf16<2> E{BIG, D_MODEL}; pg8::gemm_phase<pg8::EpiBf16<2>, StaticOrder, PG8_ALIGN, PG8_SP2>(F.lds, g, S, E); } SEAM(P + 15); CHK(P + 15, chk_plain(F, P + 15, XN, D_MODEL, F.in[22] + (size_t)l * D_MODEL * D_MODEL, D_MODEL, 0, BIG, D_MODEL, 2));
        if (IN(P + 16)) { Gemm g{(const bf16*)(ws + WS_PB), (const bf16*)(ws + WS_PP), M, D_MODEL, PLE_DIM}; StaticOrder S; S.init(M, D_MODEL, F.G, F.bid);
            pg8::EpiGateMul E{BIG, D_MODEL, Y, D_MODEL, 0}; pg8::gemm_phase<pg8::EpiGateMul, StaticOrder, PG8_ALIGN, PG8_SP2>(F.lds, g, S, E); } SEAM(P + 16); CHK(P + 16, chk_ple(F, P + 16, l));
        if (IN(P + 17)) { CHKSAVE(P + 17); phase_norm(F, F.out, 1.0f, F.in[24] + l * D_MODEL, (l + 1 < DEPTH) ? F.in[2] + (l + 1) * D_MODEL : nullptr, P + 17); } SEAM(P + 17); CHK(P + 17, chk_norm(F, P + 17, nullptr, 1.0f, F.in[24] + l * D_MODEL, (l + 1 < DEPTH) ? F.in[2] + (l + 1) * D_MODEL : nullptr));
    }
#if MK_CHECK
    if (F.bid == 0 && threadIdx.x == 0) { const unsigned v = __hip_atomic_load((unsigned*)(ws + WS_CTL) + CW_CHK, __ATOMIC_RELAXED, __HIP_MEMORY_SCOPE_AGENT); if (v) F.out[0] = 1000.0f * (float)v;
        const unsigned v2 = __hip_atomic_load((unsigned*)(ws + WS_CTL) + 65, __ATOMIC_RELAXED, __HIP_MEMORY_SCOPE_AGENT);
        if (v2 && !v) { const unsigned n = __hip_atomic_load((unsigned*)(ws + WS_CTL) + 128 + (NPHASES - v2), __ATOMIC_RELAXED, __HIP_MEMORY_SCOPE_AGENT); F.out[1] = 100.0f + (float)n; } }
#endif
#undef IN
#undef SEAM
}

extern "C" void kernel_launch(void* const* d_in, const int* in_sizes, int n_in, void* d_out, int out_size, void* d_ws, size_t ws_size, hipStream_t stream) {
    static int grid = 0;
    if (grid == 0) {
        if (n_in != 25 || in_sizes[0] != M * D_MODEL || out_size != M * D_MODEL || ws_size < WS_END) {
            fprintf(stderr, "kernel_launch: unexpected shapes (n_in %d, in0 %d, out %d, ws %zu < %zu); nothing launched\n", n_in, n_in > 0 ? in_sizes[0] : -1, out_size, ws_size, (size_t)WS_END); grid = -1; return; }
        int dev = 0, cus = 0, per_cu = 0;
        if (hipGetDevice(&dev) != hipSuccess || hipDeviceGetAttribute(&cus, hipDeviceAttributeMultiprocessorCount, dev) != hipSuccess) { grid = -1; return; }
        if (hipFuncSetAttribute((const void*)fwd, hipFuncAttributeMaxDynamicSharedMemorySize, LDS_BYTES) != hipSuccess) { fprintf(stderr, "kernel_launch: hipFuncSetAttribute failed\n"); grid = -1; return; }
        if (hipOccupancyMaxActiveBlocksPerMultiprocessor(&per_cu, (const void*)fwd, NTHR, LDS_BYTES) != hipSuccess || per_cu < 1)
            fprintf(stderr, "kernel_launch: note: occupancy query reports %d workgroups per CU\n", per_cu);
        (void)hipGetLastError();
        grid = cus;
    }
    if (grid < 0) return;
    if (hipMemsetAsync((char*)d_ws + WS_CTL, 0, CTL_ZERO_BYTES, stream) != hipSuccess) { fprintf(stderr, "kernel_launch: memset failed\n"); return; }
    Args a{};
    for (int i = 0; i < 25; ++i) a.in[i] = (const float*)d_in[i];
    a.out = (float*)d_out; a.ws = (unsigned char*)d_ws;
#if MK_ONE_LAUNCH
    a.ph_lo = 0; a.ph_hi = NPHASES;
    hipLaunchKernelGGL(fwd, dim3(grid), dim3(NTHR), LDS_BYTES, stream, a);
#else
    for (int ph = 0; ph < NPHASES; ++ph) {
        a.ph_lo = ph; a.ph_hi = ph + 1;
        hipLaunchKernelGGL(fwd, dim3(grid), dim3(NTHR), LDS_BYTES, stream, a);
    }
#endif
    const hipError_t le = hipPeekAtLastError();
    if (le != hipSuccess) fprintf(stderr, "kernel_launch: launch failed: %s\n", hipGetErrorName(le));
}
```

```cpp
#include <hip/hip_runtime.h>
#include <cstdio>
#include <cstdint>

#ifndef MK_CHECK
#define MK_CHECK 0
#endif
#ifndef MK_ONE_LAUNCH
#define MK_ONE_LAUNCH 1
#endif

namespace pg8 {
#define PG8_LAS __attribute__((address_space(3)))
typedef unsigned short bf16_t;
typedef short bf16x8 __attribute__((ext_vector_type(8)));
typedef float f32x4 __attribute__((ext_vector_type(4)));
typedef unsigned u32x4 __attribute__((ext_vector_type(4)));
constexpr int BM = 256, BK = 64, HALF = 128, HTB = HALF * BK * 2  , STAGE_BYTES = 8 * HTB, NXCD = 8, WGM = 8;

__host__ __device__ __forceinline__ int lds_byte(int r, int c) { const int st = (r >> 4) * 2 + (c >> 5), rr = r & 15, cc = c & 31, ob = rr * 64 + cc * 2; return st * 1024 + (ob ^ (((ob >> 9) & 1) << 5)); }
__host__ __device__ __forceinline__ void stage_rc(int b, int& R, int& C) { const int st = b / 1024, sb = b % 1024, swz = sb ^ (((sb >> 9) & 1) << 5); R = (st >> 1) * 16 + swz / 64; C = (st & 1) * 32 + (swz % 64) / 2; }
__host__ __device__ __forceinline__ int perm32(int rho) { const int n = rho >> 4, i = rho & 15; return 8 * (i >> 2) + 4 * n + (i & 3); }

struct Unit { int pm, pn; };
struct Gemm { const bf16_t* A; const bf16_t* Bt; int M, N, K; };

struct StaticOrder {
    int nM, nN, nwg, G, c;
    __host__ __device__ void init(int M, int N, int G_, int c_) { nM = M / BM; nN = N / BM; nwg = nM * nN; G = G_; c = c_; }
    __host__ __device__ bool next(int i, Unit& u) const {
        const long L = (long)i * G + c; if (L >= nwg) return false;
        int wgid = (int)L; { const int q = nwg / NXCD, r = nwg % NXCD, xcd = wgid % NXCD, off = wgid / NXCD; wgid = (xcd < r ? xcd * (q + 1) : r * (q + 1) + (xcd - r) * q) + off; }
        const int nig = WGM * nN, gid = wgid / nig, fm = gid * WGM, gsz = (nM - fm) < WGM ? (nM - fm) : WGM;
        u.pm = fm + ((wgid % nig) % gsz); u.pn = (wgid % nig) / gsz; return true;
    }
    __device__ __forceinline__ void a_ready(const Unit&) const {}
    __device__ __forceinline__ void done(const Unit&) const {}
};

typedef float f32x2_t __attribute__((ext_vector_type(2))); typedef __bf16 bf16x2_t __attribute__((ext_vector_type(2)));
__device__ __forceinline__ unsigned cvt_pk_bf16(float lo, float hi) { f32x2_t v = {lo, hi}; bf16x2_t b = __builtin_convertvector(v, bf16x2_t); return __builtin_bit_cast(unsigned, b); }
__device__ __forceinline__ float bf_lo(unsigned w) { return __uint_as_float(w << 16); }
__device__ __forceinline__ float bf_hi(unsigned w) { return __uint_as_float(w & 0xffff0000u); }
__device__ __forceinline__ float sigmoidf_(float v) { return __builtin_amdgcn_rcpf(1.0f + __builtin_amdgcn_exp2f(-1.4426950408889634f * v)); }

template <int ACT> struct EpiBf16 {
    static constexpr bool PERM = true, AFTER_DRAIN = false;
    bf16_t* O; int ldc;
    __device__ __forceinline__ void operator()(const f32x4 (&acc)[2][2][4][2], const Unit& u, int wr, int wc, int fr, int fq) const {
        const int row0 = u.pm * BM + wr * 64 + fr, col0 = u.pn * BM + wc * 32 + 8 * fq;
#pragma unroll
        for (int ai = 0; ai < 2; ++ai)
#pragma unroll
            for (int m = 0; m < 4; ++m) { bf16_t* rowp = O + (size_t)(row0 + ai * HALF + m * 16) * ldc + col0;
#pragma unroll
                for (int bj = 0; bj < 2; ++bj) { f32x4 v0 = acc[ai][bj][m][0], v1 = acc[ai][bj][m][1];
                    if (ACT == 2) {
#pragma unroll
                        for (int e = 0; e < 4; ++e) { v0[e] = sigmoidf_(v0[e]); v1[e] = sigmoidf_(v1[e]); } }
                    u32x4 w; w.x = cvt_pk_bf16(v0[0], v0[1]); w.y = cvt_pk_bf16(v0[2], v0[3]); w.z = cvt_pk_bf16(v1[0], v1[1]); w.w = cvt_pk_bf16(v1[2], v1[3]);
                    *(u32x4*)(rowp + bj * HALF) = w; } }
    }
};
struct EpiSwiglu {
    static constexpr bool PERM = true, AFTER_DRAIN = false;
    bf16_t* H; int ldh;
    __device__ __forceinline__ void operator()(const f32x4 (&acc)[2][2][4][2], const Unit& u, int wr, int wc, int fr, int fq) const {
        const int row0 = u.pm * BM + wr * 64 + fr, col0 = u.pn * HALF + wc * 32 + 8 * fq;
#pragma unroll
        for (int ai = 0; ai < 2; ++ai)
#pragma unroll
            for (int m = 0; m < 4; ++m) { bf16_t* rowp = H + (size_t)(row0 + ai * HALF + m * 16) * ldh + col0;
                f32x4 h0, h1;
#pragma unroll
                for (int e = 0; e < 4; ++e) { const float g0 = acc[ai][0][m][0][e], g1 = acc[ai][0][m][1][e];
                    h0[e] = g0 * sigmoidf_(g0) * acc[ai][1][m][0][e]; h1[e] = g1 * sigmoidf_(g1) * acc[ai][1][m][1][e]; }
                u32x4 w; w.x = cvt_pk_bf16(h0[0], h0[1]); w.y = cvt_pk_bf16(h0[2], h0[3]); w.z = cvt_pk_bf16(h1[0], h1[1]); w.w = cvt_pk_bf16(h1[2], h1[3]);
                *(u32x4*)rowp = w; }
    }
};
struct EpiGateMul {
    static constexpr bool PERM = true, AFTER_DRAIN = false;
    const bf16_t* G; int ldg; bf16_t* O; int ldc; int accum;
    __device__ __forceinline__ void operator()(const f32x4 (&acc)[2][2][4][2], const Unit& u, int wr, int wc, int fr, int fq) const {
        const int row0 = u.pm * BM + wr * 64 + fr, col0 = u.pn * BM + wc * 32 + 8 * fq;
#pragma unroll
        for (int ai = 0; ai < 2; ++ai)
#pragma unroll
            for (int m = 0; m < 4; ++m) { const size_t r = (size_t)(row0 + ai * HALF + m * 16);
#pragma unroll
                for (int bj = 0; bj < 2; ++bj) { const u32x4 gw = *(const u32x4*)(G + r * ldg + col0 + bj * HALF);
                    bf16_t* op = O + r * ldc + col0 + bj * HALF;
                    f32x4 v0 = acc[ai][bj][m][0], v1 = acc[ai][bj][m][1];
                    v0[0] *= bf_lo(gw.x); v0[1] *= bf_hi(gw.x); v0[2] *= bf_lo(gw.y); v0[3] *= bf_hi(gw.y);
                    v1[0] *= bf_lo(gw.z); v1[1] *= bf_hi(gw.z); v1[2] *= bf_lo(gw.w); v1[3] *= bf_hi(gw.w);
                    if (accum) { const u32x4 ow = *(const u32x4*)op;
                        v0[0] += bf_lo(ow.x); v0[1] += bf_hi(ow.x); v0[2] += bf_lo(ow.y); v0[3] += bf_hi(ow.y);
                        v1[0] += bf_lo(ow.z); v1[1] += bf_hi(ow.z); v1[2] += bf_lo(ow.w); v1[3] += bf_hi(ow.w); }
                    u32x4 w; w.x = cvt_pk_bf16(v0[0], v0[1]); w.y = cvt_pk_bf16(v0[2], v0[3]); w.z = cvt_pk_bf16(v1[0], v1[1]); w.w = cvt_pk_bf16(v1[2], v1[3]);
                    *(u32x4*)op = w; } }
    }
};

template <class Epi, class Sched, bool ALIGN_EPI = false, bool SP2 = false>
__device__ __forceinline__ void gemm_phase(PG8_LAS unsigned char* lds, const Gemm g, const Sched& S, const Epi& E) {
    int tid_ = threadIdx.x; asm volatile("" : "+v"(tid_));
    const int tid = tid_, wid = __builtin_amdgcn_readfirstlane(tid >> 6), lane = tid & 63, wr = wid >> 2, wc = wid & 3, fr = lane & 15, fq = lane >> 4;
    const int K = g.K, nt = K / BK;
    unsigned voffA[2], voffB[2];
#pragma unroll
    for (int i = 0; i < 2; ++i) { int R, C; stage_rc(tid * 16 + i * 8192, R, C); const int Rb = Epi::PERM ? ((R & ~31) + perm32(R & 31)) : R;
        voffA[i] = (unsigned)(R * K + C) * 2u; voffB[i] = (unsigned)(Rb * K + C) * 2u; }
    const size_t kstep = (size_t)(BK * 2);
    const size_t hstep = (size_t)HALF * K * 2;
    const size_t tstep = 2 * hstep;
    const unsigned ldsw = (unsigned)wid * 1024u;
    const int aoff = lds_byte(wr * 64 + fr, fq * 8), boff = lds_byte(wc * 32 + fr, fq * 8);
#define PG8_SA(b, h) (((b) * 2 + (h)) * HTB)
#define PG8_SB(b, h) ((4 + (b) * 2 + (h)) * HTB)
#define PG8_STAGE(bufoff, gbase, voff) do { _Pragma("unroll") for (int _i = 0; _i < 2; ++_i) \
        __builtin_amdgcn_global_load_lds((const unsigned*)((const char*)(gbase) + (voff)[_i]), (PG8_LAS unsigned*)(lds + (bufoff) + ldsw + _i * 8192), 16, 0, 0); } while (0)
#define PG8_LDA(dst, b, h) do { _Pragma("unroll") for (int m = 0; m < 4; ++m) _Pragma("unroll") for (int k = 0; k < 2; ++k) dst[m][k] = *(const PG8_LAS bf16x8*)(lds + PG8_SA(b, h) + aoff + m * 2048 + k * 1024); } while (0)
#define PG8_LDB(dst, b, h) do { _Pragma("unroll") for (int n = 0; n < 2; ++n) _Pragma("unroll") for (int k = 0; k < 2; ++k) dst[n][k] = *(const PG8_LAS bf16x8*)(lds + PG8_SB(b, h) + boff + n * 2048 + k * 1024); } while (0)
#define PG8_MMA(ai, bj, At, Bt) do { __builtin_amdgcn_s_setprio(1); _Pragma("unroll") for (int m = 0; m < 4; ++m) _Pragma("unroll") for (int n = 0; n < 2; ++n) _Pragma("unroll") for (int k = 0; k < 2; ++k) \
        acc[ai][bj][m][n] = __builtin_amdgcn_mfma_f32_16x16x32_bf16(Bt[n][k], At[m][k], acc[ai][bj][m][n], 0, 0, 0); __builtin_amdgcn_s_setprio(0); } while (0)
#define PG8_WAIT_V(n) asm volatile("s_waitcnt vmcnt(" #n ")" ::: "memory")
#define PG8_WAIT_L(n) asm volatile("s_waitcnt lgkmcnt(" #n ")" ::: "memory")
#define PG8_BAR __builtin_amdgcn_s_barrier()
#define PG8_SCHED __builtin_amdgcn_sched_barrier(0)
    Unit cur, nxt; int ui = 0;
    if (!S.next(0, cur)) return;
    f32x4 acc[2][2][4][2];
#pragma unroll
    for (int a = 0; a < 2; ++a)
#pragma unroll
        for (int b = 0; b < 2; ++b)
#pragma unroll
            for (int m = 0; m < 4; ++m)
#pragma unroll
                for (int n = 0; n < 2; ++n) acc[a][b][m][n] = (f32x4){0.f, 0.f, 0.f, 0.f};
    bf16x8 At[4][2], B0[2][2], B1[2][2];
    const char* cA = (const char*)g.A + (size_t)cur.pm * tstep; const char* cB = (const char*)g.Bt + (size_t)cur.pn * tstep;
    S.a_ready(cur);
    if constexpr (SP2) {
        PG8_STAGE(PG8_SB(0, 0), cB, voffB); PG8_STAGE(PG8_SB(0, 1), cB + hstep, voffB); PG8_STAGE(PG8_SA(0, 0), cA, voffA); PG8_STAGE(PG8_SA(0, 1), cA + hstep, voffA);
        if (wr == 1) PG8_BAR;
        PG8_WAIT_V(2); PG8_BAR;
        PG8_STAGE(PG8_SB(1, 0), cB + kstep, voffB); PG8_STAGE(PG8_SA(1, 0), cA + kstep, voffA); PG8_STAGE(PG8_SB(1, 1), cB + hstep + kstep, voffB);
        PG8_WAIT_V(6); PG8_BAR;
    } else {
        PG8_STAGE(PG8_SB(0, 0), cB, voffB); PG8_STAGE(PG8_SA(0, 0), cA, voffA); PG8_STAGE(PG8_SB(0, 1), cB + hstep, voffB); PG8_STAGE(PG8_SA(0, 1), cA + hstep, voffA);
        if (wr == 1) PG8_BAR;
        PG8_WAIT_V(4); PG8_BAR;
        PG8_STAGE(PG8_SB(1, 0), cB + kstep, voffB); PG8_STAGE(PG8_SA(1, 0), cA + kstep, voffA); PG8_STAGE(PG8_SB(1, 1), cB + hstep + kstep, voffB);
        PG8_WAIT_V(6); PG8_BAR;
    }
    for (;;) {
        const bool has_next = S.next(ui + 1, nxt);
        const char* nA = has_next ? (const char*)g.A + (size_t)nxt.pm * tstep : cA; const char* nB = has_next ? (const char*)g.Bt + (size_t)nxt.pn * tstep : cB;
        for (int t = 0; t < nt; t += 2) {
            const bool last = (t == nt - 2);
            const char* a1 = cA + (size_t)(t + 1) * kstep;
            const char* a2 = last ? nA : cA + (size_t)(t + 2) * kstep; const char* b2 = last ? nB : cB + (size_t)(t + 2) * kstep;
            const char* a3 = a2 + kstep; const char* b3 = b2 + kstep;
            if (last && has_next) S.a_ready(nxt);
            if constexpr (SP2) {
            PG8_LDB(B0, 0, 0); PG8_LDB(B1, 0, 1); PG8_SCHED; PG8_LDA(At, 0, 0); PG8_STAGE(PG8_SA(1, 1), a1 + hstep, voffA);
            PG8_WAIT_V(8); PG8_WAIT_L(0); PG8_BAR; PG8_MMA(0, 0, At, B0); PG8_MMA(0, 1, At, B1); PG8_BAR; PG8_SCHED;
            PG8_LDA(At, 0, 1); PG8_STAGE(PG8_SB(0, 0), b2, voffB); PG8_STAGE(PG8_SB(0, 1), b2 + hstep, voffB); PG8_STAGE(PG8_SA(0, 0), a2, voffA);
            PG8_WAIT_V(8); PG8_WAIT_L(0); PG8_BAR; PG8_MMA(1, 0, At, B0); PG8_MMA(1, 1, At, B1); PG8_BAR; PG8_SCHED;
            PG8_LDB(B0, 1, 0); PG8_LDB(B1, 1, 1); PG8_SCHED; PG8_LDA(At, 1, 0); PG8_STAGE(PG8_SA(0, 1), a2 + hstep, voffA);
            PG8_WAIT_V(8); PG8_WAIT_L(0); PG8_BAR; PG8_MMA(0, 0, At, B0); PG8_MMA(0, 1, At, B1); PG8_BAR; PG8_SCHED;
            PG8_LDA(At, 1, 1); PG8_STAGE(PG8_SB(1, 0), b3, voffB); PG8_STAGE(PG8_SB(1, 1), b3 + hstep, voffB); PG8_STAGE(PG8_SA(1, 0), a3, voffA);
            PG8_WAIT_V(8); PG8_WAIT_L(0); PG8_BAR; PG8_MMA(1, 0, At, B0); PG8_MMA(1, 1, At, B1); PG8_BAR; PG8_SCHED;
            } else {
            PG8_LDB(B0, 0, 0); PG8_SCHED; PG8_LDA(At, 0, 0); PG8_STAGE(PG8_SA(1, 1), a1 + hstep, voffA);
            PG8_WAIT_L(8); PG8_BAR; PG8_WAIT_L(0); PG8_MMA(0, 0, At, B0); PG8_BAR; PG8_SCHED;
            PG8_LDB(B1, 0, 1); PG8_STAGE(PG8_SB(0, 0), b2, voffB);
            PG8_BAR; PG8_WAIT_L(0); PG8_MMA(0, 1, At, B1); PG8_BAR;
            PG8_LDA(At, 0, 1); PG8_STAGE(PG8_SA(0, 0), a2, voffA);
            PG8_BAR; PG8_WAIT_L(0); PG8_MMA(1, 0, At, B0); PG8_BAR; PG8_SCHED;
            PG8_STAGE(PG8_SB(0, 1), b2 + hstep, voffB);
            PG8_WAIT_V(6); PG8_BAR; PG8_MMA(1, 1, At, B1); PG8_BAR;
            PG8_LDB(B0, 1, 0); PG8_SCHED; PG8_LDA(At, 1, 0); PG8_STAGE(PG8_SA(0, 1), a2 + hstep, voffA);
            PG8_WAIT_L(8); PG8_BAR; PG8_WAIT_L(0); PG8_MMA(0, 0, At, B0); PG8_BAR; PG8_SCHED;
            PG8_LDB(B1, 1, 1); PG8_STAGE(PG8_SB(1, 0), b3, voffB);
            PG8_BAR; PG8_WAIT_L(0); PG8_MMA(0, 1, At, B1); PG8_BAR;
            PG8_LDA(At, 1, 1); PG8_STAGE(PG8_SA(1, 0), a3, voffA);
            PG8_BAR; PG8_WAIT_L(0); PG8_MMA(1, 0, At, B0); PG8_BAR; PG8_SCHED;
            PG8_STAGE(PG8_SB(1, 1), b3 + hstep, voffB);
            PG8_WAIT_V(6); PG8_BAR; PG8_MMA(1, 1, At, B1); PG8_BAR;
            }
        }
        if constexpr (ALIGN_EPI) { if (wr == 0) PG8_BAR; }
        if constexpr (!Epi::AFTER_DRAIN) { E(acc, cur, wr, wc, fr, fq); S.done(cur); }
        if (!has_next) break;
#pragma unroll
        for (int a = 0; a < 2; ++a)
#pragma unroll
            for (int b = 0; b < 2; ++b)
#pragma unroll
                for (int m = 0; m < 4; ++m)
#pragma unroll
                    for (int n = 0; n < 2; ++n) acc[a][b][m][n] = (f32x4){0.f, 0.f, 0.f, 0.f};
        cur = nxt; cA = nA; cB = nB; ++ui;
        if constexpr (ALIGN_EPI) { if (wr == 1) PG8_BAR; }
    }
    PG8_WAIT_V(0);
    if constexpr (!ALIGN_EPI) { if (wr == 0) PG8_BAR; }
    PG8_BAR;
#undef PG8_SA
#undef PG8_SB
#undef PG8_STAGE
#undef PG8_LDA
#undef PG8_LDB
#undef PG8_MMA
#undef PG8_WAIT_V
#undef PG8_WAIT_L
#undef PG8_BAR
#undef PG8_SCHED
}
}

#define PG8_SP2 true
#define PG8_ALIGN true

constexpr int NWAVES = 8, NTHR = NWAVES * 64;
constexpr int D_MODEL = 2048, BATCH = 2, SEQ = 16384, DEPTH = 2, PLE_DIM = 256, D_FF = 5632, CONV_WIDTH = 512;
constexpr int NHEAD = 16, NKV = 2, HEAD_DIM = 64, WINDOW = 128;
constexpr int HG_H = 8, HG_DK = 128, HG_DV = 64, HG_C = 64, HG_NC = SEQ / HG_C;
constexpr int M = BATCH * SEQ;
constexpr int D_IN = 12032, N_MAIN = 5888, N_GATES = 6144;
constexpr int C_CX = 0, C_CB = 512, C_CC = 1024, C_AQ = 1536, C_AK = 2560, C_AV = 2688, C_RQ = 2816, C_RF = 3840, C_RI = 4864, C_RG = 5376;
constexpr float NORM_EPS = 1e-6f;
constexpr int NPH = 18;
constexpr int NPHASES = DEPTH * NPH;

constexpr size_t MiB = 1u << 20;
constexpr size_t WS_CTL = 0, CTL_ZERO_BYTES = 1 * MiB;
constexpr size_t WS_GU1 = 2 * MiB, WS_D1 = 46 * MiB, WS_WIN = 68 * MiB, WS_BC = 115 * MiB, WS_BA = 117 * MiB, WS_BH = 121 * MiB, WS_WO = 123 * MiB,
                 WS_GU2 = 131 * MiB, WS_D2 = 175 * MiB, WS_PG = 197 * MiB, WS_PP = 205 * MiB, WS_PB = 206 * MiB;
constexpr size_t WS_XN = 222 * MiB;
constexpr size_t WS_Y = 350 * MiB;
constexpr size_t WS_FC = WS_Y, WS_FA = WS_Y + 32 * MiB, WS_FH = WS_Y + 96 * MiB;
constexpr size_t WS_BIG = 478 * MiB;
constexpr size_t WS_UT = WS_BIG + 368 * MiB;
constexpr size_t WS_DD = WS_UT + 128 * MiB;
constexpr size_t WS_END = WS_DD + 2 * MiB;
constexpr int CW_BAR = 4096;

constexpr int RING_BYTES = 131072;
constexpr int LDS_X_OFF = RING_BYTES;
constexpr int MISC_OFF = RING_BYTES + 8192;
constexpr int LDS_BYTES = 147456;

#define GAS __attribute__((address_space(1)))
#define LAS __attribute__((address_space(3)))
typedef unsigned short bf16;
typedef unsigned v4u __attribute__((ext_vector_type(4)));
typedef float f32x4 __attribute__((ext_vector_type(4)));
typedef GAS unsigned gu32;
#define LDS_WAIT() asm volatile("s_waitcnt lgkmcnt(0)" ::: "memory")
__device__ __forceinline__ unsigned f2bf(float f) { unsigned u = __builtin_bit_cast(unsigned, f); return (u + 0x7fffu + ((u >> 16) & 1u)) >> 16; }
__device__ __forceinline__ unsigned pk2(float lo, float hi) { return f2bf(lo) | (f2bf(hi) << 16); }
__device__ __forceinline__ float bf2f(bf16 b) { return __uint_as_float((unsigned)b << 16); }
__device__ __forceinline__ float blo(unsigned w) { return __uint_as_float(w << 16); }
__device__ __forceinline__ float bhi(unsigned w) { return __uint_as_float(w & 0xffff0000u); }
__device__ __forceinline__ float sigm(float v) { return 1.0f / (1.0f + __expf(-v)); }

#define XB_TMO      128
#define XB_XCNT(j)  (256  + 64 * (j))
#define XB_XSUB(j)  (1280 + 64 * (j))
#define XB_XGEN(j)  (2304 + 64 * (j))
#define XB_TOP      3328
#define XB_TOPGEN   3392
#define XCD_BAR_WORDS 3456
#define XB_SPIN_CAP (1u << 18)
__device__ __forceinline__ unsigned xb_ld(unsigned* p)              { return __hip_atomic_load(p, __ATOMIC_RELAXED, __HIP_MEMORY_SCOPE_AGENT); }
__device__ __forceinline__ unsigned xb_add(unsigned* p, unsigned v) { return __hip_atomic_fetch_add(p, v, __ATOMIC_RELAXED, __HIP_MEMORY_SCOPE_AGENT); }
__device__ __forceinline__ unsigned xb_xcc_id() { return (unsigned)__builtin_amdgcn_s_getreg((3 << 11) | 20) & 0xFu; }
#define XB_SPIN(cond, bar) do { unsigned _sp = 0; while (cond) { __builtin_amdgcn_s_sleep(1); \
    if ((++_sp & 255u) == 0u) { if (xb_ld(&(bar)[XB_TMO])) break; if (_sp > XB_SPIN_CAP) { atomicAdd(&(bar)[XB_TMO], 1u); break; } } } } while (0)
struct XcdBarrier { unsigned* bar; unsigned x; volatile LAS unsigned* st; };
__device__ __forceinline__ XcdBarrier xcd_barrier_post(unsigned* bar, volatile LAS unsigned* st) {
    XcdBarrier b; b.bar = bar; b.x = xb_xcc_id(); b.st = st;
    if (threadIdx.x == 0) (void)xb_add(&bar[XB_XCNT(b.x)], 1u);
    return b;
}
__device__ __forceinline__ void xcd_barrier_complete(unsigned* bar, unsigned x, unsigned& nloc, unsigned& nx) {
    const unsigned G = gridDim.x * gridDim.y * gridDim.z;
    unsigned sum, cnt, mine, sp = 0u;
    for (;;) {
        sum = 0u; cnt = 0u; mine = 0u;
#pragma unroll
        for (unsigned j = 0; j < 16; ++j) { const unsigned c = xb_ld(&bar[XB_XCNT(j)]); sum += c; cnt += (c > 0u) ? 1u : 0u; mine = (j == x) ? c : mine; }
        if (sum == G) break;
        __builtin_amdgcn_s_sleep(1);
        if ((++sp & 255u) == 0u) { if (xb_ld(&bar[XB_TMO])) break; if (sp > XB_SPIN_CAP) { atomicAdd(&bar[XB_TMO], 1u); break; } }
    }
    nloc = mine > 0u ? mine : 1u; nx = cnt > 0u ? cnt : 1u;
}
__device__ __forceinline__ void xcd_barrier(const XcdBarrier& b) {
    asm volatile("s_waitcnt vmcnt(0)" ::: "memory");
    __syncthreads();
    if (threadIdx.x == 0) {
        unsigned* bar = b.bar;
        __builtin_amdgcn_s_waitcnt(0);
        unsigned nloc = b.st[0], nx = b.st[1];
        if (nloc == 0u) { xcd_barrier_complete(bar, b.x, nloc, nx); b.st[0] = nloc; b.st[1] = nx; }
        const unsigned old = xb_add(&bar[XB_XSUB(b.x)], 1u);
        const unsigned gen = old / nloc;
        if (old + 1u == (gen + 1u) * nloc) {
            __builtin_amdgcn_fence(__ATOMIC_RELEASE, "agent");
            asm volatile("s_waitcnt vmcnt(0)" ::: "memory");
            const unsigned og = xb_add(&bar[XB_TOP], 1u);
            const unsigned tg = og / nx;
            if (og + 1u == (tg + 1u) * nx) xb_add(&bar[XB_TOPGEN], 1u);
            else XB_SPIN(xb_ld(&bar[XB_TOPGEN]) == tg, bar);
            __builtin_amdgcn_fence(__ATOMIC_ACQUIRE, "agent");
            xb_add(&bar[XB_XGEN(b.x)], 1u);
            asm volatile("s_waitcnt vmcnt(0)" ::: "memory");
        } else {
            XB_SPIN(xb_ld(&bar[XB_XGEN(b.x)]) == gen, bar);
            __builtin_amdgcn_fence(__ATOMIC_ACQUIRE, "agent");
            asm volatile("s_waitcnt vmcnt(0)" ::: "memory");
        }
    }
    __syncthreads();
}

struct Args { const float* in[25]; float* out; unsigned char* ws; int ph_lo, ph_hi; };
struct Frame {
    LAS unsigned char* lds;
    int G, bid;
    const float* const* in;
    float* out; unsigned char* ws;
};
#define PHASE_TID() int tid_ = threadIdx.x; asm volatile("" : "+v"(tid_)); const int tid = tid_, lane = tid & 63, wave = __builtin_amdgcn_readfirstlane(tid >> 6); (void)lane; (void)wave
__device__ __forceinline__ float wave_sum(float v) {
#pragma unroll
    for (int o = 1; o < 64; o <<= 1) v += __shfl_xor(v, o);
    return v;
}
__device__ __forceinline__ float wave_max(float v) {
#pragma unroll
    for (int o = 1; o < 64; o <<= 1) v = fmaxf(v, __shfl_xor(v, o));
    return v;
}

__device__ __forceinline__ void transpose_item(const float* W, int K, int N, bf16* WT, LAS float* scr, int item, int lane, bool gu) {
    const int nblk = N / 32, kb = item / nblk, nb = item % nblk, k0 = 64 * kb, nd0 = 32 * nb;
    int ns0 = nd0;
    if (gu) { const int pn = nb >> 3, j = nb & 7; ns0 = ((j & 4) ? D_FF : 0) + 128 * pn + 32 * (j & 3); }
#pragma unroll 8
    for (int i = 0; i < 32; ++i) { const int kk = 2 * i + (lane >> 5); scr[kk * 33 + (lane & 31)] = W[(size_t)(k0 + kk) * N + ns0 + (lane & 31)]; }
    LDS_WAIT(); asm volatile("" ::: "memory");
    const int c = lane & 7;
#pragma unroll
    for (int j = 0; j < 4; ++j) { const int n = (lane >> 3) + 8 * j; const LAS float* s = scr + (8 * c) * 33 + n;
        v4u o; o.x = pk2(s[0 * 33], s[1 * 33]); o.y = pk2(s[2 * 33], s[3 * 33]); o.z = pk2(s[4 * 33], s[5 * 33]); o.w = pk2(s[6 * 33], s[7 * 33]);
        *(GAS v4u*)(WT + (size_t)(nd0 + n) * K + k0 + 8 * c) = o; }
    LDS_WAIT(); asm volatile("" ::: "memory");
}
__device__ __forceinline__ void rms_row_to_bf16(int lane, const float* xrow, const float* w, bf16* orow) {
    f32x4 v[4][2]; float ss = 0.f;
#pragma unroll
    for (int j = 0; j < 4; ++j)
#pragma unroll
        for (int h = 0; h < 2; ++h) { v[j][h] = *(const f32x4*)(xrow + 8 * lane + 512 * j + 4 * h); ss += (v[j][h].x * v[j][h].x + v[j][h].y * v[j][h].y) + (v[j][h].z * v[j][h].z + v[j][h].w * v[j][h].w); }
    const float rstd = 1.0f / sqrtf(wave_sum(ss) * (1.0f / D_MODEL) + NORM_EPS);
#pragma unroll
    for (int j = 0; j < 4; ++j) { const f32x4 w0 = *(const f32x4*)(w + 8 * lane + 512 * j), w1 = *(const f32x4*)(w + 8 * lane + 512 * j + 4);
        const f32x4 a = v[j][0] * rstd * w0, b = v[j][1] * rstd * w1;
        v4u o; o.x = pk2(a.x, a.y); o.y = pk2(a.z, a.w); o.z = pk2(b.x, b.y); o.w = pk2(b.z, b.w);
        *(v4u*)(orow + 8 * lane + 512 * j) = o; }
}

__device__ __forceinline__ void phase_convert(Frame& F, int l) {
    PHASE_TID();
    LAS float* scr = (LAS float*)(F.lds + wave * 16384);
    const int gw = F.bid * NWAVES + wave, NGW = F.G * NWAVES;
    unsigned char* ws = F.ws;
    constexpr int I_GU = (D_MODEL / 64) * (2 * D_FF / 32), I_D = (D_FF / 64) * (D_MODEL / 32), I_WIN = (D_MODEL / 64) * (D_IN / 32),
                  I_BC = (CONV_WIDTH / 64) * (D_MODEL / 32), I_BA = (1024 / 64) * (D_MODEL / 32), I_BH = (512 / 64) * (D_MODEL / 32),
                  I_SQ = (D_MODEL / 64) * (D_MODEL / 32), I_PP = (PLE_DIM / 64) * (D_MODEL / 32);
    constexpr int NITEMS = 2 * I_GU + 2 * I_D + I_WIN + I_BC + I_BA + I_BH + 2 * I_SQ + I_PP;
    for (int it = gw; it < NITEMS; it += NGW) {
        int r = it;
        if (r < I_GU) { transpose_item(F.in[3] + (size_t)l * D_MODEL * 2 * D_FF, D_MODEL, 2 * D_FF, (bf16*)(ws + WS_GU1), scr, r, lane, true); continue; } r -= I_GU;
        if (r < I_D) { transpose_item(F.in[4] + (size_t)l * D_FF * D_MODEL, D_FF, D_MODEL, (bf16*)(ws + WS_D1), scr, r, lane, false); continue; } r -= I_D;
        if (r < I_WIN) { transpose_item(F.in[7] + (size_t)l * D_MODEL * D_IN, D_MODEL, D_IN, (bf16*)(ws + WS_WIN), scr, r, lane, false); continue; } r -= I_WIN;
        if (r < I_BC) { transpose_item(F.in[12] + (size_t)l * CONV_WIDTH * D_MODEL, CONV_WIDTH, D_MODEL, (bf16*)(ws + WS_BC), scr, r, lane, false); continue; } r -= I_BC;
        if (r < I_BA) { transpose_item(F.in[13] + (size_t)l * 1024 * D_MODEL, 1024, D_MODEL, (bf16*)(ws + WS_BA), scr, r, lane, false); continue; } r -= I_BA;
        if (r < I_BH) { transpose_item(F.in[14] + (size_t)l * 512 * D_MODEL, 512, D_MODEL, (bf16*)(ws + WS_BH), scr, r, lane, false); continue; } r -= I_BH;
        if (r < I_SQ) { transpose_item(F.in[15] + (size_t)l * D_MODEL * D_MODEL, D_MODEL, D_MODEL, (bf16*)(ws + WS_WO), scr, r, lane, false); continue; } r -= I_SQ;
        if (r < I_GU) { transpose_item(F.in[18] + (size_t)l * D_MODEL * 2 * D_FF, D_MODEL, 2 * D_FF, (bf16*)(ws + WS_GU2), scr, r, lane, true); continue; } r -= I_GU;
        if (r < I_D) { transpose_item(F.in[19] + (size_t)l * D_FF * D_MODEL, D_FF, D_MODEL, (bf16*)(ws + WS_D2), scr, r, lane, false); continue; } r -= I_D;
        if (r < I_SQ) { transpose_item(F.in[22] + (size_t)l * D_MODEL * D_MODEL, D_MODEL, D_MODEL, (bf16*)(ws + WS_PG), scr, r, lane, false); continue; } r -= I_SQ;
        transpose_item(F.in[23] + (size_t)l * PLE_DIM * D_MODEL, PLE_DIM, D_MODEL, (bf16*)(ws + WS_PP), scr, r, lane, false);
    }
    { const float* p = F.in[1] + (size_t)l * M * PLE_DIM; bf16* pb = (bf16*)(ws + WS_PB);
      const size_t n8 = (size_t)M * PLE_DIM / 8;
      for (size_t i = (size_t)F.bid * NTHR + tid; i < n8; i += (size_t)F.G * NTHR) {
          const f32x4 a = *(const f32x4*)(p + 8 * i), b = *(const f32x4*)(p + 8 * i + 4);
          v4u o; o.x = pk2(a.x, a.y); o.y = pk2(a.z, a.w); o.z = pk2(b.x, b.y); o.w = pk2(b.z, b.w);
          *(v4u*)(pb + 8 * i) = o; } }
    if (l == 0) {
        for (int m = gw; m < M; m += NGW) rms_row_to_bf16(lane, F.in[0] + (size_t)m * D_MODEL, F.in[2], (bf16*)(ws + WS_XN) + (size_t)m * D_MODEL);
    }
}

__device__ __forceinline__ void phase_norm(Frame& F, const float* xin, float alpha, const float* wpost, const float* wpre, int ph = 0) {
    PHASE_TID();
    const int gw = F.bid * NWAVES + wave, NGW = F.G * NWAVES;
    const bf16* Y = (const bf16*)(F.ws + WS_Y); bf16* XN = (bf16*)(F.ws + WS_XN);
    for (int m = gw; m < M; m += NGW) {
        const bf16* yrow = Y + (size_t)m * D_MODEL; const float* xr = xin + (size_t)m * D_MODEL; float* xo = F.out + (size_t)m * D_MODEL;
        float y[4][8]; float ss = 0.f;
#pragma unroll
        for (int j = 0; j < 4; ++j) { const v4u w = *(const v4u*)(yrow + 8 * lane + 512 * j);
            y[j][0] = blo(w.x); y[j][1] = bhi(w.x); y[j][2] = blo(w.y); y[j][3] = bhi(w.y); y[j][4] = blo(w.z); y[j][5] = bhi(w.z); y[j][6] = blo(w.w); y[j][7] = bhi(w.w);
#pragma unroll
            for (int e = 0; e < 8; ++e) ss += y[j][e] * y[j][e]; }
        const float rstd = alpha / sqrtf(wave_sum(ss) * (1.0f / D_MODEL) + NORM_EPS);
#if MK_CHECK
        { float mxv = 0.f;
#pragma unroll
          for (int j = 0; j < 4; ++j)
#pragma unroll
              for (int e = 0; e < 8; ++e) mxv = fmaxf(mxv, fabsf(y[j][e]));
          mxv = wave_max(mxv) * rstd / alpha;
          if (mxv > 20.0f && lane == 0) { atomicMax((unsigned*)(F.ws + WS_CTL) + 65, (unsigned)(NPHASES - ph)); atomicAdd((unsigned*)(F.ws + WS_CTL) + 128 + ph, 1u); } }
#endif
        float ss2 = 0.f;
#pragma unroll
        for (int j = 0; j < 4; ++j) {
#pragma unroll
            for (int h = 0; h < 2; ++h) { const int c = 8 * lane + 512 * j + 4 * h;
                const f32x4 xv = *(const f32x4*)(xr + c), wp = *(const f32x4*)(wpost + c);
                f32x4 nv;
                nv.x = xv.x + y[j][4 * h + 0] * rstd * wp.x; nv.y = xv.y + y[j][4 * h + 1] * rstd * wp.y; nv.z = xv.z + y[j][4 * h + 2] * rstd * wp.z; nv.w = xv.w + y[j][4 * h + 3] * rstd * wp.w;
                *(f32x4*)(xo + c) = nv;
                y[j][4 * h + 0] = nv.x; y[j][4 * h + 1] = nv.y; y[j][4 * h + 2] = nv.z; y[j][4 * h + 3] = nv.w;
                ss2 += (nv.x * nv.x + nv.y * nv.y) + (nv.z * nv.z + nv.w * nv.w); } }
        if (wpre) {
            const float rstd2 = 1.0f / sqrtf(wave_sum(ss2) * (1.0f / D_MODEL) + NORM_EPS);
#pragma unroll
            for (int j = 0; j < 4; ++j) { const int c = 8 * lane + 512 * j;
                const f32x4 w0 = *(const f32x4*)(wpre + c), w1 = *(const f32x4*)(wpre + c + 4);
                v4u o; o.x = pk2(y[j][0] * rstd2 * w0.x, y[j][1] * rstd2 * w0.y); o.y = pk2(y[j][2] * rstd2 * w0.z, y[j][3] * rstd2 * w0.w);
                o.z = pk2(y[j][4] * rstd2 * w1.x, y[j][5] * rstd2 * w1.y); o.w = pk2(y[j][6] * rstd2 * w1.z, y[j][7] * rstd2 * w1.w);
                *(v4u*)(XN + (size_t)m * D_MODEL + c) = o; }
        }
    }
}

__device__ __forceinline__ void phase_conv(Frame& F, int l) {
    PHASE_TID();
    const bf16* main_ = (const bf16*)(F.ws + WS_BIG); bf16* FC = (bf16*)(F.ws + WS_FC);
    const float* cw = F.in[8] + (size_t)l * 3 * CONV_WIDTH;
    for (int it = F.bid * NTHR + tid; it < M * 64; it += F.G * NTHR) {
        const int row = it >> 6, cg = it & 63, t = row & (SEQ - 1);
        float acc[8];
#pragma unroll
        for (int e = 0; e < 8; ++e) acc[e] = 0.f;
#pragma unroll
        for (int j = 0; j < 3; ++j) {
            if (t - j >= 0) {
                const bf16* rp = main_ + (size_t)(row - j) * N_MAIN;
                const v4u xv = *(const v4u*)(rp + C_CX + 8 * cg), cv = *(const v4u*)(rp + C_CC + 8 * cg);
                const float* wj = cw + (2 - j) * CONV_WIDTH + 8 * cg;
                const f32x4 w0 = *(const f32x4*)wj, w1 = *(const f32x4*)(wj + 4);
                acc[0] += w0.x * blo(xv.x) * blo(cv.x); acc[1] += w0.y * bhi(xv.x) * bhi(cv.x); acc[2] += w0.z * blo(xv.y) * blo(cv.y); acc[3] += w0.w * bhi(xv.y) * bhi(cv.y);
                acc[4] += w1.x * blo(xv.z) * blo(cv.z); acc[5] += w1.y * bhi(xv.z) * bhi(cv.z); acc[6] += w1.z * blo(xv.w) * blo(cv.w); acc[7] += w1.w * bhi(xv.w) * bhi(cv.w);
            }
        }
        const v4u bv = *(const v4u*)(main_ + (size_t)row * N_MAIN + C_CB + 8 * cg);
        v4u o; o.x = pk2(acc[0] * blo(bv.x), acc[1] * bhi(bv.x)); o.y = pk2(acc[2] * blo(bv.y), acc[3] * bhi(bv.y));
        o.z = pk2(acc[4] * blo(bv.z), acc[5] * bhi(bv.z)); o.w = pk2(acc[6] * blo(bv.w), acc[7] * bhi(bv.w));
        *(v4u*)(FC + (size_t)row * CONV_WIDTH + 8 * cg) = o;
    }
}
__device__ __forceinline__ void phase_attn_simple(Frame& F, int l) {
    PHASE_TID();
    const bf16* main_ = (const bf16*)(F.ws + WS_BIG); bf16* FA = (bf16*)(F.ws + WS_FA);
    const float* sinks = F.in[9] + (size_t)l * NHEAD;
    const int gw = F.bid * NWAVES + wave, NGW = F.G * NWAVES;
    for (int task = gw; task < M * NHEAD; task += NGW) {
        const int row = task >> 4, h = task & 15, hk = h >> 3, t = row & (SEQ - 1);
        const float slope = exp2f(-0.5f * (float)(h + 1)), sink = sinks[h];
        const bf16* qp = main_ + (size_t)row * N_MAIN + C_AQ + h * 64;
        v4u q[8];
#pragma unroll
        for (int i = 0; i < 8; ++i) q[i] = *(const v4u*)(qp + 8 * i);
        float s[2];
#pragma unroll
        for (int jj = 0; jj < 2; ++jj) {
            const int j = lane + 64 * jj;
            float d = 0.f;
            if (t - j >= 0) {
                const bf16* kp = main_ + (size_t)(row - j) * N_MAIN + C_AK + hk * 64;
#pragma unroll
                for (int i = 0; i < 8; ++i) { const v4u kv = *(const v4u*)(kp + 8 * i);
                    d += blo(q[i].x) * blo(kv.x) + bhi(q[i].x) * bhi(kv.x) + blo(q[i].y) * blo(kv.y) + bhi(q[i].y) * bhi(kv.y)
                       + blo(q[i].z) * blo(kv.z) + bhi(q[i].z) * bhi(kv.z) + blo(q[i].w) * blo(kv.w) + bhi(q[i].w) * bhi(kv.w); }
                s[jj] = d * 0.125f - slope * (float)j;
            } else s[jj] = -1e30f;
        }
        const float mx = fmaxf(wave_max(fmaxf(s[0], s[1])), sink);
        const float p0 = __expf(s[0] - mx), p1 = __expf(s[1] - mx);
        const float denom = wave_sum(p0 + p1) + __expf(sink - mx);
        float acc = 0.f;
        const int jmax = t < (WINDOW - 1) ? t : (WINDOW - 1);
        const bf16* vp = main_ + (size_t)row * N_MAIN + C_AV + hk * 64 + lane;
        for (int j = 0; j <= jmax; ++j) {
            const float pj = __shfl(j < 64 ? p0 : p1, j & 63);
            acc += pj * bf2f(vp[-(ptrdiff_t)j * N_MAIN]);
        }
        FA[(size_t)row * 1024 + h * 64 + lane] = (bf16)f2bf(acc / denom);
    }
}


typedef float f32x16 __attribute__((ext_vector_type(16)));
typedef short s16x8 __attribute__((ext_vector_type(8)));
typedef short s16x4 __attribute__((ext_vector_type(4)));
typedef unsigned u32x2 __attribute__((ext_vector_type(2)));
constexpr int AT_KP = 144, AT_VP = 520, AT_VOFF = 256 * AT_KP;
__device__ __forceinline__ void phase_attn_mfma(Frame& F, int l) {
    PHASE_TID();
    const bf16* main_ = (const bf16*)(F.ws + WS_BIG); bf16* FA = (bf16*)(F.ws + WS_FA);
    LAS unsigned char* KL = F.lds; LAS unsigned char* VL = F.lds + AT_VOFF;
    const int r32 = lane & 31, hi = lane >> 5;
    constexpr float L2E = 1.4426950408889634f, NEG = -1e30f;
    for (int unit = F.bid; unit < BATCH * (SEQ / 128) * NKV; unit += F.G) {
        const int hk = unit & 1, n = (unit >> 1) & 127, b = unit >> 8;
        const size_t row0 = (size_t)b * SEQ + (size_t)n * 128;
#pragma unroll
        for (int i = 0; i < 4; ++i) { const int idx = tid + NTHR * i, key = idx & 255, dg = idx >> 8;
            v4u kv = (v4u){0u, 0u, 0u, 0u}, vv = (v4u){0u, 0u, 0u, 0u};
            if (n > 0 || key >= 128) { const bf16* rp = main_ + (row0 - 128 + key) * N_MAIN + hk * 64 + dg * 8; kv = *(const v4u*)(rp + C_AK); vv = *(const v4u*)(rp + C_AV); }
            *(LAS v4u*)(KL + key * AT_KP + dg * 16) = kv;
            LAS unsigned short* vp = (LAS unsigned short*)(VL + (dg * 8) * AT_VP + key * 2);
            vp[0 * (AT_VP / 2)] = (unsigned short)(vv.x & 0xffffu); vp[1 * (AT_VP / 2)] = (unsigned short)(vv.x >> 16);
            vp[2 * (AT_VP / 2)] = (unsigned short)(vv.y & 0xffffu); vp[3 * (AT_VP / 2)] = (unsigned short)(vv.y >> 16);
            vp[4 * (AT_VP / 2)] = (unsigned short)(vv.z & 0xffffu); vp[5 * (AT_VP / 2)] = (unsigned short)(vv.z >> 16);
            vp[6 * (AT_VP / 2)] = (unsigned short)(vv.w & 0xffffu); vp[7 * (AT_VP / 2)] = (unsigned short)(vv.w >> 16); }
        __syncthreads();
        const int h = hk * 8 + wave;
        const float slope2 = exp2f(-0.5f * (float)(h + 1)) * L2E, sink2 = F.in[9][l * NHEAD + h] * L2E;
        const float nsb2 = -slope2 * (float)(r32 + 128 - 4 * hi);
        for (int c = 0; c < 4; ++c) {
            const size_t qrow = row0 + 32 * c + r32;
            s16x8 qf[4];
#pragma unroll
            for (int ks = 0; ks < 4; ++ks) qf[ks] = *(const s16x8*)(main_ + qrow * N_MAIN + C_AQ + h * 64 + 16 * ks + 8 * hi);
            f32x16 S[5];
            float mx = NEG;
#pragma unroll
            for (int d = 0; d < 5; ++d) {
                const int kt = c + d;
                if (n == 0 && kt < 4) {
#pragma unroll
                    for (int r = 0; r < 16; ++r) S[d][r] = NEG;
                } else {
                    f32x16 acc;
#pragma unroll
                    for (int r = 0; r < 16; ++r) acc[r] = 0.f;
#pragma unroll
                    for (int ks = 0; ks < 4; ++ks) { const s16x8 a = *(const LAS s16x8*)(KL + (32 * kt + r32) * AT_KP + (16 * ks + 8 * hi) * 2);
                        acc = __builtin_amdgcn_mfma_f32_32x32x16_bf16(a, qf[ks], acc, 0, 0, 0); }
#pragma unroll
                    for (int r = 0; r < 16; ++r) { const int cr = (r & 3) + 8 * (r >> 2);
                        float s = fmaf(slope2, (float)(32 * d + cr), fmaf(acc[r], 0.125f * L2E, nsb2));
                        if (d == 0) { if (!(r32 - 4 * hi - cr < 0)) s = NEG; }
                        if (d == 4) { if (!(r32 - 4 * hi - cr >= 0)) s = NEG; }
                        S[d][r] = s; mx = fmaxf(mx, s); }
                }
            }
            mx = fmaxf(mx, __shfl_xor(mx, 32));
            mx = fmaxf(mx, sink2);
            float sum = 0.f;
            f32x16 O0, O1;
#pragma unroll
            for (int r = 0; r < 16; ++r) { O0[r] = 0.f; O1[r] = 0.f; }
#pragma unroll
            for (int d = 0; d < 5; ++d) {
                const int kt = c + d;
                if (n == 0 && kt < 4) continue;
#pragma unroll
                for (int r = 0; r < 16; ++r) { const float p = __builtin_amdgcn_exp2f(S[d][r] - mx); S[d][r] = p; sum += p; }
#pragma unroll
                for (int s = 0; s < 2; ++s) {
                    v4u pw; pw.x = pg8::cvt_pk_bf16(S[d][8 * s + 0], S[d][8 * s + 1]); pw.y = pg8::cvt_pk_bf16(S[d][8 * s + 2], S[d][8 * s + 3]);
                    pw.z = pg8::cvt_pk_bf16(S[d][8 * s + 4], S[d][8 * s + 5]); pw.w = pg8::cvt_pk_bf16(S[d][8 * s + 6], S[d][8 * s + 7]);
                    const s16x8 pf = __builtin_bit_cast(s16x8, pw);
                    const int kb = (32 * kt + 16 * s + 4 * hi) * 2;
                    { const s16x4 lo = *(const LAS s16x4*)(VL + r32 * AT_VP + kb), hh = *(const LAS s16x4*)(VL + r32 * AT_VP + kb + 16);
                      const s16x8 a = __builtin_shufflevector(lo, hh, 0, 1, 2, 3, 4, 5, 6, 7); O0 = __builtin_amdgcn_mfma_f32_32x32x16_bf16(a, pf, O0, 0, 0, 0); }
                    { const s16x4 lo = *(const LAS s16x4*)(VL + (32 + r32) * AT_VP + kb), hh = *(const LAS s16x4*)(VL + (32 + r32) * AT_VP + kb + 16);
                      const s16x8 a = __builtin_shufflevector(lo, hh, 0, 1, 2, 3, 4, 5, 6, 7); O1 = __builtin_amdgcn_mfma_f32_32x32x16_bf16(a, pf, O1, 0, 0, 0); }
                }
            }
            sum += __shfl_xor(sum, 32);
            const float inv = 1.0f / (sum + __builtin_amdgcn_exp2f(sink2 - mx));
            bf16* op = FA + qrow * 1024 + h * 64 + 4 * hi;
#pragma unroll
            for (int rg = 0; rg < 4; ++rg) {
                u32x2 w0; w0.x = pg8::cvt_pk_bf16(O0[4 * rg] * inv, O0[4 * rg + 1] * inv); w0.y = pg8::cvt_pk_bf16(O0[4 * rg + 2] * inv, O0[4 * rg + 3] * inv);
                u32x2 w1; w1.x = pg8::cvt_pk_bf16(O1[4 * rg] * inv, O1[4 * rg + 1] * inv); w1.y = pg8::cvt_pk_bf16(O1[4 * rg + 2] * inv, O1[4 * rg + 3] * inv);
                *(u32x2*)(op + 8 * rg) = w0; *(u32x2*)(op + 32 + 8 * rg) = w1; }
        }
        __syncthreads();
    }
}

__device__ __forceinline__ float hgrn_lb(const float* logits, int l, int ch) {
    float mx = -1e30f;
#pragma unroll
    for (int i = 0; i < DEPTH; ++i) mx = fmaxf(mx, logits[i * (HG_H * HG_DK) + ch]);
    float den = 0.f, num = 0.f;
#pragma unroll
    for (int i = 0; i < DEPTH; ++i) { const float e = __expf(logits[i * (HG_H * HG_DK) + ch] - mx); den += e; if (i < l) num += e; }
    return num / den;
}
template <bool WITH_Q>
__device__ __forceinline__ void hgrn_front(Frame& F, int l, int unit, int tid) {
    LAS float* L = (LAS float*)F.lds;
    LAS float* A_ = L; LAS float* KC = L + 8192; LAS float* Q = L + 16384; LAS float* V = L + 24576; LAS float* QT = L + 32768;
    const bf16* main_ = (const bf16*)(F.ws + WS_BIG);
    const int c = unit & (HG_NC - 1), bh = unit >> 8, h = bh & 7, b = bh >> 3;
    const size_t row0 = (size_t)b * SEQ + (size_t)c * HG_C;
    const int k = tid & 127, tq = tid >> 7;
    const float lb = hgrn_lb(F.in[10], l, h * HG_DK + k), lbe = fmaxf(lb, 1e-20f);
    float run = 0.f;
#pragma unroll 4
    for (int tt = 0; tt < 16; ++tt) { const int t = tq * 16 + tt;
        const bf16* rp = main_ + (row0 + t) * N_MAIN;
        const float z = bf2f(rp[C_RF + h * HG_DK + k]);
        const float sg = sigm(z);
        const float f = lbe + (1.0f - lbe) * sg;
        run += __logf(f);
        A_[t * 128 + k] = run; KC[t * 128 + k] = (1.0f - lb) * (1.0f - sg);
        if (WITH_Q) { const float qv = bf2f(rp[C_RQ + h * HG_DK + k]); Q[t * 128 + k] = qv * sigm(qv); }
    }
    QT[tq * 128 + k] = run;
    { const int t = tid >> 3, v8 = (tid & 7) * 8;
      const v4u w = *(const v4u*)(main_ + (row0 + t) * N_MAIN + C_RI + h * HG_DV + v8);
      LAS float* vp = V + t * 64 + v8;
      vp[0] = blo(w.x); vp[1] = bhi(w.x); vp[2] = blo(w.y); vp[3] = bhi(w.y); vp[4] = blo(w.z); vp[5] = bhi(w.z); vp[6] = blo(w.w); vp[7] = bhi(w.w); }
    __syncthreads();
    float off = 0.f;
    for (int q = 0; q < tq; ++q) off += QT[q * 128 + k];
#pragma unroll 4
    for (int tt = 0; tt < 16; ++tt) A_[(tq * 16 + tt) * 128 + k] += off;
    __syncthreads();
}
__device__ __forceinline__ void phase_hgrn_a(Frame& F, int l) {
    PHASE_TID();
    LAS float* L = (LAS float*)F.lds;
    LAS float* A_ = L; LAS float* KC = L + 8192; LAS float* V = L + 24576;
    float* UT = (float*)(F.ws + WS_UT); float* DD = (float*)(F.ws + WS_DD);
    const int k = tid & 127, tq = tid >> 7;
    for (int unit = F.bid; unit < BATCH * HG_H * HG_NC; unit += F.G) {
        hgrn_front<false>(F, l, unit, tid);
        const float alast = A_[63 * 128 + k];
#pragma unroll 4
        for (int tt = 0; tt < 16; ++tt) { const int t = tq * 16 + tt; KC[t * 128 + k] *= __expf(alast - A_[t * 128 + k]); }
        __syncthreads();
        float acc[16];
#pragma unroll
        for (int j = 0; j < 16; ++j) acc[j] = 0.f;
        for (int s = 0; s < 64; ++s) { const float kd = KC[s * 128 + k];
#pragma unroll
            for (int j = 0; j < 16; ++j) acc[j] += kd * V[s * 64 + tq * 16 + j]; }
#pragma unroll
        for (int j = 0; j < 16; ++j) UT[(size_t)unit * 8192 + (tq * 16 + j) * 128 + k] = acc[j];
        if (tq == 0) DD[(size_t)unit * 128 + k] = __expf(alast);
        __syncthreads();
    }
}
__device__ __forceinline__ void phase_hgrn_scan(Frame& F) {
    PHASE_TID();
    float* UT = (float*)(F.ws + WS_UT); const float* DD = (const float*)(F.ws + WS_DD);
    for (int e = F.bid * NTHR + tid; e < BATCH * HG_H * 8192; e += F.G * NTHR) {
        const int bh = e >> 13, vk = e & 8191, k = vk & 127;
        float s = 0.f;
        float* up = UT + (size_t)bh * HG_NC * 8192 + vk; const float* dp = DD + (size_t)bh * HG_NC * 128 + k;
        for (int c = 0; c < HG_NC; c += 8) {
            float u[8], d[8];
#pragma unroll
            for (int i = 0; i < 8; ++i) { u[i] = up[(size_t)(c + i) * 8192]; d[i] = dp[(size_t)(c + i) * 128]; }
#pragma unroll
            for (int i = 0; i < 8; ++i) { up[(size_t)(c + i) * 8192] = s; s = d[i] * s + u[i]; }
        }
    }
}
__device__ __forceinline__ void phase_hgrn_c(Frame& F, int l) {
    PHASE_TID();
    LAS float* L = (LAS float*)F.lds;
    LAS float* A_ = L; LAS float* KC = L + 8192; LAS float* Q = L + 16384; LAS float* V = L + 24576; LAS float* ATT = L + 28672;
    const float* UT = (const float*)(F.ws + WS_UT);
    const bf16* main_ = (const bf16*)(F.ws + WS_BIG); bf16* FH = (bf16*)(F.ws + WS_FH);
    const float* nw = F.in[11] + (size_t)l * HG_DV;
    const int k = tid & 127, tq = tid >> 7, w = wave;
    for (int unit = F.bid; unit < BATCH * HG_H * HG_NC; unit += F.G) {
        hgrn_front<true>(F, l, unit, tid);
        const int c = unit & (HG_NC - 1), bh = unit >> 8, h = bh & 7, b = bh >> 3;
        const size_t row0 = (size_t)b * SEQ + (size_t)c * HG_C;
        for (int p = w; p < 4096; p += NWAVES) { const int t = p >> 6, s = p & 63;
            if (s <= t) {
                float v = Q[t * 128 + lane] * __expf(A_[t * 128 + lane] - A_[s * 128 + lane]) * KC[s * 128 + lane]
                        + Q[t * 128 + 64 + lane] * __expf(A_[t * 128 + 64 + lane] - A_[s * 128 + 64 + lane]) * KC[s * 128 + 64 + lane];
                v = wave_sum(v);
                if (lane == 0) ATT[t * 64 + s] = v;
            }
        }
        __syncthreads();
#pragma unroll 4
        for (int tt = 0; tt < 16; ++tt) { const int t = tq * 16 + tt; Q[t * 128 + k] *= __expf(A_[t * 128 + k]); }
        __syncthreads();
        float acc[8];
#pragma unroll
        for (int i = 0; i < 8; ++i) acc[i] = 0.f;
        for (int s = 0; s < 8 * w + 8; ++s) { const float vv = V[s * 64 + lane];
#pragma unroll
            for (int i = 0; i < 8; ++i) { const int t = 8 * w + i; if (s <= t) acc[i] += ATT[t * 64 + s] * vv; } }
        const float* st = UT + (size_t)unit * 8192 + lane * 128;
        for (int k4 = 0; k4 < 128; k4 += 4) { const f32x4 sv = *(const f32x4*)(st + k4);
#pragma unroll
            for (int i = 0; i < 8; ++i) { const LAS float* qp = Q + (8 * w + i) * 128 + k4; acc[i] += qp[0] * sv.x + qp[1] * sv.y + qp[2] * sv.z + qp[3] * sv.w; } }
        const float nwv = nw[lane];
#pragma unroll
        for (int i = 0; i < 8; ++i) { const int t = 8 * w + i;
            const float ss = wave_sum(acc[i] * acc[i]);
            const float o = acc[i] * (1.0f / sqrtf(ss * (1.0f / HG_DV) + NORM_EPS)) * nwv;
            const float gv = bf2f(main_[(row0 + t) * N_MAIN + C_RG + h * HG_DV + lane]);
            FH[(row0 + t) * 512 + h * HG_DV + lane] = (bf16)f2bf(o * gv * sigm(gv)); }
        __syncthreads();
    }
}


constexpr int HG_P = 144, HG_PK = 272;
__device__ __forceinline__ void hg_stage_vt(const bf16* main_, size_t row0, int h, LAS unsigned char* VT, int tid) {
    const int s = tid & 63, dg = tid >> 6;
    const v4u w = *(const v4u*)(main_ + (row0 + s) * N_MAIN + C_RI + h * HG_DV + dg * 8);
    LAS unsigned short* vp = (LAS unsigned short*)(VT + (dg * 8) * HG_P + s * 2);
    vp[0 * (HG_P / 2)] = (unsigned short)(w.x & 0xffffu); vp[1 * (HG_P / 2)] = (unsigned short)(w.x >> 16);
    vp[2 * (HG_P / 2)] = (unsigned short)(w.y & 0xffffu); vp[3 * (HG_P / 2)] = (unsigned short)(w.y >> 16);
    vp[4 * (HG_P / 2)] = (unsigned short)(w.z & 0xffffu); vp[5 * (HG_P / 2)] = (unsigned short)(w.z >> 16);
    vp[6 * (HG_P / 2)] = (unsigned short)(w.w & 0xffffu); vp[7 * (HG_P / 2)] = (unsigned short)(w.w >> 16);
}
__device__ __forceinline__ void phase_hgrn_a2(Frame& F, int l) {
    PHASE_TID();
    LAS unsigned char* KDT = F.lds; LAS unsigned char* VT = F.lds + 18432; LAS float* QT = (LAS float*)(F.lds + 27648);
    const bf16* main_ = (const bf16*)(F.ws + WS_BIG); bf16* UTB = (bf16*)(F.ws + WS_UT); float* DD = (float*)(F.ws + WS_DD);
    const int k = tid & 127, tq = tid >> 7, r32 = lane & 31, hi = lane >> 5;
    for (int unit = F.bid; unit < BATCH * HG_H * HG_NC; unit += F.G) {
        const int c = unit & (HG_NC - 1), bh = unit >> 8, h = bh & 7, b = bh >> 3;
        const size_t row0 = (size_t)b * SEQ + (size_t)c * HG_C;
        const float lb = hgrn_lb(F.in[10], l, h * HG_DK + k), lbe = fmaxf(lb, 1e-20f);
        float a[16], kc[16]; float run = 0.f;
#pragma unroll
        for (int tt = 0; tt < 16; ++tt) { const float z = bf2f(main_[(row0 + tq * 16 + tt) * N_MAIN + C_RF + h * HG_DK + k]);
            const float sg = sigm(z); run += __logf(lbe + (1.0f - lbe) * sg); a[tt] = run; kc[tt] = (1.0f - lb) * (1.0f - sg); }
        QT[tq * 128 + k] = run;
        hg_stage_vt(main_, row0, h, VT, tid);
        __syncthreads();
        float off = 0.f, tot = 0.f;
#pragma unroll
        for (int q = 0; q < 4; ++q) { const float x = QT[q * 128 + k]; if (q < tq) off += x; tot += x; }
        float kd[16];
#pragma unroll
        for (int tt = 0; tt < 16; ++tt) kd[tt] = kc[tt] * __expf(tot - (off + a[tt]));
        { v4u w0, w1; w0.x = pg8::cvt_pk_bf16(kd[0], kd[1]); w0.y = pg8::cvt_pk_bf16(kd[2], kd[3]); w0.z = pg8::cvt_pk_bf16(kd[4], kd[5]); w0.w = pg8::cvt_pk_bf16(kd[6], kd[7]);
          w1.x = pg8::cvt_pk_bf16(kd[8], kd[9]); w1.y = pg8::cvt_pk_bf16(kd[10], kd[11]); w1.z = pg8::cvt_pk_bf16(kd[12], kd[13]); w1.w = pg8::cvt_pk_bf16(kd[14], kd[15]);
          *(LAS v4u*)(KDT + k * HG_P + tq * 32) = w0; *(LAS v4u*)(KDT + k * HG_P + tq * 32 + 16) = w1; }
        if (tq == 0) DD[(size_t)unit * 128 + k] = __expf(tot);
        __syncthreads();
        { const int kt = wave >> 1, vt = wave & 1;
          f32x16 acc;
#pragma unroll
          for (int r = 0; r < 16; ++r) acc[r] = 0.f;
#pragma unroll
          for (int ks = 0; ks < 4; ++ks) { const s16x8 A = *(const LAS s16x8*)(KDT + (32 * kt + r32) * HG_P + (16 * ks + 8 * hi) * 2);
              const s16x8 B = *(const LAS s16x8*)(VT + (32 * vt + r32) * HG_P + (16 * ks + 8 * hi) * 2);
              acc = __builtin_amdgcn_mfma_f32_32x32x16_bf16(A, B, acc, 0, 0, 0); }
          bf16* up = UTB + (size_t)unit * 8192 + (32 * vt + r32) * 128 + 32 * kt + 4 * hi;
#pragma unroll
          for (int rg = 0; rg < 4; ++rg) { u32x2 w; w.x = pg8::cvt_pk_bf16(acc[4 * rg], acc[4 * rg + 1]); w.y = pg8::cvt_pk_bf16(acc[4 * rg + 2], acc[4 * rg + 3]); *(u32x2*)(up + 8 * rg) = w; } }
        __syncthreads();
    }
}
__device__ __forceinline__ void phase_hgrn_scan2(Frame& F) {
    PHASE_TID();
    bf16* UTB = (bf16*)(F.ws + WS_UT); const float* DD = (const float*)(F.ws + WS_DD);
    for (int e = F.bid * NTHR + tid; e < BATCH * HG_H * 8192; e += F.G * NTHR) {
        const int bh = e >> 13, vk = e & 8191, k = vk & 127;
        float s = 0.f;
        bf16* up = UTB + (size_t)bh * HG_NC * 8192 + vk; const float* dp = DD + (size_t)bh * HG_NC * 128 + k;
        for (int c = 0; c < HG_NC; c += 8) {
            float u[8], d[8];
#pragma unroll
            for (int i = 0; i < 8; ++i) { u[i] = bf2f(up[(size_t)(c + i) * 8192]); d[i] = dp[(size_t)(c + i) * 128]; }
#pragma unroll
            for (int i = 0; i < 8; ++i) { up[(size_t)(c + i) * 8192] = (bf16)f2bf(s); s = d[i] * s + u[i]; }
        }
    }
}
__device__ __forceinline__ void phase_hgrn_c2(Frame& F, int l) {
    PHASE_TID();
    LAS unsigned char* QA = F.lds; LAS unsigned char* KB = F.lds + 17408; LAS unsigned char* QE = F.lds + 34816; LAS unsigned char* VT = F.lds + 52224; LAS float* QT = (LAS float*)(F.lds + 61440);
    const bf16* main_ = (const bf16*)(F.ws + WS_BIG); const bf16* UTB = (const bf16*)(F.ws + WS_UT); bf16* FH = (bf16*)(F.ws + WS_FH);
    const float* nw = F.in[11] + (size_t)l * HG_DV;
    const int k = tid & 127, tq = tid >> 7, r32 = lane & 31, hi = lane >> 5;
    for (int unit = F.bid; unit < BATCH * HG_H * HG_NC; unit += F.G) {
        const int c = unit & (HG_NC - 1), bh = unit >> 8, h = bh & 7, b = bh >> 3;
        const size_t row0 = (size_t)b * SEQ + (size_t)c * HG_C;
        const float lb = hgrn_lb(F.in[10], l, h * HG_DK + k), lbe = fmaxf(lb, 1e-20f);
        float a[16], kc[16], q[16]; float run = 0.f;
#pragma unroll
        for (int tt = 0; tt < 16; ++tt) { const bf16* rp = main_ + (row0 + tq * 16 + tt) * N_MAIN + h * HG_DK + k;
            const float z = bf2f(rp[C_RF]), qv = bf2f(rp[C_RQ]);
            const float sg = sigm(z); run += __logf(lbe + (1.0f - lbe) * sg); a[tt] = run; kc[tt] = (1.0f - lb) * (1.0f - sg); q[tt] = qv * sigm(qv); }
        QT[tq * 128 + k] = run;
        hg_stage_vt(main_, row0, h, VT, tid);
        __syncthreads();
        float off = 0.f; const float aref = QT[k] + QT[128 + k];
#pragma unroll
        for (int qq = 0; qq < 3; ++qq) { if (qq < tq) off += QT[qq * 128 + k]; }
#pragma unroll
        for (int tt = 0; tt < 16; ++tt) { const int t = tq * 16 + tt; const float at = off + a[tt];
            *(LAS unsigned short*)(QA + t * HG_PK + k * 2) = (unsigned short)f2bf(q[tt] * __expf(at - aref));
            *(LAS unsigned short*)(KB + t * HG_PK + k * 2) = (unsigned short)f2bf(kc[tt] * __expf(aref - at));
            *(LAS unsigned short*)(QE + t * HG_PK + k * 2) = (unsigned short)f2bf(q[tt] * __expf(at)); }
        __syncthreads();
        if (wave < 2) {
            const int tt_ = wave;
            f32x16 O0, O1;
#pragma unroll
            for (int r = 0; r < 16; ++r) { O0[r] = 0.f; O1[r] = 0.f; }
#pragma unroll
            for (int st = 0; st < 2; ++st) {
                if (st <= tt_) {
                    f32x16 acc;
#pragma unroll
                    for (int r = 0; r < 16; ++r) acc[r] = 0.f;
#pragma unroll
                    for (int ks = 0; ks < 8; ++ks) { const s16x8 A = *(const LAS s16x8*)(KB + (32 * st + r32) * HG_PK + (16 * ks + 8 * hi) * 2);
                        const s16x8 B = *(const LAS s16x8*)(QA + (32 * tt_ + r32) * HG_PK + (16 * ks + 8 * hi) * 2);
                        acc = __builtin_amdgcn_mfma_f32_32x32x16_bf16(A, B, acc, 0, 0, 0); }
                    if (st == tt_) {
#pragma unroll
                        for (int r = 0; r < 16; ++r) { if ((r & 3) + 8 * (r >> 2) + 4 * hi > r32) acc[r] = 0.f; } }
#pragma unroll
                    for (int s2 = 0; s2 < 2; ++s2) {
                        v4u pw; pw.x = pg8::cvt_pk_bf16(acc[8 * s2 + 0], acc[8 * s2 + 1]); pw.y = pg8::cvt_pk_bf16(acc[8 * s2 + 2], acc[8 * s2 + 3]);
                        pw.z = pg8::cvt_pk_bf16(acc[8 * s2 + 4], acc[8 * s2 + 5]); pw.w = pg8::cvt_pk_bf16(acc[8 * s2 + 6], acc[8 * s2 + 7]);
                        const s16x8 pf = __builtin_bit_cast(s16x8, pw);
                        const int kb = (32 * st + 16 * s2 + 4 * hi) * 2;
                        { const s16x4 lo = *(const LAS s16x4*)(VT + r32 * HG_P + kb), hh = *(const LAS s16x4*)(VT + r32 * HG_P + kb + 16);
                          O0 = __builtin_amdgcn_mfma_f32_32x32x16_bf16(__builtin_shufflevector(lo, hh, 0, 1, 2, 3, 4, 5, 6, 7), pf, O0, 0, 0, 0); }
                        { const s16x4 lo = *(const LAS s16x4*)(VT + (32 + r32) * HG_P + kb), hh = *(const LAS s16x4*)(VT + (32 + r32) * HG_P + kb + 16);
                          O1 = __builtin_amdgcn_mfma_f32_32x32x16_bf16(__builtin_shufflevector(lo, hh, 0, 1, 2, 3, 4, 5, 6, 7), pf, O1, 0, 0, 0); }
                    }
                }
            }
            const bf16* sp = UTB + (size_t)unit * 8192 + r32 * 128 + 8 * hi;
#pragma unroll
            for (int ks = 0; ks < 8; ++ks) { const s16x8 B = *(const LAS s16x8*)(QE + (32 * tt_ + r32) * HG_PK + (16 * ks + 8 * hi) * 2);
                const s16x8 A0 = *(const s16x8*)(sp + 16 * ks), A1 = *(const s16x8*)(sp + 32 * 128 + 16 * ks);
                O0 = __builtin_amdgcn_mfma_f32_32x32x16_bf16(A0, B, O0, 0, 0, 0); O1 = __builtin_amdgcn_mfma_f32_32x32x16_bf16(A1, B, O1, 0, 0, 0); }
            float ss = 0.f;
#pragma unroll
            for (int r = 0; r < 16; ++r) ss += O0[r] * O0[r] + O1[r] * O1[r];
            ss += __shfl_xor(ss, 32);
            const float rstd = 1.0f / sqrtf(ss * (1.0f / HG_DV) + NORM_EPS);
            const size_t row = row0 + 32 * tt_ + r32;
#pragma unroll
            for (int rg = 0; rg < 4; ++rg) {
#pragma unroll
                for (int vt = 0; vt < 2; ++vt) { const int v = 32 * vt + 8 * rg + 4 * hi;
                    const u32x2 gw = *(const u32x2*)(main_ + row * N_MAIN + C_RG + h * HG_DV + v); const f32x4 nv = *(const f32x4*)(nw + v);
                    const float g0 = blo(gw.x), g1 = bhi(gw.x), g2 = blo(gw.y), g3 = bhi(gw.y);
                    const float o0 = (vt ? O1[4 * rg] : O0[4 * rg]) * rstd * nv.x * g0 * sigm(g0), o1 = (vt ? O1[4 * rg + 1] : O0[4 * rg + 1]) * rstd * nv.y * g1 * sigm(g1);
                    const float o2 = (vt ? O1[4 * rg + 2] : O0[4 * rg + 2]) * rstd * nv.z * g2 * sigm(g2), o3 = (vt ? O1[4 * rg + 3] : O0[4 * rg + 3]) * rstd * nv.w * g3 * sigm(g3);
                    u32x2 w; w.x = pg8::cvt_pk_bf16(o0, o1); w.y = pg8::cvt_pk_bf16(o2, o3);
                    *(u32x2*)(FH + row * 512 + h * HG_DV + v) = w; } }
        }
        __syncthreads();
    }
}

#if MK_CHECK
constexpr int CW_CHK = 64;
__device__ __forceinline__ float bfr(float f) { return __uint_as_float(f2bf(f) << 16); }
__device__ __forceinline__ float dot_ar_wc(const bf16* arow, const float* W, int K, int N, int c) {
    float s = 0.f;
#pragma unroll 8
    for (int k = 0; k < K; ++k) s += bf2f(arow[k]) * bfr(W[(size_t)k * N + c]);
    return s;
}
__device__ __forceinline__ bool chk_bad(float got, float ref) { return !(fabsf(got - ref) <= 0.04f + 0.03f * fabsf(ref)); }
__device__ __forceinline__ void chk_report(Frame& F, int ph, bool fail) { if (fail) atomicMax((unsigned*)(F.ws + WS_CTL) + CW_CHK, (unsigned)(NPHASES - ph)); }
__device__ __forceinline__ void chk_rc(int tid, int ph, int N, int& r, int& c) {
    unsigned h1 = ((unsigned)tid + 1u) * 2654435761u + (unsigned)ph * 40503u; h1 ^= h1 >> 15; h1 *= 0x85ebca6bu; h1 ^= h1 >> 13;
    unsigned h2 = ((unsigned)tid + 77u) * 0x9E3779B1u + (unsigned)ph * 7919u; h2 ^= h2 >> 16; h2 *= 0xc2b2ae35u; h2 ^= h2 >> 13;
    r = (int)(h1 % (unsigned)M); c = (int)(h2 % (unsigned)N);
    if (tid == 0) r = 0; if (tid == 1) r = M - 1; if (tid == 2) r = SEQ - 1; if (tid == 3) r = SEQ; if (tid == 4) r = M - 300; if (tid == 5) r = 31500;
}
__device__ __forceinline__ float chk_rstd_bf(const bf16* row) { float ss = 0.f; for (int k = 0; k < D_MODEL; ++k) { const float v = bf2f(row[k]); ss += v * v; } return 1.0f / sqrtf(ss * (1.0f / D_MODEL) + NORM_EPS); }
__device__ __forceinline__ float chk_rstd_f(const float* row) { float ss = 0.f; for (int k = 0; k < D_MODEL; ++k) { const float v = row[k]; ss += v * v; } return 1.0f / sqrtf(ss * (1.0f / D_MODEL) + NORM_EPS); }
__device__ __forceinline__ void chk_xn(Frame& F, int ph, const float* x, const float* w) {
    PHASE_TID(); int r, c; chk_rc(tid, ph, D_MODEL, r, c);
    const float ref = x[(size_t)r * D_MODEL + c] * chk_rstd_f(x + (size_t)r * D_MODEL) * w[c];
    chk_report(F, ph, chk_bad(bf2f(((const bf16*)(F.ws + WS_XN))[(size_t)r * D_MODEL + c]), ref));
}
__device__ __forceinline__ void chk_gu(Frame& F, int ph, const float* Wgu) {
    PHASE_TID(); int r, j; chk_rc(tid, ph, D_FF, r, j);
    const bf16* a = (const bf16*)(F.ws + WS_XN) + (size_t)r * D_MODEL;
    const float g = dot_ar_wc(a, Wgu, D_MODEL, 2 * D_FF, j), u = dot_ar_wc(a, Wgu, D_MODEL, 2 * D_FF, D_FF + j);
    chk_report(F, ph, chk_bad(bf2f(((const bf16*)(F.ws + WS_BIG))[(size_t)r * D_FF + j]), g * sigm(g) * u));
}
__device__ __forceinline__ void chk_plain(Frame& F, int ph, const bf16* A, int K, const float* W, int NW, int coff, const bf16* OUT, int N, int act) {
    PHASE_TID(); int r, c; chk_rc(tid, ph, N, r, c);
    float ref = dot_ar_wc(A + (size_t)r * K, W, K, NW, coff + c); if (act == 2) ref = sigm(ref);
    chk_report(F, ph, chk_bad(bf2f(OUT[(size_t)r * N + c]), ref));
}
__device__ __forceinline__ void chk_norm(Frame& F, int ph, const float* xin, float alpha, const float* wpost, const float* wpre) {
    PHASE_TID(); int r, c; chk_rc(tid, ph, D_MODEL, r, c);
    const float* xo = F.out + (size_t)r * D_MODEL; bool fail = false;
    { const bf16* y = (const bf16*)(F.ws + WS_Y) + (size_t)r * D_MODEL;
        const float xi = xin ? xin[(size_t)r * D_MODEL + c] : ((const float*)(F.ws + WS_END))[tid];
        const float ref = xi + alpha * bf2f(y[c]) * chk_rstd_bf(y) * wpost[c]; fail = !(fabsf(xo[c] - ref) <= 0.01f + 0.01f * fabsf(ref)); }
    if (wpre) { const float ref = xo[c] * chk_rstd_f(xo) * wpre[c]; fail = fail || chk_bad(bf2f(((const bf16*)(F.ws + WS_XN))[(size_t)r * D_MODEL + c]), ref); }
    chk_report(F, ph, fail);
}
__device__ __forceinline__ void chk_save(Frame& F, int ph) {
    PHASE_TID(); int r, c; chk_rc(tid, ph, D_MODEL, r, c);
    ((float*)(F.ws + WS_END))[tid] = F.out[(size_t)r * D_MODEL + c];
}
__device__ __forceinline__ void chk_conv(Frame& F, int ph, int l) {
    PHASE_TID(); int r, c; chk_rc(tid, ph, CONV_WIDTH, r, c);
    const bf16* mn = (const bf16*)(F.ws + WS_BIG); const float* cw = F.in[8] + (size_t)l * 3 * CONV_WIDTH; const int t = r & (SEQ - 1);
    float y = 0.f;
    for (int j = 0; j < 3; ++j) if (t - j >= 0) { const bf16* rp = mn + (size_t)(r - j) * N_MAIN; y += cw[(2 - j) * CONV_WIDTH + c] * bf2f(rp[C_CC + c]) * bf2f(rp[C_CX + c]); }
    const float ref = bf2f(mn[(size_t)r * N_MAIN + C_CB + c]) * y;
    chk_report(F, ph, chk_bad(bf2f(((const bf16*)(F.ws + WS_FC))[(size_t)r * CONV_WIDTH + c]), ref));
}
__device__ __forceinline__ void chk_attn(Frame& F, int ph, int l) {
    PHASE_TID(); int r, c; chk_rc(tid, ph, 1024, r, c);
    const bf16* mn = (const bf16*)(F.ws + WS_BIG); const int h = c >> 6, d = c & 63, hk = h >> 3, t = r & (SEQ - 1);
    const float slope = exp2f(-0.5f * (float)(h + 1)), sink = F.in[9][l * NHEAD + h];
    const bf16* qp = mn + (size_t)r * N_MAIN + C_AQ + h * 64; const int jmax = t < 127 ? t : 127;
    float mx = sink;
    for (int j = 0; j <= jmax; ++j) { const bf16* kp = mn + (size_t)(r - j) * N_MAIN + C_AK + hk * 64; float s = 0.f; for (int e = 0; e < 64; ++e) s += bf2f(qp[e]) * bf2f(kp[e]); s = s * 0.125f - slope * (float)j; mx = fmaxf(mx, s); }
    float den = expf(sink - mx), acc = 0.f;
    for (int j = 0; j <= jmax; ++j) { const bf16* kp = mn + (size_t)(r - j) * N_MAIN + C_AK + hk * 64; float s = 0.f; for (int e = 0; e < 64; ++e) s += bf2f(qp[e]) * bf2f(kp[e]); s = s * 0.125f - slope * (float)j;
        const float p = expf(s - mx); den += p; acc += p * bf2f(mn[(size_t)(r - j) * N_MAIN + C_AV + hk * 64 + d]); }
    chk_report(F, ph, chk_bad(bf2f(((const bf16*)(F.ws + WS_FA))[(size_t)r * 1024 + c]), acc / den));
}
__device__ __forceinline__ void chk_hgrn(Frame& F, int ph, int l, int b, int h, int c0) {
    PHASE_TID();
    LAS float* L = (LAS float*)F.lds; LAS float* S = L; LAS float* PO = L + 8192;
    const bf16* mn = (const bf16*)(F.ws + WS_BIG); const bf16* FH = (const bf16*)(F.ws + WS_FH);
    const int v = tid & 63, kg = tid >> 6;
    for (int kk = 0; kk < 16; ++kk) { const int k = kg * 16 + kk; S[k * 64 + v] = c0 ? bf2f(((const bf16*)(F.ws + WS_UT))[(size_t)(((b * HG_H + h) << 8) + c0) * 8192 + v * 128 + k]) : 0.f; }
    __syncthreads();
    bool fail = false;
    for (int t = 0; t < 200; ++t) {
        const size_t row = (size_t)b * SEQ + (size_t)c0 * HG_C + t; const bf16* rp = mn + row * N_MAIN;
        const float iv = bf2f(rp[C_RI + h * 64 + v]); float po = 0.f;
        for (int kk = 0; kk < 16; ++kk) { const int k = kg * 16 + kk;
            const float lb = hgrn_lb(F.in[10], l, h * HG_DK + k), lbe = fmaxf(lb, 1e-20f);
            const float z = bf2f(rp[C_RF + h * HG_DK + k]), sg = 1.0f / (1.0f + expf(-z));
            const float f = lbe + (1.0f - lbe) * sg, kc = (1.0f - lb) * (1.0f - sg);
            const float qr = bf2f(rp[C_RQ + h * HG_DK + k]), qv = qr / (1.0f + expf(-qr));
            const float s = f * S[k * 64 + v] + kc * iv; S[k * 64 + v] = s; po += s * qv; }
        PO[kg * 64 + v] = po;
        __syncthreads();
        if (tid < 64) { float o = 0.f; for (int q = 0; q < 8; ++q) o += PO[q * 64 + tid];
            const float ss = wave_sum(o * o); const float gv = bf2f(rp[C_RG + h * 64 + tid]);
            const float ref = o * (1.0f / sqrtf(ss * (1.0f / 64.0f) + NORM_EPS)) * F.in[11][l * HG_DV + tid] * gv / (1.0f + expf(-gv));
            fail = fail || chk_bad(bf2f(FH[row * 512 + h * 64 + tid]), ref); }
        __syncthreads();
    }
    chk_report(F, ph, fail);
}
__device__ __forceinline__ void chk_merge(Frame& F, int ph, int l) {
    PHASE_TID(); int r, c; chk_rc(tid, ph, D_MODEL, r, c);
    const bf16* G = (const bf16*)(F.ws + WS_BIG) + (size_t)r * N_GATES;
    const float y0 = dot_ar_wc((const bf16*)(F.ws + WS_FC) + (size_t)r * 512, F.in[12] + (size_t)l * 512 * D_MODEL, 512, D_MODEL, c);
    const float y1 = dot_ar_wc((const bf16*)(F.ws + WS_FA) + (size_t)r * 1024, F.in[13] + (size_t)l * 1024 * D_MODEL, 1024, D_MODEL, c);
    const float y2 = dot_ar_wc((const bf16*)(F.ws + WS_FH) + (size_t)r * 512, F.in[14] + (size_t)l * 512 * D_MODEL, 512, D_MODEL, c);
    const float ref = bf2f(G[c]) * y0 + bf2f(G[D_MODEL + c]) * y1 + bf2f(G[2 * D_MODEL + c]) * y2;
    chk_report(F, ph, chk_bad(bf2f(((const bf16*)(F.ws + WS_XN))[(size_t)r * D_MODEL + c]), ref));
}
__device__ __forceinline__ void chk_ple(Frame& F, int ph, int l) {
    PHASE_TID(); int r, c; chk_rc(tid, ph, D_MODEL, r, c);
    const float y = dot_ar_wc((const bf16*)(F.ws + WS_PB) + (size_t)r * PLE_DIM, F.in[23] + (size_t)l * PLE_DIM * D_MODEL, PLE_DIM, D_MODEL, c);
    const float ref = bf2f(((const bf16*)(F.ws + WS_BIG))[(size_t)r * D_MODEL + c]) * y;
    chk_report(F, ph, chk_bad(bf2f(((const bf16*)(F.ws + WS_Y))[(size_t)r * D_MODEL + c]), ref));
}
#endif

__global__ void __launch_bounds__(NTHR, 2) fwd(Args args) {
    extern __shared__ __attribute__((aligned(16))) unsigned char lds[];
    Frame F;
    F.lds = (LAS unsigned char*)lds;
    F.G = gridDim.x; F.bid = blockIdx.x; F.in = args.in; F.out = args.out; F.ws = args.ws;
    unsigned char* ws = args.ws;
    volatile LAS unsigned* MISC = (volatile LAS unsigned*)(F.lds + MISC_OFF);
    if (threadIdx.x < 32) MISC[threadIdx.x] = 0u;
    __syncthreads();
#if MK_ONE_LAUNCH
    XcdBarrier bar = xcd_barrier_post((unsigned*)(ws + WS_CTL) + CW_BAR, MISC + 8);
#define GRID_BAR() xcd_barrier(bar)
#else
#define GRID_BAR() do {} while (0)
#endif
    const int lo = args.ph_lo, hi = args.ph_hi;
#define IN(k) (lo <= (k) && (k) < hi)
#if MK_CHECK
#define SEAM(k) do { if (IN(k)) GRID_BAR(); } while (0)
#define CHK(k, stmt) do { if (IN(k)) { if (F.bid == 0) { stmt; } GRID_BAR(); } } while (0)
#define CHKSAVE(k) do { if (F.bid == 0) chk_save(F, (k)); GRID_BAR(); } while (0)
#else
#define CHKSAVE(k) do {} while (0)
#define SEAM(k) do { if (IN(k) && IN((k) + 1)) GRID_BAR(); } while (0)
#define CHK(k, stmt) do {} while (0)
#endif
    bf16* XN = (bf16*)(ws + WS_XN); bf16* Y = (bf16*)(ws + WS_Y); bf16* BIG = (bf16*)(ws + WS_BIG);
    using pg8::Gemm; using pg8::StaticOrder;

    for (int l = 0; l < DEPTH; ++l) {
        const int P = l * NPH;
        const float* in_x = (l == 0) ? F.in[0] : F.out;
        if (IN(P + 0)) { phase_convert(F, l); } SEAM(P + 0); CHK(P + 0, if (l == 0) chk_xn(F, P + 0, F.in[0], F.in[2]));
        if (IN(P + 1)) { Gemm g{XN, (const bf16*)(ws + WS_GU1), M, 2 * D_FF, D_MODEL}; StaticOrder S; S.init(M, 2 * D_FF, F.G, F.bid);
            pg8::EpiSwiglu E{BIG, D_FF}; pg8::gemm_phase<pg8::EpiSwiglu, StaticOrder, PG8_ALIGN, PG8_SP2>(F.lds, g, S, E); } SEAM(P + 1); CHK(P + 1, chk_gu(F, P + 1, F.in[3] + (size_t)l * D_MODEL * 2 * D_FF));
        if (IN(P + 2)) { Gemm g{BIG, (const bf16*)(ws + WS_D1), M, D_MODEL, D_FF}; StaticOrder S; S.init(M, D_MODEL, F.G, F.bid);
            pg8::EpiBf16<0> E{Y, D_MODEL}; pg8::gemm_phase<pg8::EpiBf16<0>, StaticOrder, PG8_ALIGN, PG8_SP2>(F.lds, g, S, E); } SEAM(P + 2); CHK(P + 2, chk_plain(F, P + 2, BIG, D_FF, F.in[4] + (size_t)l * D_FF * D_MODEL, D_MODEL, 0, Y, D_MODEL, 0));
        if (IN(P + 3)) { if (l > 0) { CHKSAVE(P + 3); } phase_norm(F, in_x, 0.5f, F.in[5] + l * D_MODEL, F.in[6] + l * D_MODEL, P + 3); } SEAM(P + 3); CHK(P + 3, chk_norm(F, P + 3, (l == 0) ? F.in[0] : nullptr, 0.5f, F.in[5] + l * D_MODEL, F.in[6] + l * D_MODEL));
        if (IN(P + 4)) { Gemm g{XN, (const bf16*)(ws + WS_WIN), M, N_MAIN, D_MODEL}; StaticOrder S; S.init(M, N_MAIN, F.G, F.bid);
            pg8::EpiBf16<0> E{BIG, N_MAIN}; pg8::gemm_phase<pg8::EpiBf16<0>, StaticOrder, PG8_ALIGN, PG8_SP2>(F.lds, g, S, E); } SEAM(P + 4); CHK(P + 4, chk_plain(F, P + 4, XN, D_MODEL, F.in[7] + (size_t)l * D_MODEL * D_IN, D_IN, 0, BIG, N_MAIN, 0));
        if (IN(P + 5)) { phase_conv(F, l); phase_attn_mfma(F, l); phase_hgrn_a2(F, l); } SEAM(P + 5); CHK(P + 5, chk_conv(F, P + 5, l); chk_attn(F, P + 5, l));
        if (IN(P + 6)) { phase_hgrn_scan2(F); } SEAM(P + 6);
        if (IN(P + 7)) { phase_hgrn_c2(F, l); } SEAM(P + 7); CHK(P + 7, chk_hgrn(F, P + 7, l, 1, 5, 0); chk_hgrn(F, P + 7, l, 0, 2, 100); chk_hgrn(F, P + 7, l, 1, 7, 252));
        if (IN(P + 8)) { Gemm g{XN, (const bf16*)(ws + WS_WIN) + (size_t)N_MAIN * D_MODEL, M, N_GATES, D_MODEL}; StaticOrder S; S.init(M, N_GATES, F.G, F.bid);
            pg8::EpiBf16<2> E{BIG, N_GATES}; pg8::gemm_phase<pg8::EpiBf16<2>, StaticOrder, PG8_ALIGN, PG8_SP2>(F.lds, g, S, E); } SEAM(P + 8); CHK(P + 8, chk_plain(F, P + 8, XN, D_MODEL, F.in[7] + (size_t)l * D_MODEL * D_IN, D_IN, N_MAIN, BIG, N_GATES, 2));
        if (IN(P + 9)) {
            StaticOrder S; S.init(M, D_MODEL, F.G, F.bid);
            { Gemm g{(const bf16*)(ws + WS_FC), (const bf16*)(ws + WS_BC), M, D_MODEL, CONV_WIDTH};
              pg8::EpiGateMul E{BIG, N_GATES, XN, D_MODEL, 0}; pg8::gemm_phase<pg8::EpiGateMul, StaticOrder, PG8_ALIGN, PG8_SP2>(F.lds, g, S, E); }
            { Gemm g{(const bf16*)(ws + WS_FA), (const bf16*)(ws + WS_BA), M, D_MODEL, 1024};
              pg8::EpiGateMul E{BIG + D_MODEL, N_GATES, XN, D_MODEL, 1}; pg8::gemm_phase<pg8::EpiGateMul, StaticOrder, PG8_ALIGN, PG8_SP2>(F.lds, g, S, E); }
            { Gemm g{(const bf16*)(ws + WS_FH), (const bf16*)(ws + WS_BH), M, D_MODEL, 512};
              pg8::EpiGateMul E{BIG + 2 * D_MODEL, N_GATES, XN, D_MODEL, 1}; pg8::gemm_phase<pg8::EpiGateMul, StaticOrder, PG8_ALIGN, PG8_SP2>(F.lds, g, S, E); }
        } SEAM(P + 9); CHK(P + 9, chk_merge(F, P + 9, l));
        if (IN(P + 10)) { Gemm g{XN, (const bf16*)(ws + WS_WO), M, D_MODEL, D_MODEL}; StaticOrder S; S.init(M, D_MODEL, F.G, F.bid);
            pg8::EpiBf16<0> E{Y, D_MODEL}; pg8::gemm_phase<pg8::EpiBf16<0>, StaticOrder, PG8_ALIGN, PG8_SP2>(F.lds, g, S, E); } SEAM(P + 10); CHK(P + 10, chk_plain(F, P + 10, XN, D_MODEL, F.in[15] + (size_t)l * D_MODEL * D_MODEL, D_MODEL, 0, Y, D_MODEL, 0));
        if (IN(P + 11)) { CHKSAVE(P + 11); phase_norm(F, F.out, 1.0f, F.in[16] + l * D_MODEL, F.in[17] + l * D_MODEL, P + 11); } SEAM(P + 11); CHK(P + 11, chk_norm(F, P + 11, nullptr, 1.0f, F.in[16] + l * D_MODEL, F.in[17] + l * D_MODEL));
        if (IN(P + 12)) { Gemm g{XN, (const bf16*)(ws + WS_GU2), M, 2 * D_FF, D_MODEL}; StaticOrder S; S.init(M, 2 * D_FF, F.G, F.bid);
            pg8::EpiSwiglu E{BIG, D_FF}; pg8::gemm_phase<pg8::EpiSwiglu, StaticOrder, PG8_ALIGN, PG8_SP2>(F.lds, g, S, E); } SEAM(P + 12); CHK(P + 12, chk_gu(F, P + 12, F.in[18] + (size_t)l * D_MODEL * 2 * D_FF));
        if (IN(P + 13)) { Gemm g{BIG, (const bf16*)(ws + WS_D2), M, D_MODEL, D_FF}; StaticOrder S; S.init(M, D_MODEL, F.G, F.bid);
            pg8::EpiBf16<0> E{Y, D_MODEL}; pg8::gemm_phase<pg8::EpiBf16<0>, StaticOrder, PG8_ALIGN, PG8_SP2>(F.lds, g, S, E); } SEAM(P + 13); CHK(P + 13, chk_plain(F, P + 13, BIG, D_FF, F.in[19] + (size_t)l * D_FF * D_MODEL, D_MODEL, 0, Y, D_MODEL, 0));
        if (IN(P + 14)) { CHKSAVE(P + 14); phase_norm(F, F.out, 0.5f, F.in[20] + l * D_MODEL, F.in[21] + l * D_MODEL, P + 14); } SEAM(P + 14); CHK(P + 14, chk_norm(F, P + 14, nullptr, 0.5f, F.in[20] + l * D_MODEL, F.in[21] + l * D_MODEL));
        if (IN(P + 15)) { Gemm g{XN, (const bf16*)(ws + WS_PG), M, D_MODEL, D_MODEL}; StaticOrder S; S.init(M, D_MODEL, F.G, F.bid);
            pg8::EpiBf16<2> E{BIG, D_MODEL}; pg8::gemm_phase<pg8::EpiBf16<2>, StaticOrder, PG8_ALIGN, PG8_SP2>(F.lds, g, S, E); } SEAM(P + 15); CHK(P + 15, chk_plain(F, P + 15, XN, D_MODEL, F.in[22] + (size_t)l * D_MODEL * D_MODEL, D_MODEL, 0, BIG, D_MODEL, 2));
        if (IN(P + 16)) { Gemm g{(const bf16*)(ws + WS_PB), (const bf16*)(ws + WS_PP), M, D_MODEL, PLE_DIM}; StaticOrder S; S.init(M, D_MODEL, F.G, F.bid);
            pg8::EpiGateMul E{BIG, D_MODEL, Y, D_MODEL, 0}; pg8::gemm_phase<pg8::EpiGateMul, StaticOrder, PG8_ALIGN, PG8_SP2>(F.lds, g, S, E); } SEAM(P + 16); CHK(P + 16, chk_ple(F, P + 16, l));
        if (IN(P + 17)) { CHKSAVE(P + 17); phase_norm(F, F.out, 1.0f, F.in[24] + l * D_MODEL, (l + 1 < DEPTH) ? F.in[2] + (l + 1) * D_MODEL : nullptr, P + 17); } SEAM(P + 17); CHK(P + 17, chk_norm(F, P + 17, nullptr, 1.0f, F.in[24] + l * D_MODEL, (l + 1 < DEPTH) ? F.in[2] + (l + 1) * D_MODEL : nullptr));
    }
#if MK_CHECK
    if (F.bid == 0 && threadIdx.x == 0) { const unsigned v = __hip_atomic_load((unsigned*)(ws + WS_CTL) + CW_CHK, __ATOMIC_RELAXED, __HIP_MEMORY_SCOPE_AGENT); if (v) F.out[0] = 1000.0f * (float)v;
        const unsigned v2 = __hip_atomic_load((unsigned*)(ws + WS_CTL) + 65, __ATOMIC_RELAXED, __HIP_MEMORY_SCOPE_AGENT);
        if (v2 && !v) { const unsigned n = __hip_atomic_load((unsigned*)(ws + WS_CTL) + 128 + (NPHASES - v2), __ATOMIC_RELAXED, __HIP_MEMORY_SCOPE_AGENT); F.out[1] = 100.0f + (float)n; } }
#endif
#undef IN
#undef SEAM
}

extern "C" void kernel_launch(void* const* d_in, const int* in_sizes, int n_in, void* d_out, int out_size, void* d_ws, size_t ws_size, hipStream_t stream) {
    static int grid = 0;
    if (grid == 0) {
        if (n_in != 25 || in_sizes[0] != M * D_MODEL || out_size != M * D_MODEL || ws_size < WS_END) {
            fprintf(stderr, "kernel_launch: unexpected shapes (n_in %d, in0 %d, out %d, ws %zu < %zu); nothing launched\n", n_in, n_in > 0 ? in_sizes[0] : -1, out_size, ws_size, (size_t)WS_END); grid = -1; return; }
        int dev = 0, cus = 0, per_cu = 0;
        if (hipGetDevice(&dev) != hipSuccess || hipDeviceGetAttribute(&cus, hipDeviceAttributeMultiprocessorCount, dev) != hipSuccess) { grid = -1; return; }
        if (hipFuncSetAttribute((const void*)fwd, hipFuncAttributeMaxDynamicSharedMemorySize, LDS_BYTES) != hipSuccess) { fprintf(stderr, "kernel_launch: hipFuncSetAttribute failed\n"); grid = -1; return; }
        if (hipOccupancyMaxActiveBlocksPerMultiprocessor(&per_cu, (const void*)fwd, NTHR, LDS_BYTES) != hipSuccess || per_cu < 1)
            fprintf(stderr, "kernel_launch: note: occupancy query reports %d workgroups per CU\n", per_cu);
        (void)hipGetLastError();
        grid = cus;
    }
    if (grid < 0) return;
    if (hipMemsetAsync((char*)d_ws + WS_CTL, 0, CTL_ZERO_BYTES, stream) != hipSuccess) { fprintf(stderr, "kernel_launch: memset failed\n"); return; }
    Args a{};
    for (int i = 0; i < 25; ++i) a.in[i] = (const float*)d_in[i];
    a.out = (float*)d_out; a.ws = (unsigned char*)d_ws;
#if MK_ONE_LAUNCH
    a.ph_lo = 0; a.ph_hi = NPHASES;
    hipLaunchKernelGGL(fwd, dim3(grid), dim3(NTHR), LDS_BYTES, stream, a);
#else
    for (int ph = 0; ph < NPHASES; ++ph) {
        a.ph_lo = ph; a.ph_hi = ph + 1;
        hipLaunchKernelGGL(fwd, dim3(grid), dim3(NTHR), LDS_BYTES, stream, a);
    }
#endif
    const hipError_t le = hipPeekAtLastError();
    if (le != hipSuccess) fprintf(stderr, "kernel_launch: launch failed: %s\n", hipGetErrorName(le));
}
```

```cpp
#include <hip/hip_runtime.h>
#include <cstdio>
#include <cstdint>

#ifndef MK_CHECK
#define MK_CHECK 0
#endif
#ifndef REV_DOWN
#define REV_DOWN 1
#endif
#ifndef WGM_WIDE
#define WGM_WIDE 4
#endif
#ifndef WGM_NARROW
#define WGM_NARROW 4
#endif
#ifndef REP_P9
#define REP_P9 1
#endif
#ifndef MK_DUMMY
#define MK_DUMMY 0
#endif
#ifndef MK_GTIME
#define MK_GTIME 0
#endif
#ifndef GT_BASE
#define GT_BASE 10000.0f
#endif
#ifndef MK_BARTIME
#define MK_BARTIME 0
#endif
#ifndef REP_CA
#define REP_CA 1
#endif
#ifndef REP_HA
#define REP_HA 1
#endif
#ifndef REP_HC
#define REP_HC 1
#endif
#ifndef REP_BAR
#define REP_BAR 1
#endif
#ifndef REP_GEMM
#define REP_GEMM 1
#endif
#ifndef REP_NORM
#define REP_NORM 1
#endif
#ifndef REP_CONV
#define REP_CONV 1
#endif
#ifndef REP_MIX
#define REP_MIX 1
#endif
#ifndef MK_CHECK_MASK
#define MK_CHECK_MASK 0x3ffff
#endif
#ifndef MK_ONE_LAUNCH
#define MK_ONE_LAUNCH 1
#endif

namespace pg8 {
#define PG8_LAS __attribute__((address_space(3)))
typedef unsigned short bf16_t;
typedef short bf16x8 __attribute__((ext_vector_type(8)));
typedef float f32x4 __attribute__((ext_vector_type(4)));
typedef unsigned u32x4 __attribute__((ext_vector_type(4)));
constexpr int BM = 256, BK = 64, HALF = 128, HTB = HALF * BK * 2  , STAGE_BYTES = 8 * HTB, NXCD = 8;

__host__ __device__ __forceinline__ int lds_byte(int r, int c) { const int st = (r >> 4) * 2 + (c >> 5), rr = r & 15, cc = c & 31, ob = rr * 64 + cc * 2; return st * 1024 + (ob ^ (((ob >> 9) & 1) << 5)); }
__host__ __device__ __forceinline__ void stage_rc(int b, int& R, int& C) { const int st = b / 1024, sb = b % 1024, swz = sb ^ (((sb >> 9) & 1) << 5); R = (st >> 1) * 16 + swz / 64; C = (st & 1) * 32 + (swz % 64) / 2; }
__host__ __device__ __forceinline__ int perm32(int rho) { const int n = rho >> 4, i = rho & 15; return 8 * (i >> 2) + 4 * n + (i & 3); }

struct Unit { int pm, pn; };
struct Gemm { const bf16_t* A; const bf16_t* Bt; int M, N, K; };

struct StaticOrder {
    int nM, nN, nwg, G, c, rev, WGM, dummy = 0;
    __host__ __device__ void init(int M, int N, int G_, int c_, int rev_ = 0) { nM = M / BM; nN = N / BM; nwg = nM * nN; G = G_; c = c_; rev = rev_; WGM = (nN > 8) ? WGM_WIDE : WGM_NARROW; }
    __host__ __device__ bool next(int i, Unit& u) const {
        const long L = (long)i * G + c; if (L >= nwg) return false;
        int wgid = (int)L; { const int q = nwg / NXCD, r = nwg % NXCD, xcd = wgid % NXCD, off = wgid / NXCD; wgid = (xcd < r ? xcd * (q + 1) : r * (q + 1) + (xcd - r) * q) + off; }
        const int nig = WGM * nN, gid = wgid / nig, fm = gid * WGM, gsz = (nM - fm) < WGM ? (nM - fm) : WGM;
        u.pm = fm + ((wgid % nig) % gsz); u.pn = (wgid % nig) / gsz; if (rev) u.pm = nM - 1 - u.pm; if (dummy & 1) u.pm = 0; if (dummy & 2) u.pn = 0; return true;
    }
    __device__ __forceinline__ void a_ready(const Unit&) const {}
    __device__ __forceinline__ void done(const Unit&) const {}
};

typedef float f32x2_t __attribute__((ext_vector_type(2))); typedef __bf16 bf16x2_t __attribute__((ext_vector_type(2)));
__device__ __forceinline__ unsigned cvt_pk_bf16(float lo, float hi) { f32x2_t v = {lo, hi}; bf16x2_t b = __builtin_convertvector(v, bf16x2_t); return __builtin_bit_cast(unsigned, b); }
__device__ __forceinline__ float bf_lo(unsigned w) { return __uint_as_float(w << 16); }
__device__ __forceinline__ float bf_hi(unsigned w) { return __uint_as_float(w & 0xffff0000u); }
__device__ __forceinline__ float sigmoidf_(float v) { return __builtin_amdgcn_rcpf(1.0f + __builtin_amdgcn_exp2f(-1.4426950408889634f * v)); }

#ifndef EPI_NT
#define EPI_NT 1
#endif
#if EPI_NT
#define EPI_STORE16(p, v) __builtin_nontemporal_store((v), (u32x4*)(p))
#else
#define EPI_STORE16(p, v) (*(u32x4*)(p) = (v))
#endif
template <int ACT> struct EpiBf16 {
    static constexpr bool PERM = true, AFTER_DRAIN = false;
    bf16_t* O; int ldc; const float* rs;
    __device__ __forceinline__ void operator()(const f32x4 (&acc)[2][2][4][2], const Unit& u, int wr, int wc, int fr_, int fq_) const {
        (void)fr_; (void)fq_; unsigned z_ = 0u; asm volatile("" : "+s"(z_)); const int ln_ = (int)__builtin_amdgcn_mbcnt_hi(~0u, __builtin_amdgcn_mbcnt_lo(~0u, z_)), fr = ln_ & 15, fq = ln_ >> 4;
        const int row0 = u.pm * BM + wr * 64 + fr, col0 = u.pn * BM + wc * 32 + 8 * fq;
#pragma unroll
        for (int ai = 0; ai < 2; ++ai)
#pragma unroll
            for (int m = 0; m < 4; ++m) { const int row = row0 + ai * HALF + m * 16; bf16_t* rowp = O + (size_t)row * ldc + col0;
                const float sc = rs ? rs[row] : 1.0f;
#pragma unroll
                for (int bj = 0; bj < 2; ++bj) { f32x4 v0 = acc[ai][bj][m][0] * sc, v1 = acc[ai][bj][m][1] * sc;
                    if (ACT == 2) {
#pragma unroll
                        for (int e = 0; e < 4; ++e) { v0[e] = sigmoidf_(v0[e]); v1[e] = sigmoidf_(v1[e]); } }
                    u32x4 w; w.x = cvt_pk_bf16(v0[0], v0[1]); w.y = cvt_pk_bf16(v0[2], v0[3]); w.z = cvt_pk_bf16(v1[0], v1[1]); w.w = cvt_pk_bf16(v1[2], v1[3]);
                    EPI_STORE16(rowp + bj * HALF, w); } }
    }
};
struct EpiSwiglu {
    static constexpr bool PERM = true, AFTER_DRAIN = false;
    bf16_t* H; int ldh; const float* rs;
    __device__ __forceinline__ void operator()(const f32x4 (&acc)[2][2][4][2], const Unit& u, int wr, int wc, int fr_, int fq_) const {
        (void)fr_; (void)fq_; unsigned z_ = 0u; asm volatile("" : "+s"(z_)); const int ln_ = (int)__builtin_amdgcn_mbcnt_hi(~0u, __builtin_amdgcn_mbcnt_lo(~0u, z_)), fr = ln_ & 15, fq = ln_ >> 4;
        const int row0 = u.pm * BM + wr * 64 + fr, col0 = u.pn * HALF + wc * 32 + 8 * fq;
#pragma unroll
        for (int ai = 0; ai < 2; ++ai)
#pragma unroll
            for (int m = 0; m < 4; ++m) { const int row = row0 + ai * HALF + m * 16; bf16_t* rowp = H + (size_t)row * ldh + col0;
                const float sc = rs[row];
                f32x4 h0, h1;
#pragma unroll
                for (int e = 0; e < 4; ++e) { const float g0 = acc[ai][0][m][0][e] * sc, g1 = acc[ai][0][m][1][e] * sc;
                    h0[e] = g0 * sigmoidf_(g0) * (acc[ai][1][m][0][e] * sc); h1[e] = g1 * sigmoidf_(g1) * (acc[ai][1][m][1][e] * sc); }
                u32x4 w; w.x = cvt_pk_bf16(h0[0], h0[1]); w.y = cvt_pk_bf16(h0[2], h0[3]); w.z = cvt_pk_bf16(h1[0], h1[1]); w.w = cvt_pk_bf16(h1[2], h1[3]);
                EPI_STORE16(rowp, w); }
    }
};
struct EpiGateMerge {
    static constexpr bool PERM = true, AFTER_DRAIN = false;
    const bf16_t* YB; bf16_t* MG; const float* rs; size_t ystride;
    __device__ __forceinline__ void operator()(const f32x4 (&acc)[2][2][4][2], const Unit& u, int wr, int wc, int fr_, int fq_) const {
        (void)fr_; (void)fq_; unsigned z_ = 0u; asm volatile("" : "+s"(z_)); const int ln_ = (int)__builtin_amdgcn_mbcnt_hi(~0u, __builtin_amdgcn_mbcnt_lo(~0u, z_)), fr = ln_ & 15, fq = ln_ >> 4;
        const int b = u.pn >> 3, pn8 = u.pn & 7;
        const int row0 = u.pm * BM + wr * 64 + fr, col0 = pn8 * BM + wc * 32 + 8 * fq;
        const bf16_t* yb = YB + (size_t)b * ystride;
#pragma unroll
        for (int ai = 0; ai < 2; ++ai)
#pragma unroll
            for (int mp = 0; mp < 2; ++mp) {
                u32x4 yw[2][2], ow[2][2]; float sc[2];
#pragma unroll
                for (int mm = 0; mm < 2; ++mm) { const int row = row0 + ai * HALF + (2 * mp + mm) * 16; const int off = row * 2048 + col0; sc[mm] = rs[row];
#pragma unroll
                    for (int bj = 0; bj < 2; ++bj) { yw[mm][bj] = *(const u32x4*)(yb + off + bj * HALF); ow[mm][bj] = (u32x4){0u, 0u, 0u, 0u}; if (b) ow[mm][bj] = *(const u32x4*)(MG + off + bj * HALF); } }
#pragma unroll
                for (int mm = 0; mm < 2; ++mm) { const int m = 2 * mp + mm; const int row = row0 + ai * HALF + m * 16; const int off = row * 2048 + col0;
#pragma unroll
                    for (int bj = 0; bj < 2; ++bj) { const f32x4 a0 = acc[ai][bj][m][0], a1 = acc[ai][bj][m][1]; const u32x4 y = yw[mm][bj], o = ow[mm][bj]; const float s = sc[mm];
                        u32x4 w;
                        w.x = cvt_pk_bf16(fmaf(sigmoidf_(a0[0] * s), bf_lo(y.x), bf_lo(o.x)), fmaf(sigmoidf_(a0[1] * s), bf_hi(y.x), bf_hi(o.x)));
                        w.y = cvt_pk_bf16(fmaf(sigmoidf_(a0[2] * s), bf_lo(y.y), bf_lo(o.y)), fmaf(sigmoidf_(a0[3] * s), bf_hi(y.y), bf_hi(o.y)));
                        w.z = cvt_pk_bf16(fmaf(sigmoidf_(a1[0] * s), bf_lo(y.z), bf_lo(o.z)), fmaf(sigmoidf_(a1[1] * s), bf_hi(y.z), bf_hi(o.z)));
                        w.w = cvt_pk_bf16(fmaf(sigmoidf_(a1[2] * s), bf_lo(y.w), bf_lo(o.w)), fmaf(sigmoidf_(a1[3] * s), bf_hi(y.w), bf_hi(o.w)));
                        *(u32x4*)(MG + off + bj * HALF) = w; } }
                asm volatile("" ::: "memory"); }
    }
};
struct MergeOrder {
    StaticOrder base;
    __device__ bool next(int i, Unit& u) const { Unit t; if (!base.next(i / 3, t)) return false; u.pm = t.pm; u.pn = (i % 3) * 8 + t.pn; return true; }
    __device__ __forceinline__ void a_ready(const Unit&) const {}
    __device__ __forceinline__ void done(const Unit&) const {}
};
struct EpiGateMul {
    static constexpr bool PERM = true, AFTER_DRAIN = false;
    const bf16_t* G; int ldg; bf16_t* O; int ldc; int accum;
    __device__ __forceinline__ void operator()(const f32x4 (&acc)[2][2][4][2], const Unit& u, int wr, int wc, int fr_, int fq_) const {
        (void)fr_; (void)fq_; unsigned z_ = 0u; asm volatile("" : "+s"(z_)); const int ln_ = (int)__builtin_amdgcn_mbcnt_hi(~0u, __builtin_amdgcn_mbcnt_lo(~0u, z_)), fr = ln_ & 15, fq = ln_ >> 4;
        const int row0 = u.pm * BM + wr * 64 + fr, col0 = u.pn * BM + wc * 32 + 8 * fq;
#pragma unroll
        for (int ai = 0; ai < 2; ++ai)
#pragma unroll
            for (int m = 0; m < 4; ++m) { const size_t r = (size_t)(row0 + ai * HALF + m * 16);
#pragma unroll
                for (int bj = 0; bj < 2; ++bj) { const u32x4 gw = *(const u32x4*)(G + r * ldg + col0 + bj * HALF);
                    bf16_t* op = O + r * ldc + col0 + bj * HALF;
                    f32x4 v0 = acc[ai][bj][m][0], v1 = acc[ai][bj][m][1];
                    v0[0] *= bf_lo(gw.x); v0[1] *= bf_hi(gw.x); v0[2] *= bf_lo(gw.y); v0[3] *= bf_hi(gw.y);
                    v1[0] *= bf_lo(gw.z); v1[1] *= bf_hi(gw.z); v1[2] *= bf_lo(gw.w); v1[3] *= bf_hi(gw.w);
                    if (accum) { const u32x4 ow = *(const u32x4*)op;
                        v0[0] += bf_lo(ow.x); v0[1] += bf_hi(ow.x); v0[2] += bf_lo(ow.y); v0[3] += bf_hi(ow.y);
                        v1[0] += bf_lo(ow.z); v1[1] += bf_hi(ow.z); v1[2] += bf_lo(ow.w); v1[3] += bf_hi(ow.w); }
                    u32x4 w; w.x = cvt_pk_bf16(v0[0], v0[1]); w.y = cvt_pk_bf16(v0[2], v0[3]); w.z = cvt_pk_bf16(v1[0], v1[1]); w.w = cvt_pk_bf16(v1[2], v1[3]);
                    *(u32x4*)op = w; } }
    }
};

template <class Epi, class Sched, bool ALIGN_EPI = false, bool SP2 = false>
__device__ __forceinline__ void gemm_phase(PG8_LAS unsigned char* lds, const Gemm g, const Sched& S, const Epi& E, int wv) {
    unsigned z_ = 0u; asm volatile("" : "+s"(z_)); int lane_ = (int)__builtin_amdgcn_mbcnt_hi(~0u, __builtin_amdgcn_mbcnt_lo(~0u, z_)); asm volatile("" : "+v"(lane_));
    const int wid = wv, lane = lane_, tid = (wid << 6) | lane, wr = wid >> 2, wc = wid & 3, fr = lane & 15, fq = lane >> 4;
    const int K = g.K, nt = K / BK;
    unsigned voffA[2], voffB[2];
#pragma unroll
    for (int i = 0; i < 2; ++i) { int R, C; stage_rc(tid * 16 + i * 8192, R, C); const int Rb = Epi::PERM ? ((R & ~31) + perm32(R & 31)) : R;
        voffA[i] = (unsigned)(R * K + C) * 2u; voffB[i] = (unsigned)(Rb * K + C) * 2u; }
    const size_t kstep = (size_t)(BK * 2);
    const size_t hstep = (size_t)HALF * K * 2;
    const size_t tstep = 2 * hstep;
    const unsigned ldsw = (unsigned)wid * 1024u;
    const int aoff = lds_byte(wr * 64 + fr, fq * 8), boff = lds_byte(wc * 32 + fr, fq * 8);
#define PG8_SA(b, h) (((b) * 2 + (h)) * HTB)
#define PG8_SB(b, h) ((4 + (b) * 2 + (h)) * HTB)
#define PG8_STAGE(bufoff, gbase, voff) do { _Pragma("unroll") for (int _i = 0; _i < 2; ++_i) \
        __builtin_amdgcn_global_load_lds((const unsigned*)((const char*)(gbase) + (voff)[_i]), (PG8_LAS unsigned*)(lds + (bufoff) + ldsw + _i * 8192), 16, 0, 0); } while (0)
#define PG8_LDA(dst, b, h) do { _Pragma("unroll") for (int m = 0; m < 4; ++m) _Pragma("unroll") for (int k = 0; k < 2; ++k) dst[m][k] = *(const PG8_LAS bf16x8*)(lds + PG8_SA(b, h) + aoff + m * 2048 + k * 1024); } while (0)
#define PG8_LDB(dst, b, h) do { _Pragma("unroll") for (int n = 0; n < 2; ++n) _Pragma("unroll") for (int k = 0; k < 2; ++k) dst[n][k] = *(const PG8_LAS bf16x8*)(lds + PG8_SB(b, h) + boff + n * 2048 + k * 1024); } while (0)
#define PG8_MMA(ai, bj, At, Bt) do { __builtin_amdgcn_s_setprio(1); _Pragma("unroll") for (int m = 0; m < 4; ++m) _Pragma("unroll") for (int n = 0; n < 2; ++n) _Pragma("unroll") for (int k = 0; k < 2; ++k) \
        acc[ai][bj][m][n] = __builtin_amdgcn_mfma_f32_16x16x32_bf16(Bt[n][k], At[m][k], acc[ai][bj][m][n], 0, 0, 0); __builtin_amdgcn_s_setprio(0); } while (0)
#define PG8_WAIT_V(n) asm volatile("s_waitcnt vmcnt(" #n ")" ::: "memory")
#define PG8_WAIT_L(n) asm volatile("s_waitcnt lgkmcnt(" #n ")" ::: "memory")
#define PG8_BAR __builtin_amdgcn_s_barrier()
#define PG8_SCHED __builtin_amdgcn_sched_barrier(0)
    Unit cur, nxt; int ui = 0;
    if (!S.next(0, cur)) return;
    f32x4 acc[2][2][4][2];
#pragma unroll
    for (int a = 0; a < 2; ++a)
#pragma unroll
        for (int b = 0; b < 2; ++b)
#pragma unroll
            for (int m = 0; m < 4; ++m)
#pragma unroll
                for (int n = 0; n < 2; ++n) acc[a][b][m][n] = (f32x4){0.f, 0.f, 0.f, 0.f};
    bf16x8 At[4][2], B0[2][2], B1[2][2];
    const char* cA = (const char*)g.A + (size_t)cur.pm * tstep; const char* cB = (const char*)g.Bt + (size_t)cur.pn * tstep;
    S.a_ready(cur);
    if constexpr (SP2) {
        PG8_STAGE(PG8_SB(0, 0), cB, voffB); PG8_STAGE(PG8_SB(0, 1), cB + hstep, voffB); PG8_STAGE(PG8_SA(0, 0), cA, voffA); PG8_STAGE(PG8_SA(0, 1), cA + hstep, voffA);
        if (wr == 1) PG8_BAR;
        PG8_WAIT_V(2); PG8_BAR;
        PG8_STAGE(PG8_SB(1, 0), cB + kstep, voffB); PG8_STAGE(PG8_SA(1, 0), cA + kstep, voffA); PG8_STAGE(PG8_SB(1, 1), cB + hstep + kstep, voffB);
        PG8_WAIT_V(6); PG8_BAR;
    } else {
        PG8_STAGE(PG8_SB(0, 0), cB, voffB); PG8_STAGE(PG8_SA(0, 0), cA, voffA); PG8_STAGE(PG8_SB(0, 1), cB + hstep, voffB); PG8_STAGE(PG8_SA(0, 1), cA + hstep, voffA);
        if (wr == 1) PG8_BAR;
        PG8_WAIT_V(4); PG8_BAR;
        PG8_STAGE(PG8_SB(1, 0), cB + kstep, voffB); PG8_STAGE(PG8_SA(1, 0), cA + kstep, voffA); PG8_STAGE(PG8_SB(1, 1), cB + hstep + kstep, voffB);
        PG8_WAIT_V(6); PG8_BAR;
    }
    for (;;) {
        const bool has_next = S.next(ui + 1, nxt);
        const char* nA = has_next ? (const char*)g.A + (size_t)nxt.pm * tstep : cA; const char* nB = has_next ? (const char*)g.Bt + (size_t)nxt.pn * tstep : cB;
        for (int t = 0; t < nt; t += 2) {
            const bool last = (t == nt - 2);
            const char* a1 = cA + (size_t)(t + 1) * kstep;
            const char* a2 = last ? nA : cA + (size_t)(t + 2) * kstep; const char* b2 = last ? nB : cB + (size_t)(t + 2) * kstep;
            const char* a3 = a2 + kstep; const char* b3 = b2 + kstep;
            if (last && has_next) S.a_ready(nxt);
            if constexpr (SP2) {
            PG8_LDB(B0, 0, 0); PG8_LDB(B1, 0, 1); PG8_SCHED; PG8_LDA(At, 0, 0); PG8_STAGE(PG8_SA(1, 1), a1 + hstep, voffA);
            PG8_WAIT_V(8); PG8_WAIT_L(0); PG8_BAR; PG8_MMA(0, 0, At, B0); PG8_MMA(0, 1, At, B1); PG8_BAR; PG8_SCHED;
            PG8_LDA(At, 0, 1); PG8_STAGE(PG8_SB(0, 0), b2, voffB); PG8_STAGE(PG8_SB(0, 1), b2 + hstep, voffB); PG8_STAGE(PG8_SA(0, 0), a2, voffA);
            PG8_WAIT_V(8); PG8_WAIT_L(0); PG8_BAR; PG8_MMA(1, 0, At, B0); PG8_MMA(1, 1, At, B1); PG8_BAR; PG8_SCHED;
            PG8_LDB(B0, 1, 0); PG8_LDB(B1, 1, 1); PG8_SCHED; PG8_LDA(At, 1, 0); PG8_STAGE(PG8_SA(0, 1), a2 + hstep, voffA);
            PG8_WAIT_V(8); PG8_WAIT_L(0); PG8_BAR; PG8_MMA(0, 0, At, B0); PG8_MMA(0, 1, At, B1); PG8_BAR; PG8_SCHED;
            PG8_LDA(At, 1, 1); PG8_STAGE(PG8_SB(1, 0), b3, voffB); PG8_STAGE(PG8_SB(1, 1), b3 + hstep, voffB); PG8_STAGE(PG8_SA(1, 0), a3, voffA);
            PG8_WAIT_V(8); PG8_WAIT_L(0); PG8_BAR; PG8_MMA(1, 0, At, B0); PG8_MMA(1, 1, At, B1); PG8_BAR; PG8_SCHED;
            } else {
            PG8_LDB(B0, 0, 0); PG8_SCHED; PG8_LDA(At, 0, 0); PG8_STAGE(PG8_SA(1, 1), a1 + hstep, voffA);
            PG8_WAIT_L(8); PG8_BAR; PG8_WAIT_L(0); PG8_MMA(0, 0, At, B0); PG8_BAR; PG8_SCHED;
            PG8_LDB(B1, 0, 1); PG8_STAGE(PG8_SB(0, 0), b2, voffB);
            PG8_BAR; PG8_WAIT_L(0); PG8_MMA(0, 1, At, B1); PG8_BAR;
            PG8_LDA(At, 0, 1); PG8_STAGE(PG8_SA(0, 0), a2, voffA);
            PG8_BAR; PG8_WAIT_L(0); PG8_MMA(1, 0, At, B0); PG8_BAR; PG8_SCHED;
            PG8_STAGE(PG8_SB(0, 1), b2 + hstep, voffB);
            PG8_WAIT_V(6); PG8_BAR; PG8_MMA(1, 1, At, B1); PG8_BAR;
            PG8_LDB(B0, 1, 0); PG8_SCHED; PG8_LDA(At, 1, 0); PG8_STAGE(PG8_SA(0, 1), a2 + hstep, voffA);
            PG8_WAIT_L(8); PG8_BAR; PG8_WAIT_L(0); PG8_MMA(0, 0, At, B0); PG8_BAR; PG8_SCHED;
            PG8_LDB(B1, 1, 1); PG8_STAGE(PG8_SB(1, 0), b3, voffB);
            PG8_BAR; PG8_WAIT_L(0); PG8_MMA(0, 1, At, B1); PG8_BAR;
            PG8_LDA(At, 1, 1); PG8_STAGE(PG8_SA(1, 0), a3, voffA);
            PG8_BAR; PG8_WAIT_L(0); PG8_MMA(1, 0, At, B0); PG8_BAR; PG8_SCHED;
            PG8_STAGE(PG8_SB(1, 1), b3 + hstep, voffB);
            PG8_WAIT_V(6); PG8_BAR; PG8_MMA(1, 1, At, B1); PG8_BAR;
            }
        }
        if constexpr (ALIGN_EPI) { if (wr == 0) PG8_BAR; }
        if constexpr (!Epi::AFTER_DRAIN) { E(acc, cur, wr, wc, fr, fq); S.done(cur); }
        if (!has_next) break;
#pragma unroll
        for (int a = 0; a < 2; ++a)
#pragma unroll
            for (int b = 0; b < 2; ++b)
#pragma unroll
                for (int m = 0; m < 4; ++m)
#pragma unroll
                    for (int n = 0; n < 2; ++n) acc[a][b][m][n] = (f32x4){0.f, 0.f, 0.f, 0.f};
        cur = nxt; cA = nA; cB = nB; ++ui;
        if constexpr (ALIGN_EPI) { if (wr == 1) PG8_BAR; }
    }
    PG8_WAIT_V(0);
    if constexpr (!ALIGN_EPI) { if (wr == 0) PG8_BAR; }
    PG8_BAR;
#undef PG8_SA
#undef PG8_SB
#undef PG8_STAGE
#undef PG8_LDA
#undef PG8_LDB
#undef PG8_MMA
#undef PG8_WAIT_V
#undef PG8_WAIT_L
#undef PG8_BAR
#undef PG8_SCHED
}
}

#define PG8_SP2 true
#define PG8_ALIGN true

constexpr int NWAVES = 8, NTHR = NWAVES * 64;
constexpr int D_MODEL = 2048, BATCH = 2, SEQ = 16384, DEPTH = 2, PLE_DIM = 256, D_FF = 5632, CONV_WIDTH = 512;
constexpr int NHEAD = 16, NKV = 2, HEAD_DIM = 64, WINDOW = 128;
constexpr int HG_H = 8, HG_DK = 128, HG_DV = 64, HG_C = 64, HG_NC = SEQ / HG_C;
constexpr int M = BATCH * SEQ;
constexpr int D_IN = 12032, N_MAIN = 5888, N_GATES = 6144;
constexpr int C_CX = 0, C_CB = 512, C_CC = 1024, C_AQ = 1536, C_AK = 2560, C_AV = 2688, C_RQ = 2816, C_RF = 3840, C_RI = 4864, C_RG = 5376;
constexpr float NORM_EPS = 1e-6f;
constexpr int NPH = 18;
constexpr int NPHASES = DEPTH * NPH;

constexpr size_t MiB = 1u << 20;
constexpr size_t WS_CTL = 0, CTL_ZERO_BYTES = 1 * MiB;
constexpr size_t WS_GU1 = 2 * MiB, WS_D1 = 46 * MiB, WS_WIN = 68 * MiB, WS_BC = 115 * MiB, WS_BA = 117 * MiB, WS_BH = 121 * MiB, WS_WO = 123 * MiB,
                 WS_GU2 = 131 * MiB, WS_D2 = 175 * MiB, WS_PG = 197 * MiB, WS_PP = 205 * MiB, WS_PB = 206 * MiB;
constexpr size_t WS_X16 = 222 * MiB;
constexpr size_t WS_Y = 350 * MiB;
constexpr size_t WS_FC = WS_Y, WS_FA = WS_Y + 32 * MiB, WS_FH = WS_Y + 96 * MiB;
constexpr size_t WS_BIG = 478 * MiB;
constexpr size_t WS_UT = WS_BIG + 368 * MiB;
constexpr size_t WS_DD = WS_UT + 64 * MiB;
constexpr size_t WS_MG = WS_BIG + 384 * MiB;
constexpr size_t WS_RS = WS_MG + 128 * MiB;
constexpr size_t WS_END = WS_RS + 1 * MiB;
constexpr int CW_BAR = 4096;

constexpr int RING_BYTES = 131072;
constexpr int LDS_X_OFF = RING_BYTES;
constexpr int MISC_OFF = RING_BYTES + 8192;
constexpr int LDS_BYTES = 147456;

#define GAS __attribute__((address_space(1)))
#define LAS __attribute__((address_space(3)))
typedef unsigned short bf16;
typedef unsigned v4u __attribute__((ext_vector_type(4)));
typedef float f32x4 __attribute__((ext_vector_type(4)));
typedef GAS unsigned gu32;
#define LDS_WAIT() asm volatile("s_waitcnt lgkmcnt(0)" ::: "memory")
__device__ __forceinline__ unsigned f2bf(float f) { unsigned u = __builtin_bit_cast(unsigned, f); return (u + 0x7fffu + ((u >> 16) & 1u)) >> 16; }
__device__ __forceinline__ unsigned pk2(float lo, float hi) { return f2bf(lo) | (f2bf(hi) << 16); }
__device__ __forceinline__ float bf2f(bf16 b) { return __uint_as_float((unsigned)b << 16); }
__device__ __forceinline__ float blo(unsigned w) { return __uint_as_float(w << 16); }
__device__ __forceinline__ float bhi(unsigned w) { return __uint_as_float(w & 0xffff0000u); }
__device__ __forceinline__ float sigm(float v) { return __builtin_amdgcn_rcpf(1.0f + __builtin_amdgcn_exp2f(-1.4426950408889634f * v)); }

#define XB_TMO      128
#define XB_XCNT(j)  (256  + 64 * (j))
#define XB_XSUB(j)  (1280 + 64 * (j))
#define XB_XGEN(j)  (2304 + 64 * (j))
#define XB_TOP      3328
#define XB_TOPGEN   3392
#define XCD_BAR_WORDS 3456
#define XB_SPIN_CAP (1u << 18)
__device__ __forceinline__ unsigned xb_ld(unsigned* p)              { return __hip_atomic_load(p, __ATOMIC_RELAXED, __HIP_MEMORY_SCOPE_AGENT); }
__device__ __forceinline__ unsigned xb_add(unsigned* p, unsigned v) { return __hip_atomic_fetch_add(p, v, __ATOMIC_RELAXED, __HIP_MEMORY_SCOPE_AGENT); }
__device__ __forceinline__ unsigned xb_xcc_id() { return (unsigned)__builtin_amdgcn_s_getreg((3 << 11) | 20) & 0xFu; }
#define XB_SPIN(cond, bar) do { unsigned _sp = 0; while (cond) { __builtin_amdgcn_s_sleep(1); \
    if ((++_sp & 255u) == 0u) { if (xb_ld(&(bar)[XB_TMO])) break; if (_sp > XB_SPIN_CAP) { atomicAdd(&(bar)[XB_TMO], 1u); break; } } } } while (0)
struct XcdBarrier { unsigned* bar; unsigned x; volatile LAS unsigned* st; };
__device__ __forceinline__ XcdBarrier xcd_barrier_post(unsigned* bar, volatile LAS unsigned* st) {
    XcdBarrier b; b.bar = bar; b.x = xb_xcc_id(); b.st = st;
    if (threadIdx.x == 0) (void)xb_add(&bar[XB_XCNT(b.x)], 1u);
    return b;
}
__device__ __forceinline__ void xcd_barrier_complete(unsigned* bar, unsigned x, unsigned& nloc, unsigned& nx) {
    const unsigned G = gridDim.x * gridDim.y * gridDim.z;
    unsigned sum, cnt, mine, sp = 0u;
    for (;;) {
        sum = 0u; cnt = 0u; mine = 0u;
#pragma unroll
        for (unsigned j = 0; j < 16; ++j) { const unsigned c = xb_ld(&bar[XB_XCNT(j)]); sum += c; cnt += (c > 0u) ? 1u : 0u; mine = (j == x) ? c : mine; }
        if (sum == G) break;
        __builtin_amdgcn_s_sleep(1);
        if ((++sp & 255u) == 0u) { if (xb_ld(&bar[XB_TMO])) break; if (sp > XB_SPIN_CAP) { atomicAdd(&bar[XB_TMO], 1u); break; } }
    }
    nloc = mine > 0u ? mine : 1u; nx = cnt > 0u ? cnt : 1u;
}
__device__ __forceinline__ void xcd_barrier(const XcdBarrier& b) {
    asm volatile("s_waitcnt vmcnt(0)" ::: "memory");
    __syncthreads();
    if (threadIdx.x == 0) {
        unsigned* bar = b.bar;
        __builtin_amdgcn_s_waitcnt(0);
        unsigned nloc = b.st[0], nx = b.st[1];
        if (nloc == 0u) { xcd_barrier_complete(bar, b.x, nloc, nx); b.st[0] = nloc; b.st[1] = nx; }
        const unsigned old = xb_add(&bar[XB_XSUB(b.x)], 1u);
        const unsigned gen = old / nloc;
        if (old + 1u == (gen + 1u) * nloc) {
            __builtin_amdgcn_fence(__ATOMIC_RELEASE, "agent");
            asm volatile("s_waitcnt vmcnt(0)" ::: "memory");
            const unsigned og = xb_add(&bar[XB_TOP], 1u);
            const unsigned tg = og / nx;
            if (og + 1u == (tg + 1u) * nx) xb_add(&bar[XB_TOPGEN], 1u);
            else XB_SPIN(xb_ld(&bar[XB_TOPGEN]) == tg, bar);
            __builtin_amdgcn_fence(__ATOMIC_ACQUIRE, "agent");
            xb_add(&bar[XB_XGEN(b.x)], 1u);
            asm volatile("s_waitcnt vmcnt(0)" ::: "memory");
        } else {
            XB_SPIN(xb_ld(&bar[XB_XGEN(b.x)]) == gen, bar);
            __builtin_amdgcn_fence(__ATOMIC_ACQUIRE, "agent");
            asm volatile("s_waitcnt vmcnt(0)" ::: "memory");
        }
    }
    __syncthreads();
}

struct Args { const float* in[25]; float* out; unsigned char* ws; int ph_lo, ph_hi; };
struct Frame {
    LAS unsigned char* lds;
    int G, bid, wv;
    const float* const* in;
    float* out; unsigned char* ws;
};
#define PHASE_TID() unsigned z_ = 0u; asm volatile("" : "+s"(z_)); int lane_ = (int)__builtin_amdgcn_mbcnt_hi(~0u, __builtin_amdgcn_mbcnt_lo(~0u, z_)); asm volatile("" : "+v"(lane_)); const int lane = lane_, wave = F.wv, tid = (wave << 6) | lane; (void)lane; (void)wave; (void)tid
template <int MASK> __device__ __forceinline__ float swz_xor(float v) { return __int_as_float(__builtin_amdgcn_ds_swizzle(__float_as_int(v), 0x1f | (MASK << 10))); }
__device__ __forceinline__ float xor32_sum(float v) { const auto rr = __builtin_amdgcn_permlane32_swap(__float_as_uint(v), __float_as_uint(v), false, false); return __uint_as_float(rr[0]) + __uint_as_float(rr[1]); }
__device__ __forceinline__ float xor32_max(float v) { const auto rr = __builtin_amdgcn_permlane32_swap(__float_as_uint(v), __float_as_uint(v), false, false); return fmaxf(__uint_as_float(rr[0]), __uint_as_float(rr[1])); }
__device__ __forceinline__ float wave_sum(float v) {
    v += swz_xor<1>(v); v += swz_xor<2>(v); v += swz_xor<4>(v); v += swz_xor<8>(v); v += swz_xor<16>(v);
    return xor32_sum(v);
}
__device__ __forceinline__ float wave_max(float v) {
    v = fmaxf(v, swz_xor<1>(v)); v = fmaxf(v, swz_xor<2>(v)); v = fmaxf(v, swz_xor<4>(v)); v = fmaxf(v, swz_xor<8>(v)); v = fmaxf(v, swz_xor<16>(v));
    return xor32_max(v);
}

__device__ __forceinline__ void transpose_item(const float* W, int K, int N, bf16* WT, LAS float* scr, int item, int lane, bool gu, const float* gain = nullptr) {
    const int nblk = N / 32, kb = item / nblk, nb = item % nblk, k0 = 64 * kb, nd0 = 32 * nb;
    int ns0 = nd0;
    if (gu) { const int pn = nb >> 3, j = nb & 7; ns0 = ((j & 4) ? D_FF : 0) + 128 * pn + 32 * (j & 3); }
    float wv[32];
#pragma unroll
    for (int i = 0; i < 32; ++i) { const int kk = 2 * i + (lane >> 5); wv[i] = W[(size_t)(k0 + kk) * N + ns0 + (lane & 31)]; }
#pragma unroll
    for (int i = 0; i < 32; ++i) { const int kk = 2 * i + (lane >> 5); scr[kk * 33 + (lane & 31)] = wv[i] * (gain ? gain[k0 + kk] : 1.0f); }
    LDS_WAIT(); asm volatile("" ::: "memory");
    const int c = lane & 7;
#pragma unroll
    for (int j = 0; j < 4; ++j) { const int n = (lane >> 3) + 8 * j; const LAS float* s = scr + (8 * c) * 33 + n;
        v4u o; o.x = pk2(s[0 * 33], s[1 * 33]); o.y = pk2(s[2 * 33], s[3 * 33]); o.z = pk2(s[4 * 33], s[5 * 33]); o.w = pk2(s[6 * 33], s[7 * 33]);
        *(GAS v4u*)(WT + (size_t)(nd0 + n) * K + k0 + 8 * c) = o; }
    LDS_WAIT(); asm volatile("" ::: "memory");
}
__device__ __forceinline__ void x_row_to_bf16(int lane, const float* xrow, bf16* orow, float* rs) {
    float ss = 0.f;
#pragma unroll
    for (int j = 0; j < 4; ++j) { const f32x4 a = *(const f32x4*)(xrow + 8 * lane + 512 * j), b = *(const f32x4*)(xrow + 8 * lane + 512 * j + 4);
        ss += (a.x * a.x + a.y * a.y) + (a.z * a.z + a.w * a.w) + (b.x * b.x + b.y * b.y) + (b.z * b.z + b.w * b.w);
        v4u o; o.x = pk2(a.x, a.y); o.y = pk2(a.z, a.w); o.z = pk2(b.x, b.y); o.w = pk2(b.z, b.w);
        *(v4u*)(orow + 8 * lane + 512 * j) = o; }
    ss = wave_sum(ss);
    if (lane == 0) *rs = 1.0f / sqrtf(ss * (1.0f / D_MODEL) + NORM_EPS);
}

__device__ __forceinline__ void phase_convert(Frame& F, int l) {
    PHASE_TID();
    LAS float* scr = (LAS float*)(F.lds + wave * 16384);
    const int gw = F.bid * NWAVES + wave, NGW = F.G * NWAVES;
    unsigned char* ws = F.ws;
    constexpr int I_GU = (D_MODEL / 64) * (2 * D_FF / 32), I_D = (D_FF / 64) * (D_MODEL / 32), I_WIN = (D_MODEL / 64) * (D_IN / 32),
                  I_BC = (CONV_WIDTH / 64) * (D_MODEL / 32), I_BA = (1024 / 64) * (D_MODEL / 32), I_BH = (512 / 64) * (D_MODEL / 32),
                  I_SQ = (D_MODEL / 64) * (D_MODEL / 32), I_PP = (PLE_DIM / 64) * (D_MODEL / 32);
    constexpr int NITEMS = 2 * I_GU + 2 * I_D + I_WIN + I_BC + I_BA + I_BH + 2 * I_SQ + I_PP;
    for (int it = gw; it < NITEMS; it += NGW) {
        int r = it;
        if (r < I_GU) { transpose_item(F.in[3] + (size_t)l * D_MODEL * 2 * D_FF, D_MODEL, 2 * D_FF, (bf16*)(ws + WS_GU1), scr, r, lane, true, F.in[2] + l * D_MODEL); continue; } r -= I_GU;
        if (r < I_D) { transpose_item(F.in[4] + (size_t)l * D_FF * D_MODEL, D_FF, D_MODEL, (bf16*)(ws + WS_D1), scr, r, lane, false); continue; } r -= I_D;
        if (r < I_WIN) { transpose_item(F.in[7] + (size_t)l * D_MODEL * D_IN, D_MODEL, D_IN, (bf16*)(ws + WS_WIN), scr, r, lane, false, F.in[6] + l * D_MODEL); continue; } r -= I_WIN;
        if (r < I_BC) { transpose_item(F.in[12] + (size_t)l * CONV_WIDTH * D_MODEL, CONV_WIDTH, D_MODEL, (bf16*)(ws + WS_BC), scr, r, lane, false); continue; } r -= I_BC;
        if (r < I_BA) { transpose_item(F.in[13] + (size_t)l * 1024 * D_MODEL, 1024, D_MODEL, (bf16*)(ws + WS_BA), scr, r, lane, false); continue; } r -= I_BA;
        if (r < I_BH) { transpose_item(F.in[14] + (size_t)l * 512 * D_MODEL, 512, D_MODEL, (bf16*)(ws + WS_BH), scr, r, lane, false); continue; } r -= I_BH;
        if (r < I_SQ) { transpose_item(F.in[15] + (size_t)l * D_MODEL * D_MODEL, D_MODEL, D_MODEL, (bf16*)(ws + WS_WO), scr, r, lane, false); continue; } r -= I_SQ;
        if (r < I_GU) { transpose_item(F.in[18] + (size_t)l * D_MODEL * 2 * D_FF, D_MODEL, 2 * D_FF, (bf16*)(ws + WS_GU2), scr, r, lane, true, F.in[17] + l * D_MODEL); continue; } r -= I_GU;
        if (r < I_D) { transpose_item(F.in[19] + (size_t)l * D_FF * D_MODEL, D_FF, D_MODEL, (bf16*)(ws + WS_D2), scr, r, lane, false); continue; } r -= I_D;
        if (r < I_SQ) { transpose_item(F.in[22] + (size_t)l * D_MODEL * D_MODEL, D_MODEL, D_MODEL, (bf16*)(ws + WS_PG), scr, r, lane, false, F.in[21] + l * D_MODEL); continue; } r -= I_SQ;
        transpose_item(F.in[23] + (size_t)l * PLE_DIM * D_MODEL, PLE_DIM, D_MODEL, (bf16*)(ws + WS_PP), scr, r, lane, false);
    }
    { const float* p = F.in[1] + (size_t)l * M * PLE_DIM; bf16* pb = (bf16*)(ws + WS_PB);
      const size_t n8 = (size_t)M * PLE_DIM / 8;
      for (size_t i = (size_t)F.bid * NTHR + tid; i < n8; i += (size_t)F.G * NTHR) {
          const f32x4 a = *(const f32x4*)(p + 8 * i), b = *(const f32x4*)(p + 8 * i + 4);
          v4u o; o.x = pk2(a.x, a.y); o.y = pk2(a.z, a.w); o.z = pk2(b.x, b.y); o.w = pk2(b.z, b.w);
          *(v4u*)(pb + 8 * i) = o; } }
    if (l == 0) {
        for (int m = gw; m < M; m += NGW) x_row_to_bf16(lane, F.in[0] + (size_t)m * D_MODEL, (bf16*)(ws + WS_X16) + (size_t)m * D_MODEL, (float*)(ws + WS_RS) + m);
    }
}

__device__ __forceinline__ void phase_norm(Frame& F, float alpha, const float* wpost, bool final_, int ph = 0) {
    PHASE_TID();
    const int gw = F.bid * NWAVES + wave, NGW = F.G * NWAVES;
    const bf16* Y = (const bf16*)(F.ws + WS_Y); bf16* X = (bf16*)(F.ws + WS_X16); float* RS = (float*)(F.ws + WS_RS);
    for (int m0 = gw; m0 < M; m0 += 2 * NGW) {
        v4u yw[2][4], xw[2][4];
#pragma unroll
        for (int q = 0; q < 2; ++q) { const int m = m0 + q * NGW;
            if (m < M) {
#pragma unroll
                for (int j = 0; j < 4; ++j) { yw[q][j] = *(const v4u*)(Y + (size_t)m * D_MODEL + 8 * lane + 512 * j); xw[q][j] = *(const v4u*)(X + (size_t)m * D_MODEL + 8 * lane + 512 * j); } } }
#pragma unroll
        for (int q = 0; q < 2; ++q) { const int m = m0 + q * NGW;
            if (m < M) {
                bf16* xrow = X + (size_t)m * D_MODEL;
                float y[4][8]; float ss = 0.f;
#pragma unroll
                for (int j = 0; j < 4; ++j) { const v4u w = yw[q][j];
                    y[j][0] = blo(w.x); y[j][1] = bhi(w.x); y[j][2] = blo(w.y); y[j][3] = bhi(w.y); y[j][4] = blo(w.z); y[j][5] = bhi(w.z); y[j][6] = blo(w.w); y[j][7] = bhi(w.w);
#pragma unroll
                    for (int e = 0; e < 8; ++e) ss += y[j][e] * y[j][e]; }
                const float rstd = alpha / sqrtf(wave_sum(ss) * (1.0f / D_MODEL) + NORM_EPS);
#if MK_CHECK
                { float mxv = 0.f;
#pragma unroll
                  for (int j = 0; j < 4; ++j)
#pragma unroll
                      for (int e = 0; e < 8; ++e) mxv = fmaxf(mxv, fabsf(y[j][e]));
                  mxv = wave_max(mxv) * rstd / alpha;
                  if (mxv > 20.0f && lane == 0) { atomicMax((unsigned*)(F.ws + WS_CTL) + 65, (unsigned)(NPHASES - ph)); atomicAdd((unsigned*)(F.ws + WS_CTL) + 128 + ph, 1u); } }
#endif
                float ss2 = 0.f;
#pragma unroll
                for (int j = 0; j < 4; ++j) { const int c = 8 * lane + 512 * j; const v4u xv = xw[q][j];
                    const f32x4 w0 = *(const f32x4*)(wpost + c), w1 = *(const f32x4*)(wpost + c + 4);
                    y[j][0] = blo(xv.x) + y[j][0] * rstd * w0.x; y[j][1] = bhi(xv.x) + y[j][1] * rstd * w0.y; y[j][2] = blo(xv.y) + y[j][2] * rstd * w0.z; y[j][3] = bhi(xv.y) + y[j][3] * rstd * w0.w;
                    y[j][4] = blo(xv.z) + y[j][4] * rstd * w1.x; y[j][5] = bhi(xv.z) + y[j][5] * rstd * w1.y; y[j][6] = blo(xv.w) + y[j][6] * rstd * w1.z; y[j][7] = bhi(xv.w) + y[j][7] * rstd * w1.w;
                    if (final_) { float* xo = F.out + (size_t)m * D_MODEL + c;
                        *(f32x4*)xo = (f32x4){y[j][0], y[j][1], y[j][2], y[j][3]}; *(f32x4*)(xo + 4) = (f32x4){y[j][4], y[j][5], y[j][6], y[j][7]}; }
                    else { v4u o; o.x = pk2(y[j][0], y[j][1]); o.y = pk2(y[j][2], y[j][3]); o.z = pk2(y[j][4], y[j][5]); o.w = pk2(y[j][6], y[j][7]);
                        *(v4u*)(xrow + c) = o;
#pragma unroll
                        for (int e = 0; e < 8; ++e) ss2 += y[j][e] * y[j][e]; } }
                if (!final_) { ss2 = wave_sum(ss2); if (lane == 0) RS[m] = 1.0f / sqrtf(ss2 * (1.0f / D_MODEL) + NORM_EPS); }
            } }
    }
}

__device__ __forceinline__ void phase_conv(Frame& F, int l) {
    PHASE_TID();
    const bf16* main_ = (const bf16*)(F.ws + WS_BIG); bf16* FC = (bf16*)(F.ws + WS_FC);
    const float* cw = F.in[8] + (size_t)l * 3 * CONV_WIDTH;
    for (int it = F.bid * NTHR + tid; it < M * 64; it += F.G * NTHR) {
        const int row = it >> 6, cg = it & 63, t = row & (SEQ - 1);
        float acc[8];
#pragma unroll
        for (int e = 0; e < 8; ++e) acc[e] = 0.f;
#pragma unroll
        for (int j = 0; j < 3; ++j) {
            if (t - j >= 0) {
                const bf16* rp = main_ + (size_t)(row - j) * N_MAIN;
                const v4u xv = *(const v4u*)(rp + C_CX + 8 * cg), cv = *(const v4u*)(rp + C_CC + 8 * cg);
                const float* wj = cw + (2 - j) * CONV_WIDTH + 8 * cg;
                const f32x4 w0 = *(const f32x4*)wj, w1 = *(const f32x4*)(wj + 4);
                acc[0] += w0.x * blo(xv.x) * blo(cv.x); acc[1] += w0.y * bhi(xv.x) * bhi(cv.x); acc[2] += w0.z * blo(xv.y) * blo(cv.y); acc[3] += w0.w * bhi(xv.y) * bhi(cv.y);
                acc[4] += w1.x * blo(xv.z) * blo(cv.z); acc[5] += w1.y * bhi(xv.z) * bhi(cv.z); acc[6] += w1.z * blo(xv.w) * blo(cv.w); acc[7] += w1.w * bhi(xv.w) * bhi(cv.w);
            }
        }
        const v4u bv = *(const v4u*)(main_ + (size_t)row * N_MAIN + C_CB + 8 * cg);
        v4u o; o.x = pk2(acc[0] * blo(bv.x), acc[1] * bhi(bv.x)); o.y = pk2(acc[2] * blo(bv.y), acc[3] * bhi(bv.y));
        o.z = pk2(acc[4] * blo(bv.z), acc[5] * bhi(bv.z)); o.w = pk2(acc[6] * blo(bv.w), acc[7] * bhi(bv.w));
        *(v4u*)(FC + (size_t)row * CONV_WIDTH + 8 * cg) = o;
    }
}
__device__ __forceinline__ void phase_attn_simple(Frame& F, int l) {
    PHASE_TID();
    const bf16* main_ = (const bf16*)(F.ws + WS_BIG); bf16* FA = (bf16*)(F.ws + WS_FA);
    const float* sinks = F.in[9] + (size_t)l * NHEAD;
    const int gw = F.bid * NWAVES + wave, NGW = F.G * NWAVES;
    for (int task = gw; task < M * NHEAD; task += NGW) {
        const int row = task >> 4, h = task & 15, hk = h >> 3, t = row & (SEQ - 1);
        const float slope = exp2f(-0.5f * (float)(h + 1)), sink = sinks[h];
        const bf16* qp = main_ + (size_t)row * N_MAIN + C_AQ + h * 64;
        v4u q[8];
#pragma unroll
        for (int i = 0; i < 8; ++i) q[i] = *(const v4u*)(qp + 8 * i);
        float s[2];
#pragma unroll
        for (int jj = 0; jj < 2; ++jj) {
            const int j = lane + 64 * jj;
            float d = 0.f;
            if (t - j >= 0) {
                const bf16* kp = main_ + (size_t)(row - j) * N_MAIN + C_AK + hk * 64;
#pragma unroll
                for (int i = 0; i < 8; ++i) { const v4u kv = *(const v4u*)(kp + 8 * i);
                    d += blo(q[i].x) * blo(kv.x) + bhi(q[i].x) * bhi(kv.x) + blo(q[i].y) * blo(kv.y) + bhi(q[i].y) * bhi(kv.y)
                       + blo(q[i].z) * blo(kv.z) + bhi(q[i].z) * bhi(kv.z) + blo(q[i].w) * blo(kv.w) + bhi(q[i].w) * bhi(kv.w); }
                s[jj] = d * 0.125f - slope * (float)j;
            } else s[jj] = -1e30f;
        }
        const float mx = fmaxf(wave_max(fmaxf(s[0], s[1])), sink);
        const float p0 = __expf(s[0] - mx), p1 = __expf(s[1] - mx);
        const float denom = wave_sum(p0 + p1) + __expf(sink - mx);
        float acc = 0.f;
        const int jmax = t < (WINDOW - 1) ? t : (WINDOW - 1);
        const bf16* vp = main_ + (size_t)row * N_MAIN + C_AV + hk * 64 + lane;
        for (int j = 0; j <= jmax; ++j) {
            const float pj = __shfl(j < 64 ? p0 : p1, j & 63);
            acc += pj * bf2f(vp[-(ptrdiff_t)j * N_MAIN]);
        }
        FA[(size_t)row * 1024 + h * 64 + lane] = (bf16)f2bf(acc / denom);
    }
}


typedef float f32x16 __attribute__((ext_vector_type(16)));
typedef short s16x8 __attribute__((ext_vector_type(8)));
typedef short s16x4 __attribute__((ext_vector_type(4)));
typedef unsigned u32x2 __attribute__((ext_vector_type(2)));
constexpr int AT_KP = 144, AT_VP = 520, AT_VOFF = 256 * AT_KP;
__device__ __forceinline__ void phase_attn_mfma(Frame& F, int l) {
    PHASE_TID();
    const bf16* main_ = (const bf16*)(F.ws + WS_BIG); bf16* FA = (bf16*)(F.ws + WS_FA);
    LAS unsigned char* KL = F.lds; LAS unsigned char* VL = F.lds + AT_VOFF;
    const int r32 = lane & 31, hi = lane >> 5;
    constexpr float L2E = 1.4426950408889634f, NEG = -1e30f;
    constexpr int NU = BATCH * (SEQ / 128) * NKV;
    v4u kvr[4], vvr[4];
#define AT_LOAD(u_) do { const int hk_ = (u_) & 1, n_ = ((u_) >> 1) & 127, b_ = (u_) >> 8; const size_t r0_ = (size_t)b_ * SEQ + (size_t)n_ * 128; \
        _Pragma("unroll") for (int i = 0; i < 4; ++i) { const int idx = tid + NTHR * i, key = idx & 255, dg = idx >> 8; kvr[i] = (v4u){0u, 0u, 0u, 0u}; vvr[i] = (v4u){0u, 0u, 0u, 0u}; \
            if (n_ > 0 || key >= 128) { const bf16* rp = main_ + (r0_ - 128 + key) * N_MAIN + hk_ * 64 + dg * 8; kvr[i] = *(const v4u*)(rp + C_AK); vvr[i] = *(const v4u*)(rp + C_AV); } } } while (0)
    int unit = F.bid;
    if (unit < NU) AT_LOAD(unit);
    for (; unit < NU; unit += F.G) {
        const int hk = unit & 1, n = (unit >> 1) & 127, b = unit >> 8;
        const size_t row0 = (size_t)b * SEQ + (size_t)n * 128;
        const int h = hk * 8 + wave;
        s16x8 qf[4];
#pragma unroll
        for (int ks = 0; ks < 4; ++ks) qf[ks] = *(const s16x8*)(main_ + (row0 + r32) * N_MAIN + C_AQ + h * 64 + 16 * ks + 8 * hi);
#pragma unroll
        for (int i = 0; i < 4; ++i) { const int idx = tid + NTHR * i, key = idx & 255, dg = idx >> 8; const v4u vv = vvr[i];
            *(LAS v4u*)(KL + key * AT_KP + dg * 16) = kvr[i];
            LAS unsigned short* vp = (LAS unsigned short*)(VL + (dg * 8) * AT_VP + key * 2);
            vp[0 * (AT_VP / 2)] = (unsigned short)(vv.x & 0xffffu); vp[1 * (AT_VP / 2)] = (unsigned short)(vv.x >> 16);
            vp[2 * (AT_VP / 2)] = (unsigned short)(vv.y & 0xffffu); vp[3 * (AT_VP / 2)] = (unsigned short)(vv.y >> 16);
            vp[4 * (AT_VP / 2)] = (unsigned short)(vv.z & 0xffffu); vp[5 * (AT_VP / 2)] = (unsigned short)(vv.z >> 16);
            vp[6 * (AT_VP / 2)] = (unsigned short)(vv.w & 0xffffu); vp[7 * (AT_VP / 2)] = (unsigned short)(vv.w >> 16); }
        __syncthreads();
        const float slope2 = exp2f(-0.5f * (float)(h + 1)) * L2E, sink2 = F.in[9][l * NHEAD + h] * L2E;
        const float nsb2 = -slope2 * (float)(r32 + 128 - 4 * hi);
#pragma unroll 1
        for (int c = 0; c < 4; ++c) {
            const size_t qrow = row0 + 32 * c + r32;
            if (c == 3 && unit + F.G < NU) { AT_LOAD(unit + F.G); }
            f32x16 S[5];
            float mx = NEG;
#pragma unroll
            for (int d = 0; d < 5; ++d) {
                const int kt = c + d;
                if (n == 0 && kt < 4) {
#pragma unroll
                    for (int r = 0; r < 16; ++r) S[d][r] = NEG;
                } else {
                    f32x16 acc;
#pragma unroll
                    for (int r = 0; r < 16; ++r) acc[r] = 0.f;
#pragma unroll
                    for (int ks = 0; ks < 4; ++ks) { const s16x8 a = *(const LAS s16x8*)(KL + (32 * kt + r32) * AT_KP + (16 * ks + 8 * hi) * 2);
                        acc = __builtin_amdgcn_mfma_f32_32x32x16_bf16(a, qf[ks], acc, 0, 0, 0); }
#pragma unroll
                    for (int r = 0; r < 16; ++r) { const int cr = (r & 3) + 8 * (r >> 2);
                        float s = fmaf(slope2, (float)(32 * d + cr), fmaf(acc[r], 0.125f * L2E, nsb2));
                        if (d == 0) { if (!(r32 - 4 * hi - cr < 0)) s = NEG; }
                        if (d == 4) { if (!(r32 - 4 * hi - cr >= 0)) s = NEG; }
                        S[d][r] = s; mx = fmaxf(mx, s); }
                }
            }
            if (c < 3) {
#pragma unroll
                for (int ks = 0; ks < 4; ++ks) qf[ks] = *(const s16x8*)(main_ + (qrow + 32) * N_MAIN + C_AQ + h * 64 + 16 * ks + 8 * hi);
            }
            mx = xor32_max(mx);
            mx = fmaxf(mx, sink2);
            float sum = 0.f;
            f32x16 O0, O1;
#pragma unroll
            for (int r = 0; r < 16; ++r) { O0[r] = 0.f; O1[r] = 0.f; }
#pragma unroll
            for (int d = 0; d < 5; ++d) {
                const int kt = c + d;
                if (n == 0 && kt < 4) continue;
#pragma unroll
                for (int r = 0; r < 16; ++r) { const float p = __builtin_amdgcn_exp2f(S[d][r] - mx); S[d][r] = p; sum += p; }
#pragma unroll
                for (int s = 0; s < 2; ++s) {
                    v4u pw; pw.x = pg8::cvt_pk_bf16(S[d][8 * s + 0], S[d][8 * s + 1]); pw.y = pg8::cvt_pk_bf16(S[d][8 * s + 2], S[d][8 * s + 3]);
                    pw.z = pg8::cvt_pk_bf16(S[d][8 * s + 4], S[d][8 * s + 5]); pw.w = pg8::cvt_pk_bf16(S[d][8 * s + 6], S[d][8 * s + 7]);
                    const s16x8 pf = __builtin_bit_cast(s16x8, pw);
                    const int kb = (32 * kt + 16 * s + 4 * hi) * 2;
                    { const s16x4 lo = *(const LAS s16x4*)(VL + r32 * AT_VP + kb), hh = *(const LAS s16x4*)(VL + r32 * AT_VP + kb + 16);
                      const s16x8 a = __builtin_shufflevector(lo, hh, 0, 1, 2, 3, 4, 5, 6, 7); O0 = __builtin_amdgcn_mfma_f32_32x32x16_bf16(a, pf, O0, 0, 0, 0); }
                    { const s16x4 lo = *(const LAS s16x4*)(VL + (32 + r32) * AT_VP + kb), hh = *(const LAS s16x4*)(VL + (32 + r32) * AT_VP + kb + 16);
                      const s16x8 a = __builtin_shufflevector(lo, hh, 0, 1, 2, 3, 4, 5, 6, 7); O1 = __builtin_amdgcn_mfma_f32_32x32x16_bf16(a, pf, O1, 0, 0, 0); }
                }
            }
            sum = xor32_sum(sum);
            const float inv = 1.0f / (sum + __builtin_amdgcn_exp2f(sink2 - mx));
            bf16* op = FA + qrow * 1024 + h * 64 + 4 * hi;
#pragma unroll
            for (int rg = 0; rg < 4; ++rg) {
                u32x2 w0; w0.x = pg8::cvt_pk_bf16(O0[4 * rg] * inv, O0[4 * rg + 1] * inv); w0.y = pg8::cvt_pk_bf16(O0[4 * rg + 2] * inv, O0[4 * rg + 3] * inv);
                u32x2 w1; w1.x = pg8::cvt_pk_bf16(O1[4 * rg] * inv, O1[4 * rg + 1] * inv); w1.y = pg8::cvt_pk_bf16(O1[4 * rg + 2] * inv, O1[4 * rg + 3] * inv);
                *(u32x2*)(op + 8 * rg) = w0; *(u32x2*)(op + 32 + 8 * rg) = w1; }
        }
        __syncthreads();
    }
#undef AT_LOAD
}

__device__ __forceinline__ float hgrn_lb(const float* logits, int l, int ch) {
    float mx = -1e30f;
#pragma unroll
    for (int i = 0; i < DEPTH; ++i) mx = fmaxf(mx, logits[i * (HG_H * HG_DK) + ch]);
    float den = 0.f, num = 0.f;
#pragma unroll
    for (int i = 0; i < DEPTH; ++i) { const float e = __expf(logits[i * (HG_H * HG_DK) + ch] - mx); den += e; if (i < l) num += e; }
    return num / den;
}
__device__ __forceinline__ float hgrn_lb2(float x0, float x1, int l) { if (l == 0) return 0.f; const float mx = fmaxf(x0, x1), e0 = __expf(x0 - mx), e1 = __expf(x1 - mx); return e0 / (e0 + e1); }
static_assert(DEPTH == 2, "hgrn_lb2 is written for two layers");
template <bool WITH_Q>
__device__ __forceinline__ void hgrn_front(Frame& F, int l, int unit, int tid) {
    LAS float* L = (LAS float*)F.lds;
    LAS float* A_ = L; LAS float* KC = L + 8192; LAS float* Q = L + 16384; LAS float* V = L + 24576; LAS float* QT = L + 32768;
    const bf16* main_ = (const bf16*)(F.ws + WS_BIG);
    const int c = unit & (HG_NC - 1), bh = unit >> 8, h = bh & 7, b = bh >> 3;
    const size_t row0 = (size_t)b * SEQ + (size_t)c * HG_C;
    const int k = tid & 127, tq = tid >> 7;
    const float lb = hgrn_lb(F.in[10], l, h * HG_DK + k), lbe = fmaxf(lb, 1e-20f);
    float run = 0.f;
#pragma unroll 4
    for (int tt = 0; tt < 16; ++tt) { const int t = tq * 16 + tt;
        const bf16* rp = main_ + (row0 + t) * N_MAIN;
        const float z = bf2f(rp[C_RF + h * HG_DK + k]);
        const float sg = sigm(z);
        const float f = lbe + (1.0f - lbe) * sg;
        run += __logf(f);
        A_[t * 128 + k] = run; KC[t * 128 + k] = (1.0f - lb) * (1.0f - sg);
        if (WITH_Q) { const float qv = bf2f(rp[C_RQ + h * HG_DK + k]); Q[t * 128 + k] = qv * sigm(qv); }
    }
    QT[tq * 128 + k] = run;
    { const int t = tid >> 3, v8 = (tid & 7) * 8;
      const v4u w = *(const v4u*)(main_ + (row0 + t) * N_MAIN + C_RI + h * HG_DV + v8);
      LAS float* vp = V + t * 64 + v8;
      vp[0] = blo(w.x); vp[1] = bhi(w.x); vp[2] = blo(w.y); vp[3] = bhi(w.y); vp[4] = blo(w.z); vp[5] = bhi(w.z); vp[6] = blo(w.w); vp[7] = bhi(w.w); }
    __syncthreads();
    float off = 0.f;
    for (int q = 0; q < tq; ++q) off += QT[q * 128 + k];
#pragma unroll 4
    for (int tt = 0; tt < 16; ++tt) A_[(tq * 16 + tt) * 128 + k] += off;
    __syncthreads();
}
__device__ __forceinline__ void phase_hgrn_a(Frame& F, int l) {
    PHASE_TID();
    LAS float* L = (LAS float*)F.lds;
    LAS float* A_ = L; LAS float* KC = L + 8192; LAS float* V = L + 24576;
    float* UT = (float*)(F.ws + WS_UT); float* DD = (float*)(F.ws + WS_DD);
    const int k = tid & 127, tq = tid >> 7;
    for (int unit = F.bid; unit < BATCH * HG_H * HG_NC; unit += F.G) {
        hgrn_front<false>(F, l, unit, tid);
        const float alast = A_[63 * 128 + k];
#pragma unroll 4
        for (int tt = 0; tt < 16; ++tt) { const int t = tq * 16 + tt; KC[t * 128 + k] *= __expf(alast - A_[t * 128 + k]); }
        __syncthreads();
        float acc[16];
#pragma unroll
        for (int j = 0; j < 16; ++j) acc[j] = 0.f;
        for (int s = 0; s < 64; ++s) { const float kd = KC[s * 128 + k];
#pragma unroll
            for (int j = 0; j < 16; ++j) acc[j] += kd * V[s * 64 + tq * 16 + j]; }
#pragma unroll
        for (int j = 0; j < 16; ++j) UT[(size_t)unit * 8192 + (tq * 16 + j) * 128 + k] = acc[j];
        if (tq == 0) DD[(size_t)unit * 128 + k] = __expf(alast);
        __syncthreads();
    }
}
__device__ __forceinline__ void phase_hgrn_scan(Frame& F) {
    PHASE_TID();
    float* UT = (float*)(F.ws + WS_UT); const float* DD = (const float*)(F.ws + WS_DD);
    for (int e = F.bid * NTHR + tid; e < BATCH * HG_H * 8192; e += F.G * NTHR) {
        const int bh = e >> 13, vk = e & 8191, k = vk & 127;
        float s = 0.f;
        float* up = UT + (size_t)bh * HG_NC * 8192 + vk; const float* dp = DD + (size_t)bh * HG_NC * 128 + k;
        for (int c = 0; c < HG_NC; c += 8) {
            float u[8], d[8];
#pragma unroll
            for (int i = 0; i < 8; ++i) { u[i] = up[(size_t)(c + i) * 8192]; d[i] = dp[(size_t)(c + i) * 128]; }
#pragma unroll
            for (int i = 0; i < 8; ++i) { up[(size_t)(c + i) * 8192] = s; s = d[i] * s + u[i]; }
        }
    }
}
__device__ __forceinline__ void phase_hgrn_c(Frame& F, int l) {
    PHASE_TID();
    LAS float* L = (LAS float*)F.lds;
    LAS float* A_ = L; LAS float* KC = L + 8192; LAS float* Q = L + 16384; LAS float* V = L + 24576; LAS float* ATT = L + 28672;
    const float* UT = (const float*)(F.ws + WS_UT);
    const bf16* main_ = (const bf16*)(F.ws + WS_BIG); bf16* FH = (bf16*)(F.ws + WS_FH);
    const float* nw = F.in[11] + (size_t)l * HG_DV;
    const int k = tid & 127, tq = tid >> 7, w = wave;
    for (int unit = F.bid; unit < BATCH * HG_H * HG_NC; unit += F.G) {
        hgrn_front<true>(F, l, unit, tid);
        const int c = unit & (HG_NC - 1), bh = unit >> 8, h = bh & 7, b = bh >> 3;
        const size_t row0 = (size_t)b * SEQ + (size_t)c * HG_C;
        for (int p = w; p < 4096; p += NWAVES) { const int t = p >> 6, s = p & 63;
            if (s <= t) {
                float v = Q[t * 128 + lane] * __expf(A_[t * 128 + lane] - A_[s * 128 + lane]) * KC[s * 128 + lane]
                        + Q[t * 128 + 64 + lane] * __expf(A_[t * 128 + 64 + lane] - A_[s * 128 + 64 + lane]) * KC[s * 128 + 64 + lane];
                v = wave_sum(v);
                if (lane == 0) ATT[t * 64 + s] = v;
            }
        }
        __syncthreads();
#pragma unroll 4
        for (int tt = 0; tt < 16; ++tt) { const int t = tq * 16 + tt; Q[t * 128 + k] *= __expf(A_[t * 128 + k]); }
        __syncthreads();
        float acc[8];
#pragma unroll
        for (int i = 0; i < 8; ++i) acc[i] = 0.f;
        for (int s = 0; s < 8 * w + 8; ++s) { const float vv = V[s * 64 + lane];
#pragma unroll
            for (int i = 0; i < 8; ++i) { const int t = 8 * w + i; if (s <= t) acc[i] += ATT[t * 64 + s] * vv; } }
        const float* st = UT + (size_t)unit * 8192 + lane * 128;
        for (int k4 = 0; k4 < 128; k4 += 4) { const f32x4 sv = *(const f32x4*)(st + k4);
#pragma unroll
            for (int i = 0; i < 8; ++i) { const LAS float* qp = Q + (8 * w + i) * 128 + k4; acc[i] += qp[0] * sv.x + qp[1] * sv.y + qp[2] * sv.z + qp[3] * sv.w; } }
        const float nwv = nw[lane];
#pragma unroll
        for (int i = 0; i < 8; ++i) { const int t = 8 * w + i;
            const float ss = wave_sum(acc[i] * acc[i]);
            const float o = acc[i] * (1.0f / sqrtf(ss * (1.0f / HG_DV) + NORM_EPS)) * nwv;
            const float gv = bf2f(main_[(row0 + t) * N_MAIN + C_RG + h * HG_DV + lane]);
            FH[(row0 + t) * 512 + h * HG_DV + lane] = (bf16)f2bf(o * gv * sigm(gv)); }
        __syncthreads();
    }
}


constexpr int HG_P = 144, HG_PK = 272;
__device__ __forceinline__ void hg_stage_vt(const bf16* main_, size_t row0, int h, LAS unsigned char* VT, int tid) {
    const int s = tid & 63, dg = tid >> 6;
    const v4u w = *(const v4u*)(main_ + (row0 + s) * N_MAIN + C_RI + h * HG_DV + dg * 8);
    LAS unsigned short* vp = (LAS unsigned short*)(VT + (dg * 8) * HG_P + s * 2);
    vp[0 * (HG_P / 2)] = (unsigned short)(w.x & 0xffffu); vp[1 * (HG_P / 2)] = (unsigned short)(w.x >> 16);
    vp[2 * (HG_P / 2)] = (unsigned short)(w.y & 0xffffu); vp[3 * (HG_P / 2)] = (unsigned short)(w.y >> 16);
    vp[4 * (HG_P / 2)] = (unsigned short)(w.z & 0xffffu); vp[5 * (HG_P / 2)] = (unsigned short)(w.z >> 16);
    vp[6 * (HG_P / 2)] = (unsigned short)(w.w & 0xffffu); vp[7 * (HG_P / 2)] = (unsigned short)(w.w >> 16);
}
__device__ __forceinline__ void phase_hgrn_a2(Frame& F, int l) {
    PHASE_TID();
    LAS unsigned char* KDT = F.lds; LAS unsigned char* VT = F.lds + 18432; LAS float* QT = (LAS float*)(F.lds + 27648);
    const bf16* main_ = (const bf16*)(F.ws + WS_BIG); bf16* UTB = (bf16*)(F.ws + WS_UT); float* DD = (float*)(F.ws + WS_DD);
    const int k = tid & 127, tq = tid >> 7, r32 = lane & 31, hi = lane >> 5;
    for (int unit = F.bid; unit < BATCH * HG_H * HG_NC; unit += F.G) {
        const int c = unit & (HG_NC - 1), bh = unit >> 8, h = bh & 7, b = bh >> 3;
        const size_t row0 = (size_t)b * SEQ + (size_t)c * HG_C;
        const float lb = hgrn_lb(F.in[10], l, h * HG_DK + k), lbe = fmaxf(lb, 1e-20f);
        float a[16], kc[16]; float run = 0.f;
#pragma unroll
        for (int tt = 0; tt < 16; ++tt) { const float z = bf2f(main_[(row0 + tq * 16 + tt) * N_MAIN + C_RF + h * HG_DK + k]);
            const float sg = sigm(z); run += __logf(lbe + (1.0f - lbe) * sg); a[tt] = run; kc[tt] = (1.0f - lb) * (1.0f - sg); }
        QT[tq * 128 + k] = run;
        hg_stage_vt(main_, row0, h, VT, tid);
        __syncthreads();
        float off = 0.f, tot = 0.f;
#pragma unroll
        for (int q = 0; q < 4; ++q) { const float x = QT[q * 128 + k]; if (q < tq) off += x; tot += x; }
        float kd[16];
#pragma unroll
        for (int tt = 0; tt < 16; ++tt) kd[tt] = kc[tt] * __expf(tot - (off + a[tt]));
        { v4u w0, w1; w0.x = pg8::cvt_pk_bf16(kd[0], kd[1]); w0.y = pg8::cvt_pk_bf16(kd[2], kd[3]); w0.z = pg8::cvt_pk_bf16(kd[4], kd[5]); w0.w = pg8::cvt_pk_bf16(kd[6], kd[7]);
          w1.x = pg8::cvt_pk_bf16(kd[8], kd[9]); w1.y = pg8::cvt_pk_bf16(kd[10], kd[11]); w1.z = pg8::cvt_pk_bf16(kd[12], kd[13]); w1.w = pg8::cvt_pk_bf16(kd[14], kd[15]);
          *(LAS v4u*)(KDT + k * HG_P + tq * 32) = w0; *(LAS v4u*)(KDT + k * HG_P + tq * 32 + 16) = w1; }
        if (tq == 0) DD[(size_t)unit * 128 + k] = __expf(tot);
        __syncthreads();
        { const int kt = wave >> 1, vt = wave & 1;
          f32x16 acc;
#pragma unroll
          for (int r = 0; r < 16; ++r) acc[r] = 0.f;
#pragma unroll
          for (int ks = 0; ks < 4; ++ks) { const s16x8 A = *(const LAS s16x8*)(KDT + (32 * kt + r32) * HG_P + (16 * ks + 8 * hi) * 2);
              const s16x8 B = *(const LAS s16x8*)(VT + (32 * vt + r32) * HG_P + (16 * ks + 8 * hi) * 2);
              acc = __builtin_amdgcn_mfma_f32_32x32x16_bf16(A, B, acc, 0, 0, 0); }
          bf16* up = UTB + (size_t)unit * 8192 + (32 * vt + r32) * 128 + 32 * kt + 4 * hi;
#pragma unroll
          for (int rg = 0; rg < 4; ++rg) { u32x2 w; w.x = pg8::cvt_pk_bf16(acc[4 * rg], acc[4 * rg + 1]); w.y = pg8::cvt_pk_bf16(acc[4 * rg + 2], acc[4 * rg + 3]); *(u32x2*)(up + 8 * rg) = w; } }
        __syncthreads();
    }
}
__device__ __forceinline__ void phase_hgrn_scan2(Frame& F) {
    PHASE_TID();
    bf16* UTB = (bf16*)(F.ws + WS_UT); const float* DD = (const float*)(F.ws + WS_DD);
    for (int e = F.bid * NTHR + tid; e < BATCH * HG_H * 8192; e += F.G * NTHR) {
        const int bh = e >> 13, vk = e & 8191, k = vk & 127;
        float s = 0.f;
        bf16* up = UTB + (size_t)bh * HG_NC * 8192 + vk; const float* dp = DD + (size_t)bh * HG_NC * 128 + k;
        for (int c = 0; c < HG_NC; c += 32) {
            bf16 u[32]; float d[32];
#pragma unroll
            for (int i = 0; i < 32; ++i) { u[i] = up[(size_t)(c + i) * 8192]; d[i] = dp[(size_t)(c + i) * 128]; }
#pragma unroll
            for (int i = 0; i < 32; ++i) { up[(size_t)(c + i) * 8192] = (bf16)f2bf(s); s = d[i] * s + bf2f(u[i]); }
        }
    }
}
__device__ __forceinline__ void phase_hgrn_c2(Frame& F, int l) {
    PHASE_TID();
    LAS unsigned char* QA = F.lds; LAS unsigned char* KB = F.lds + 17408; LAS unsigned char* QE = F.lds + 34816; LAS unsigned char* VT = F.lds + 52224; LAS float* QT = (LAS float*)(F.lds + 61440);
    const bf16* main_ = (const bf16*)(F.ws + WS_BIG); const bf16* UTB = (const bf16*)(F.ws + WS_UT); bf16* FH = (bf16*)(F.ws + WS_FH);
    const float* nw = F.in[11] + (size_t)l * HG_DV;
    const int k = tid & 127, tq = tid >> 7, r32 = lane & 31, hi = lane >> 5;
    for (int unit = F.bid; unit < BATCH * HG_H * HG_NC; unit += F.G) {
        const int c = unit & (HG_NC - 1), bh = unit >> 8, h = bh & 7, b = bh >> 3;
        const size_t row0 = (size_t)b * SEQ + (size_t)c * HG_C;
        const float lb = hgrn_lb(F.in[10], l, h * HG_DK + k), lbe = fmaxf(lb, 1e-20f);
        float a[16], kc[16], q[16]; float run = 0.f;
#pragma unroll
        for (int tt = 0; tt < 16; ++tt) { const bf16* rp = main_ + (row0 + tq * 16 + tt) * N_MAIN + h * HG_DK + k;
            const float z = bf2f(rp[C_RF]), qv = bf2f(rp[C_RQ]);
            const float sg = sigm(z); run += __logf(lbe + (1.0f - lbe) * sg); a[tt] = run; kc[tt] = (1.0f - lb) * (1.0f - sg); q[tt] = qv * sigm(qv); }
        QT[tq * 128 + k] = run;
        hg_stage_vt(main_, row0, h, VT, tid);
        __syncthreads();
        float off = 0.f; const float aref = QT[k] + QT[128 + k];
#pragma unroll
        for (int qq = 0; qq < 3; ++qq) { if (qq < tq) off += QT[qq * 128 + k]; }
#pragma unroll
        for (int tt = 0; tt < 16; ++tt) { const int t = tq * 16 + tt; const float at = off + a[tt];
            *(LAS unsigned short*)(QA + t * HG_PK + k * 2) = (unsigned short)f2bf(q[tt] * __expf(at - aref));
            *(LAS unsigned short*)(KB + t * HG_PK + k * 2) = (unsigned short)f2bf(kc[tt] * __expf(aref - at));
            *(LAS unsigned short*)(QE + t * HG_PK + k * 2) = (unsigned short)f2bf(q[tt] * __expf(at)); }
        __syncthreads();
        if (wave < 2) {
            const int tt_ = wave;
            f32x16 O0, O1;
#pragma unroll
            for (int r = 0; r < 16; ++r) { O0[r] = 0.f; O1[r] = 0.f; }
#pragma unroll
            for (int st = 0; st < 2; ++st) {
                if (st <= tt_) {
                    f32x16 acc;
#pragma unroll
                    for (int r = 0; r < 16; ++r) acc[r] = 0.f;
#pragma unroll
                    for (int ks = 0; ks < 8; ++ks) { const s16x8 A = *(const LAS s16x8*)(KB + (32 * st + r32) * HG_PK + (16 * ks + 8 * hi) * 2);
                        const s16x8 B = *(const LAS s16x8*)(QA + (32 * tt_ + r32) * HG_PK + (16 * ks + 8 * hi) * 2);
                        acc = __builtin_amdgcn_mfma_f32_32x32x16_bf16(A, B, acc, 0, 0, 0); }
                    if (st == tt_) {
#pragma unroll
                        for (int r = 0; r < 16; ++r) { if ((r & 3) + 8 * (r >> 2) + 4 * hi > r32) acc[r] = 0.f; } }
#pragma unroll
                    for (int s2 = 0; s2 < 2; ++s2) {
                        v4u pw; pw.x = pg8::cvt_pk_bf16(acc[8 * s2 + 0], acc[8 * s2 + 1]); pw.y = pg8::cvt_pk_bf16(acc[8 * s2 + 2], acc[8 * s2 + 3]);
                        pw.z = pg8::cvt_pk_bf16(acc[8 * s2 + 4], acc[8 * s2 + 5]); pw.w = pg8::cvt_pk_bf16(acc[8 * s2 + 6], acc[8 * s2 + 7]);
                        const s16x8 pf = __builtin_bit_cast(s16x8, pw);
                        const int kb = (32 * st + 16 * s2 + 4 * hi) * 2;
                        { const s16x4 lo = *(const LAS s16x4*)(VT + r32 * HG_P + kb), hh = *(const LAS s16x4*)(VT + r32 * HG_P + kb + 16);
                          O0 = __builtin_amdgcn_mfma_f32_32x32x16_bf16(__builtin_shufflevector(lo, hh, 0, 1, 2, 3, 4, 5, 6, 7), pf, O0, 0, 0, 0); }
                        { const s16x4 lo = *(const LAS s16x4*)(VT + (32 + r32) * HG_P + kb), hh = *(const LAS s16x4*)(VT + (32 + r32) * HG_P + kb + 16);
                          O1 = __builtin_amdgcn_mfma_f32_32x32x16_bf16(__builtin_shufflevector(lo, hh, 0, 1, 2, 3, 4, 5, 6, 7), pf, O1, 0, 0, 0); }
                    }
                }
            }
            const bf16* sp = UTB + (size_t)unit * 8192 + r32 * 128 + 8 * hi;
#pragma unroll
            for (int ks = 0; ks < 8; ++ks) { const s16x8 B = *(const LAS s16x8*)(QE + (32 * tt_ + r32) * HG_PK + (16 * ks + 8 * hi) * 2);
                const s16x8 A0 = *(const s16x8*)(sp + 16 * ks), A1 = *(const s16x8*)(sp + 32 * 128 + 16 * ks);
                O0 = __builtin_amdgcn_mfma_f32_32x32x16_bf16(A0, B, O0, 0, 0, 0); O1 = __builtin_amdgcn_mfma_f32_32x32x16_bf16(A1, B, O1, 0, 0, 0); }
            float ss = 0.f;
#pragma unroll
            for (int r = 0; r < 16; ++r) ss += O0[r] * O0[r] + O1[r] * O1[r];
            ss = xor32_sum(ss);
            const float rstd = 1.0f / sqrtf(ss * (1.0f / HG_DV) + NORM_EPS);
            const size_t row = row0 + 32 * tt_ + r32;
#pragma unroll
            for (int rg = 0; rg < 4; ++rg) {
#pragma unroll
                for (int vt = 0; vt < 2; ++vt) { const int v = 32 * vt + 8 * rg + 4 * hi;
                    const u32x2 gw = *(const u32x2*)(main_ + row * N_MAIN + C_RG + h * HG_DV + v); const f32x4 nv = *(const f32x4*)(nw + v);
                    const float g0 = blo(gw.x), g1 = bhi(gw.x), g2 = blo(gw.y), g3 = bhi(gw.y);
                    const float o0 = (vt ? O1[4 * rg] : O0[4 * rg]) * rstd * nv.x * g0 * sigm(g0), o1 = (vt ? O1[4 * rg + 1] : O0[4 * rg + 1]) * rstd * nv.y * g1 * sigm(g1);
                    const float o2 = (vt ? O1[4 * rg + 2] : O0[4 * rg + 2]) * rstd * nv.z * g2 * sigm(g2), o3 = (vt ? O1[4 * rg + 3] : O0[4 * rg + 3]) * rstd * nv.w * g3 * sigm(g3);
                    u32x2 w; w.x = pg8::cvt_pk_bf16(o0, o1); w.y = pg8::cvt_pk_bf16(o2, o3);
                    *(u32x2*)(FH + row * 512 + h * HG_DV + v) = w; } }
        }
        __syncthreads();
    }
}


__device__ __forceinline__ void phase_hgrn_c3(Frame& F, int l) {
    PHASE_TID();
    LAS unsigned char* QA = F.lds; LAS unsigned char* KB = F.lds + 17408; LAS unsigned char* QE = F.lds + 34816; LAS unsigned char* VT = F.lds + 52224;
    LAS float* QT = (LAS float*)(F.lds + 61440); LAS float* SSQ = (LAS float*)(F.lds + 63488);
    const bf16* main_ = (const bf16*)(F.ws + WS_BIG); const bf16* UTB = (const bf16*)(F.ws + WS_UT); bf16* FH = (bf16*)(F.ws + WS_FH);
    const float* nw = F.in[11] + (size_t)l * HG_DV;
    const int k = tid & 127, tq = tid >> 7, r32 = lane & 31, hi = lane >> 5;
    const int vt = wave & 1, tt_ = (wave >> 1) & 1;
    constexpr int NU = BATCH * HG_H * HG_NC;
    bf16 zr[16], qr[16]; v4u vtw = (v4u){0u, 0u, 0u, 0u}; float lg0 = 0.f, lg1 = 0.f;
#define HGC_LOAD(u_) do { const int c_ = (u_) & (HG_NC - 1), bh_ = (u_) >> 8, h_ = bh_ & 7, b_ = bh_ >> 3; const size_t r0_ = (size_t)b_ * SEQ + (size_t)c_ * HG_C; \
        _Pragma("unroll") for (int tt = 0; tt < 16; ++tt) { const bf16* rp_ = main_ + (r0_ + tq * 16 + tt) * N_MAIN + h_ * HG_DK + k; zr[tt] = rp_[C_RF]; qr[tt] = rp_[C_RQ]; } \
        vtw = *(const v4u*)(main_ + (r0_ + (tid & 63)) * N_MAIN + C_RI + h_ * HG_DV + (tid >> 6) * 8); lg0 = F.in[10][h_ * HG_DK + k]; lg1 = F.in[10][HG_H * HG_DK + h_ * HG_DK + k]; } while (0)
    f32x4 nwv[4];
#pragma unroll
    for (int rg = 0; rg < 4; ++rg) nwv[rg] = *(const f32x4*)(nw + 32 * vt + 8 * rg + 4 * hi);
    int unit = F.bid;
    if (unit < NU) HGC_LOAD(unit);
    for (; unit < NU; unit += F.G) {
        const int c = unit & (HG_NC - 1), bh = unit >> 8, h = bh & 7, b = bh >> 3;
        const size_t row0 = (size_t)b * SEQ + (size_t)c * HG_C;
        s16x8 sf[8]; u32x2 gw[4];
        if (wave < 4) { const bf16* sp = UTB + (size_t)unit * 8192 + (32 * vt + r32) * 128 + 8 * hi;
#pragma unroll
            for (int ks = 0; ks < 8; ++ks) sf[ks] = *(const s16x8*)(sp + 16 * ks);
            const bf16* gp = main_ + (row0 + 32 * tt_ + r32) * N_MAIN + C_RG + h * HG_DV + 32 * vt + 4 * hi;
#pragma unroll
            for (int rg = 0; rg < 4; ++rg) gw[rg] = *(const u32x2*)(gp + 8 * rg); }
        const float lb = hgrn_lb2(lg0, lg1, l), lbe = fmaxf(lb, 1e-20f);
        float a[16], kc[16], q[16]; float run = 0.f;
#pragma unroll
        for (int tt = 0; tt < 16; ++tt) { const float z = bf2f(zr[tt]), qv = bf2f(qr[tt]);
            const float sg = sigm(z); run += __logf(lbe + (1.0f - lbe) * sg); a[tt] = run; kc[tt] = (1.0f - lb) * (1.0f - sg); q[tt] = qv * sigm(qv); }
        QT[tq * 128 + k] = run;
        { LAS unsigned short* vp = (LAS unsigned short*)(VT + ((tid >> 6) * 8) * HG_P + (tid & 63) * 2);
          vp[0 * (HG_P / 2)] = (unsigned short)(vtw.x & 0xffffu); vp[1 * (HG_P / 2)] = (unsigned short)(vtw.x >> 16);
          vp[2 * (HG_P / 2)] = (unsigned short)(vtw.y & 0xffffu); vp[3 * (HG_P / 2)] = (unsigned short)(vtw.y >> 16);
          vp[4 * (HG_P / 2)] = (unsigned short)(vtw.z & 0xffffu); vp[5 * (HG_P / 2)] = (unsigned short)(vtw.z >> 16);
          vp[6 * (HG_P / 2)] = (unsigned short)(vtw.w & 0xffffu); vp[7 * (HG_P / 2)] = (unsigned short)(vtw.w >> 16); }
        __syncthreads();
        float off = 0.f; const float aref = QT[k] + QT[128 + k];
#pragma unroll
        for (int qq = 0; qq < 3; ++qq) { if (qq < tq) off += QT[qq * 128 + k]; }
        const float earef = __expf(aref);
#pragma unroll
        for (int tt = 0; tt < 16; ++tt) { const int t = tq * 16 + tt; const float e1 = __expf(off + a[tt] - aref), qa = q[tt] * e1;
            *(LAS unsigned short*)(QA + t * HG_PK + k * 2) = (unsigned short)f2bf(qa);
            *(LAS unsigned short*)(KB + t * HG_PK + k * 2) = (unsigned short)f2bf(kc[tt] * __builtin_amdgcn_rcpf(e1));
            *(LAS unsigned short*)(QE + t * HG_PK + k * 2) = (unsigned short)f2bf(qa * earef); }
        __syncthreads();
        if (unit + F.G < NU) HGC_LOAD(unit + F.G);
        f32x16 O;
#pragma unroll
        for (int r = 0; r < 16; ++r) O[r] = 0.f;
        if (wave < 4) {
#pragma unroll
            for (int st = 0; st < 2; ++st) {
                if (st <= tt_) {
                    f32x16 acc;
#pragma unroll
                    for (int r = 0; r < 16; ++r) acc[r] = 0.f;
#pragma unroll
                    for (int ks = 0; ks < 8; ++ks) { const s16x8 A = *(const LAS s16x8*)(KB + (32 * st + r32) * HG_PK + (16 * ks + 8 * hi) * 2);
                        const s16x8 B = *(const LAS s16x8*)(QA + (32 * tt_ + r32) * HG_PK + (16 * ks + 8 * hi) * 2);
                        acc = __builtin_amdgcn_mfma_f32_32x32x16_bf16(A, B, acc, 0, 0, 0); }
                    if (st == tt_) {
#pragma unroll
                        for (int r = 0; r < 16; ++r) { if ((r & 3) + 8 * (r >> 2) + 4 * hi > r32) acc[r] = 0.f; } }
#pragma unroll
                    for (int s2 = 0; s2 < 2; ++s2) {
                        v4u pw; pw.x = pg8::cvt_pk_bf16(acc[8 * s2 + 0], acc[8 * s2 + 1]); pw.y = pg8::cvt_pk_bf16(acc[8 * s2 + 2], acc[8 * s2 + 3]);
                        pw.z = pg8::cvt_pk_bf16(acc[8 * s2 + 4], acc[8 * s2 + 5]); pw.w = pg8::cvt_pk_bf16(acc[8 * s2 + 6], acc[8 * s2 + 7]);
                        const int kb = (32 * st + 16 * s2 + 4 * hi) * 2;
                        const s16x4 lo = *(const LAS s16x4*)(VT + (32 * vt + r32) * HG_P + kb), hh = *(const LAS s16x4*)(VT + (32 * vt + r32) * HG_P + kb + 16);
                        O = __builtin_amdgcn_mfma_f32_32x32x16_bf16(__builtin_shufflevector(lo, hh, 0, 1, 2, 3, 4, 5, 6, 7), __builtin_bit_cast(s16x8, pw), O, 0, 0, 0);
                    }
                }
            }
#pragma unroll
            for (int ks = 0; ks < 8; ++ks) { const s16x8 B = *(const LAS s16x8*)(QE + (32 * tt_ + r32) * HG_PK + (16 * ks + 8 * hi) * 2);
                O = __builtin_amdgcn_mfma_f32_32x32x16_bf16(sf[ks], B, O, 0, 0, 0); }
            float ss = 0.f;
#pragma unroll
            for (int r = 0; r < 16; ++r) ss += O[r] * O[r];
            ss = xor32_sum(ss);
            if (hi == 0) SSQ[vt * 64 + 32 * tt_ + r32] = ss;
        }
        __syncthreads();
        if (wave < 4) {
            const float rstd = 1.0f / sqrtf((SSQ[32 * tt_ + r32] + SSQ[64 + 32 * tt_ + r32]) * (1.0f / HG_DV) + NORM_EPS);
            const size_t row = row0 + 32 * tt_ + r32;
#pragma unroll
            for (int rg = 0; rg < 4; ++rg) { const int v = 32 * vt + 8 * rg + 4 * hi;
                const f32x4 nv = nwv[rg];
                const float g0 = blo(gw[rg].x), g1 = bhi(gw[rg].x), g2 = blo(gw[rg].y), g3 = bhi(gw[rg].y);
                u32x2 w; w.x = pg8::cvt_pk_bf16(O[4 * rg] * rstd * nv.x * g0 * sigm(g0), O[4 * rg + 1] * rstd * nv.y * g1 * sigm(g1));
                w.y = pg8::cvt_pk_bf16(O[4 * rg + 2] * rstd * nv.z * g2 * sigm(g2), O[4 * rg + 3] * rstd * nv.w * g3 * sigm(g3));
                *(u32x2*)(FH + row * 512 + h * HG_DV + v) = w; }
        }
    }
#undef HGC_LOAD
    __syncthreads();
}


__device__ __forceinline__ void phase_hgrn_a3(Frame& F, int l) {
    PHASE_TID();
    LAS unsigned char* KDT = F.lds; LAS unsigned char* VT = F.lds + 18432; LAS float* QT = (LAS float*)(F.lds + 27648);
    const bf16* main_ = (const bf16*)(F.ws + WS_BIG); bf16* UTB = (bf16*)(F.ws + WS_UT); float* DD = (float*)(F.ws + WS_DD);
    const int k = tid & 127, tq = tid >> 7, r32 = lane & 31, hi = lane >> 5;
    constexpr int NU = BATCH * HG_H * HG_NC;
    bf16 zr[16]; v4u vtw = (v4u){0u, 0u, 0u, 0u}; float lg0 = 0.f, lg1 = 0.f;
#define HGA_LOAD(u_) do { const int c_ = (u_) & (HG_NC - 1), bh_ = (u_) >> 8, h_ = bh_ & 7, b_ = bh_ >> 3; const size_t r0_ = (size_t)b_ * SEQ + (size_t)c_ * HG_C; \
        _Pragma("unroll") for (int tt = 0; tt < 16; ++tt) zr[tt] = main_[(r0_ + tq * 16 + tt) * N_MAIN + C_RF + h_ * HG_DK + k]; \
        vtw = *(const v4u*)(main_ + (r0_ + (tid & 63)) * N_MAIN + C_RI + h_ * HG_DV + (tid >> 6) * 8); lg0 = F.in[10][h_ * HG_DK + k]; lg1 = F.in[10][HG_H * HG_DK + h_ * HG_DK + k]; } while (0)
    int unit = F.bid;
    if (unit < NU) HGA_LOAD(unit);
    for (; unit < NU; unit += F.G) {
        const float lb = hgrn_lb2(lg0, lg1, l), lbe = fmaxf(lb, 1e-20f);
        float a[16], kc[16]; float run = 0.f;
#pragma unroll
        for (int tt = 0; tt < 16; ++tt) { const float z = bf2f(zr[tt]); const float sg = sigm(z); run += __logf(lbe + (1.0f - lbe) * sg); a[tt] = run; kc[tt] = (1.0f - lb) * (1.0f - sg); }
        QT[tq * 128 + k] = run;
        { LAS unsigned short* vp = (LAS unsigned short*)(VT + ((tid >> 6) * 8) * HG_P + (tid & 63) * 2);
          vp[0 * (HG_P / 2)] = (unsigned short)(vtw.x & 0xffffu); vp[1 * (HG_P / 2)] = (unsigned short)(vtw.x >> 16);
          vp[2 * (HG_P / 2)] = (unsigned short)(vtw.y & 0xffffu); vp[3 * (HG_P / 2)] = (unsigned short)(vtw.y >> 16);
          vp[4 * (HG_P / 2)] = (unsigned short)(vtw.z & 0xffffu); vp[5 * (HG_P / 2)] = (unsigned short)(vtw.z >> 16);
          vp[6 * (HG_P / 2)] = (unsigned short)(vtw.w & 0xffffu); vp[7 * (HG_P / 2)] = (unsigned short)(vtw.w >> 16); }
        __syncthreads();
        if (unit + F.G < NU) HGA_LOAD(unit + F.G);
        float off = 0.f, tot = 0.f;
#pragma unroll
        for (int q = 0; q < 4; ++q) { const float x = QT[q * 128 + k]; if (q < tq) off += x; tot += x; }
        float kd[16];
#pragma unroll
        for (int tt = 0; tt < 16; ++tt) kd[tt] = kc[tt] * __expf(tot - (off + a[tt]));
        { v4u w0, w1; w0.x = pg8::cvt_pk_bf16(kd[0], kd[1]); w0.y = pg8::cvt_pk_bf16(kd[2], kd[3]); w0.z = pg8::cvt_pk_bf16(kd[4], kd[5]); w0.w = pg8::cvt_pk_bf16(kd[6], kd[7]);
          w1.x = pg8::cvt_pk_bf16(kd[8], kd[9]); w1.y = pg8::cvt_pk_bf16(kd[10], kd[11]); w1.z = pg8::cvt_pk_bf16(kd[12], kd[13]); w1.w = pg8::cvt_pk_bf16(kd[14], kd[15]);
          *(LAS v4u*)(KDT + k * HG_P + tq * 32) = w0; *(LAS v4u*)(KDT + k * HG_P + tq * 32 + 16) = w1; }
        if (tq == 0) DD[(size_t)unit * 128 + k] = __expf(tot);
        __syncthreads();
        { const int kt = wave >> 1, vt = wave & 1;
          f32x16 acc;
#pragma unroll
          for (int r = 0; r < 16; ++r) acc[r] = 0.f;
#pragma unroll
          for (int ks = 0; ks < 4; ++ks) { const s16x8 A = *(const LAS s16x8*)(KDT + (32 * kt + r32) * HG_P + (16 * ks + 8 * hi) * 2);
              const s16x8 B = *(const LAS s16x8*)(VT + (32 * vt + r32) * HG_P + (16 * ks + 8 * hi) * 2);
              acc = __builtin_amdgcn_mfma_f32_32x32x16_bf16(A, B, acc, 0, 0, 0); }
          bf16* up = UTB + (size_t)unit * 8192 + (32 * vt + r32) * 128 + 32 * kt + 4 * hi;
#pragma unroll
          for (int rg = 0; rg < 4; ++rg) { u32x2 w; w.x = pg8::cvt_pk_bf16(acc[4 * rg], acc[4 * rg + 1]); w.y = pg8::cvt_pk_bf16(acc[4 * rg + 2], acc[4 * rg + 3]); *(u32x2*)(up + 8 * rg) = w; } }
        __syncthreads();
    }
#undef HGA_LOAD
}

#if MK_CHECK
constexpr int CW_CHK = 64;
__device__ __forceinline__ float bfr(float f) { return __uint_as_float(f2bf(f) << 16); }
__device__ __forceinline__ float dot_ar_wc(const bf16* arow, const float* W, int K, int N, int c) {
    float s = 0.f;
#pragma unroll 8
    for (int k = 0; k < K; ++k) s += bf2f(arow[k]) * bfr(W[(size_t)k * N + c]);
    return s;
}
__device__ __forceinline__ bool chk_bad(float got, float ref) { return !(fabsf(got - ref) <= 0.04f + 0.03f * fabsf(ref)); }
__device__ __forceinline__ void chk_report(Frame& F, int ph, bool fail) { if (fail) atomicMax((unsigned*)(F.ws + WS_CTL) + CW_CHK, (unsigned)(NPHASES - ph)); }
__device__ __forceinline__ void chk_rc(int tid, int ph, int N, int& r, int& c) {
    unsigned h1 = ((unsigned)tid + 1u) * 2654435761u + (unsigned)ph * 40503u; h1 ^= h1 >> 15; h1 *= 0x85ebca6bu; h1 ^= h1 >> 13;
    unsigned h2 = ((unsigned)tid + 77u) * 0x9E3779B1u + (unsigned)ph * 7919u; h2 ^= h2 >> 16; h2 *= 0xc2b2ae35u; h2 ^= h2 >> 13;
    r = (int)(h1 % (unsigned)M); c = (int)(h2 % (unsigned)N);
    if (tid == 0) r = 0; if (tid == 1) r = M - 1; if (tid == 2) r = SEQ - 1; if (tid == 3) r = SEQ; if (tid == 4) r = M - 300; if (tid == 5) r = 31500;
}
__device__ __forceinline__ float chk_rstd_bf(const bf16* row) { float ss = 0.f; for (int k = 0; k < D_MODEL; ++k) { const float v = bf2f(row[k]); ss += v * v; } return 1.0f / sqrtf(ss * (1.0f / D_MODEL) + NORM_EPS); }
__device__ __forceinline__ float chk_rstd_f(const float* row) { float ss = 0.f; for (int k = 0; k < D_MODEL; ++k) { const float v = row[k]; ss += v * v; } return 1.0f / sqrtf(ss * (1.0f / D_MODEL) + NORM_EPS); }
__device__ __forceinline__ void chk_x16(Frame& F, int ph) {
    PHASE_TID(); int r, c; chk_rc(tid, ph, D_MODEL, r, c);
    const float* x = F.in[0];
    bool fail = chk_bad(bf2f(((const bf16*)(F.ws + WS_X16))[(size_t)r * D_MODEL + c]), x[(size_t)r * D_MODEL + c]);
    const float rr = chk_rstd_f(x + (size_t)r * D_MODEL), rg = ((const float*)(F.ws + WS_RS))[r];
    fail = fail || !(fabsf(rg - rr) <= 0.002f * rr);
    chk_report(F, ph, fail);
}
__device__ __forceinline__ float dot_ar_wc_g(const bf16* arow, const float* W, int K, int N, int c, const float* gain) {
    float s = 0.f;
#pragma unroll 8
    for (int k = 0; k < K; ++k) s += bf2f(arow[k]) * bfr(W[(size_t)k * N + c] * (gain ? gain[k] : 1.0f));
    return s;
}
__device__ __forceinline__ void chk_gu(Frame& F, int ph, const float* Wgu, const float* gain) {
    PHASE_TID(); int r, j; chk_rc(tid, ph, D_FF, r, j);
    const bf16* a = (const bf16*)(F.ws + WS_X16) + (size_t)r * D_MODEL; const float rs = ((const float*)(F.ws + WS_RS))[r];
    const float g = rs * dot_ar_wc_g(a, Wgu, D_MODEL, 2 * D_FF, j, gain), u = rs * dot_ar_wc_g(a, Wgu, D_MODEL, 2 * D_FF, D_FF + j, gain);
    chk_report(F, ph, chk_bad(bf2f(((const bf16*)(F.ws + WS_BIG))[(size_t)r * D_FF + j]), g * sigm(g) * u));
}
__device__ __forceinline__ void chk_plain(Frame& F, int ph, const bf16* A, int K, const float* W, int NW, int coff, const bf16* OUT, int N, int act, const float* gain) {
    PHASE_TID(); int r, c; chk_rc(tid, ph, N, r, c);
    float ref = dot_ar_wc_g(A + (size_t)r * K, W, K, NW, coff + c, gain); if (gain) ref *= ((const float*)(F.ws + WS_RS))[r]; if (act == 2) ref = sigm(ref);
    chk_report(F, ph, chk_bad(bf2f(OUT[(size_t)r * N + c]), ref));
}
__device__ __forceinline__ void chk_norm(Frame& F, int ph, float alpha, const float* wpost, bool final_) {
    PHASE_TID(); int r, c; chk_rc(tid, ph, D_MODEL, r, c);
    const bf16* y = (const bf16*)(F.ws + WS_Y) + (size_t)r * D_MODEL;
    const float xi = ((const float*)(F.ws + WS_END))[tid];
    const float ref = xi + alpha * bf2f(y[c]) * chk_rstd_bf(y) * wpost[c];
    bool fail;
    if (final_) fail = !(fabsf(F.out[(size_t)r * D_MODEL + c] - ref) <= 0.01f + 0.01f * fabsf(ref));
    else { const bf16* xr = (const bf16*)(F.ws + WS_X16) + (size_t)r * D_MODEL;
        fail = chk_bad(bf2f(xr[c]), ref);
        const float rr = chk_rstd_bf(xr), rg = ((const float*)(F.ws + WS_RS))[r]; fail = fail || !(fabsf(rg - rr) <= 0.01f * rr); }
    chk_report(F, ph, fail);
}
__device__ __forceinline__ void chk_save(Frame& F, int ph) {
    PHASE_TID(); int r, c; chk_rc(tid, ph, D_MODEL, r, c);
    ((float*)(F.ws + WS_END))[tid] = bf2f(((const bf16*)(F.ws + WS_X16))[(size_t)r * D_MODEL + c]);
}
__device__ __forceinline__ void chk_conv(Frame& F, int ph, int l) {
    PHASE_TID(); int r, c; chk_rc(tid, ph, CONV_WIDTH, r, c);
    const bf16* mn = (const bf16*)(F.ws + WS_BIG); const float* cw = F.in[8] + (size_t)l * 3 * CONV_WIDTH; const int t = r & (SEQ - 1);
    float y = 0.f;
    for (int j = 0; j < 3; ++j) if (t - j >= 0) { const bf16* rp = mn + (size_t)(r - j) * N_MAIN; y += cw[(2 - j) * CONV_WIDTH + c] * bf2f(rp[C_CC + c]) * bf2f(rp[C_CX + c]); }
    const float ref = bf2f(mn[(size_t)r * N_MAIN + C_CB + c]) * y;
    chk_report(F, ph, chk_bad(bf2f(((const bf16*)(F.ws + WS_FC))[(size_t)r * CONV_WIDTH + c]), ref));
}
__device__ __forceinline__ void chk_attn(Frame& F, int ph, int l) {
    PHASE_TID(); int r, c; chk_rc(tid, ph, 1024, r, c);
    const bf16* mn = (const bf16*)(F.ws + WS_BIG); const int h = c >> 6, d = c & 63, hk = h >> 3, t = r & (SEQ - 1);
    const float slope = exp2f(-0.5f * (float)(h + 1)), sink = F.in[9][l * NHEAD + h];
    const bf16* qp = mn + (size_t)r * N_MAIN + C_AQ + h * 64; const int jmax = t < 127 ? t : 127;
    float mx = sink;
    for (int j = 0; j <= jmax; ++j) { const bf16* kp = mn + (size_t)(r - j) * N_MAIN + C_AK + hk * 64; float s = 0.f; for (int e = 0; e < 64; ++e) s += bf2f(qp[e]) * bf2f(kp[e]); s = s * 0.125f - slope * (float)j; mx = fmaxf(mx, s); }
    float den = expf(sink - mx), acc = 0.f;
    for (int j = 0; j <= jmax; ++j) { const bf16* kp = mn + (size_t)(r - j) * N_MAIN + C_AK + hk * 64; float s = 0.f; for (int e = 0; e < 64; ++e) s += bf2f(qp[e]) * bf2f(kp[e]); s = s * 0.125f - slope * (float)j;
        const float p = expf(s - mx); den += p; acc += p * bf2f(mn[(size_t)(r - j) * N_MAIN + C_AV + hk * 64 + d]); }
    chk_report(F, ph, chk_bad(bf2f(((const bf16*)(F.ws + WS_FA))[(size_t)r * 1024 + c]), acc / den));
}
__device__ __forceinline__ void chk_hgrn(Frame& F, int ph, int l, int b, int h, int c0) {
    PHASE_TID();
    LAS float* L = (LAS float*)F.lds; LAS float* S = L; LAS float* PO = L + 8192;
    const bf16* mn = (const bf16*)(F.ws + WS_BIG); const bf16* FH = (const bf16*)(F.ws + WS_FH);
    const int v = tid & 63, kg = tid >> 6;
    for (int kk = 0; kk < 16; ++kk) { const int k = kg * 16 + kk; S[k * 64 + v] = c0 ? bf2f(((const bf16*)(F.ws + WS_UT))[(size_t)(((b * HG_H + h) << 8) + c0) * 8192 + v * 128 + k]) : 0.f; }
    __syncthreads();
    bool fail = false;
    for (int t = 0; t < 200; ++t) {
        const size_t row = (size_t)b * SEQ + (size_t)c0 * HG_C + t; const bf16* rp = mn + row * N_MAIN;
        const float iv = bf2f(rp[C_RI + h * 64 + v]); float po = 0.f;
        for (int kk = 0; kk < 16; ++kk) { const int k = kg * 16 + kk;
            const float lb = hgrn_lb(F.in[10], l, h * HG_DK + k), lbe = fmaxf(lb, 1e-20f);
            const float z = bf2f(rp[C_RF + h * HG_DK + k]), sg = 1.0f / (1.0f + expf(-z));
            const float f = lbe + (1.0f - lbe) * sg, kc = (1.0f - lb) * (1.0f - sg);
            const float qr = bf2f(rp[C_RQ + h * HG_DK + k]), qv = qr / (1.0f + expf(-qr));
            const float s = f * S[k * 64 + v] + kc * iv; S[k * 64 + v] = s; po += s * qv; }
        PO[kg * 64 + v] = po;
        __syncthreads();
        if (tid < 64) { float o = 0.f; for (int q = 0; q < 8; ++q) o += PO[q * 64 + tid];
            const float ss = wave_sum(o * o); const float gv = bf2f(rp[C_RG + h * 64 + tid]);
            const float ref = o * (1.0f / sqrtf(ss * (1.0f / 64.0f) + NORM_EPS)) * F.in[11][l * HG_DV + tid] * gv / (1.0f + expf(-gv));
            fail = fail || chk_bad(bf2f(FH[row * 512 + h * 64 + tid]), ref); }
        __syncthreads();
    }
    chk_report(F, ph, fail);
}
__device__ __forceinline__ void chk_merge(Frame& F, int ph, int l) {
    PHASE_TID(); int r, c; chk_rc(tid, ph, D_MODEL, r, c);
    const bf16* a = (const bf16*)(F.ws + WS_X16) + (size_t)r * D_MODEL; const float rs = ((const float*)(F.ws + WS_RS))[r];
    const float* Win = F.in[7] + (size_t)l * D_MODEL * D_IN; const float* gain = F.in[6] + l * D_MODEL;
    const bf16* YB = (const bf16*)(F.ws + WS_BIG);
    float ref = 0.f;
    for (int b = 0; b < 3; ++b) { const float g = sigm(rs * dot_ar_wc_g(a, Win, D_MODEL, D_IN, N_MAIN + b * D_MODEL + c, gain));
        ref += g * bf2f(YB[(size_t)b * M * D_MODEL + (size_t)r * D_MODEL + c]); }
    chk_report(F, ph, chk_bad(bf2f(((const bf16*)(F.ws + WS_MG))[(size_t)r * D_MODEL + c]), ref));
}
__device__ __forceinline__ void chk_ple(Frame& F, int ph, int l) {
    PHASE_TID(); int r, c; chk_rc(tid, ph, D_MODEL, r, c);
    const float y = dot_ar_wc((const bf16*)(F.ws + WS_PB) + (size_t)r * PLE_DIM, F.in[23] + (size_t)l * PLE_DIM * D_MODEL, PLE_DIM, D_MODEL, c);
    const float ref = bf2f(((const bf16*)(F.ws + WS_BIG))[(size_t)r * D_MODEL + c]) * y;
    chk_report(F, ph, chk_bad(bf2f(((const bf16*)(F.ws + WS_Y))[(size_t)r * D_MODEL + c]), ref));
}
#endif

__global__ void __launch_bounds__(NTHR, 2) fwd(Args args) {
    extern __shared__ __attribute__((aligned(16))) unsigned char lds[];
    Frame F0;
    F0.lds = (LAS unsigned char*)lds;
    F0.G = gridDim.x; F0.bid = blockIdx.x; F0.in = args.in; F0.out = args.out; F0.ws = args.ws; F0.wv = __builtin_amdgcn_readfirstlane((int)(threadIdx.x >> 6));
    unsigned char* ws0 = args.ws;
    volatile LAS unsigned* MISC = (volatile LAS unsigned*)(F0.lds + MISC_OFF);
    if (threadIdx.x < 32) MISC[threadIdx.x] = 0u;
    __syncthreads();
#if MK_ONE_LAUNCH
    XcdBarrier bar = xcd_barrier_post((unsigned*)(ws0 + WS_CTL) + CW_BAR, MISC + 8);
#if MK_BARTIME
#define GRID_BAR() do { unsigned long long t0_ = 0; if (threadIdx.x == 0) t0_ = __builtin_amdgcn_s_memrealtime(); xcd_barrier(bar); \
    if (threadIdx.x == 0) { const unsigned dt_ = (unsigned)(__builtin_amdgcn_s_memrealtime() - t0_); MISC[16] += dt_; if (cur_is_gemm) MISC[17] += dt_; } } while (0)
#else
#define GRID_BAR() xcd_barrier(bar)
#endif
#else
#define GRID_BAR() do {} while (0)
#endif
    const int lo = args.ph_lo, hi = args.ph_hi; const bool cur_is_gemm = false; (void)cur_is_gemm;
#define IN(k) (lo <= (k) && (k) < hi)
#if MK_CHECK
#define SEAM(k) do { if (IN(k)) GRID_BAR(); } while (0)
#define CHKL(kl, k, stmt) do { if (IN(k)) { if (((MK_CHECK_MASK >> (kl)) & 1) && F0.bid == 0) { PH_OPQ(); stmt; } GRID_BAR(); } } while (0)
#define CHKSAVE(k) do { if (F0.bid == 0) chk_save(F, (k)); GRID_BAR(); } while (0)
#else
#define CHKSAVE(k) do {} while (0)
#define SEAM(k) do { if (IN(k) && IN((k) + 1)) { const int kk_ = (k) % NPH; const bool cur_is_gemm = (kk_ == 1 || kk_ == 2 || kk_ == 4 || (kk_ >= 8 && kk_ <= 10) || kk_ == 12 || kk_ == 13 || kk_ == 15 || kk_ == 16); (void)cur_is_gemm; for (int rb_ = 0; rb_ < REP_BAR; ++rb_) GRID_BAR(); } } while (0)
#define CHKL(kl, k, stmt) do {} while (0)
#endif
#define PH_OPQ() Frame F = F0; unsigned char* ws = ws0; int l = l0; { asm volatile("" : "+s"(ws), "+s"(l)); F.ws = ws; } \
    bf16* X16 = (bf16*)(ws + WS_X16); bf16* Y = (bf16*)(ws + WS_Y); bf16* BIG = (bf16*)(ws + WS_BIG); bf16* MG = (bf16*)(ws + WS_MG); const float* RS = (const float*)(ws + WS_RS); \
    (void)X16; (void)Y; (void)BIG; (void)MG; (void)RS; (void)l
    using pg8::Gemm; using pg8::StaticOrder;
#if MK_GTIME
#define GT_BEGIN() unsigned long long gt0_ = 0; if (threadIdx.x == 0) gt0_ = __builtin_amdgcn_s_memrealtime()
#define GT_END() if (threadIdx.x == 0) MISC[18] += (unsigned)(__builtin_amdgcn_s_memrealtime() - gt0_)
#else
#define GT_BEGIN() do {} while (0)
#define GT_END() do {} while (0)
#endif
#define GEMM_RUN(EPI) { GT_BEGIN(); for (int rep_ = 0; rep_ < REP_GEMM; ++rep_) { pg8::gemm_phase<EPI, StaticOrder, PG8_ALIGN, PG8_SP2>(F.lds, g, S, E, F.wv); } GT_END(); }
#define NORM_RUN(k, alpha, wpost, fin) do { CHKSAVE(k); phase_norm(F, (alpha), (wpost), (fin), (k)); for (int rep_ = 1; rep_ < REP_NORM && !(fin); ++rep_) { GRID_BAR(); phase_norm(F, 0.0f, (wpost), (fin), (k)); } } while (0)

    for (int l0 = 0; l0 < DEPTH; ++l0) {
        const int P = l0 * NPH;
        if (IN(P + 0)) { PH_OPQ(); for (int rep_ = 0; rep_ < REP_CONV; ++rep_) phase_convert(F, l); } SEAM(P + 0); CHKL(0, P + 0, if (l == 0) chk_x16(F, P + 0));
        if (IN(P + 1)) { PH_OPQ(); Gemm g{X16, (const bf16*)(ws + WS_GU1), M, 2 * D_FF, D_MODEL}; StaticOrder S; S.init(M, 2 * D_FF, F.G, F.bid);
            pg8::EpiSwiglu E{BIG, D_FF, RS}; for (int dm_ = (MK_DUMMY ? 1 : 0); dm_ >= 0; --dm_) { S.dummy = dm_ ? MK_DUMMY : 0; GEMM_RUN(pg8::EpiSwiglu) if (dm_) GRID_BAR(); } } SEAM(P + 1); CHKL(1, P + 1, chk_gu(F, P + 1, F.in[3] + (size_t)l * D_MODEL * 2 * D_FF, F.in[2] + l * D_MODEL));
        if (IN(P + 2)) { PH_OPQ(); Gemm g{BIG, (const bf16*)(ws + WS_D1), M, D_MODEL, D_FF}; StaticOrder S; S.init(M, D_MODEL, F.G, F.bid, REV_DOWN);
            pg8::EpiBf16<0> E{Y, D_MODEL, nullptr}; GEMM_RUN(pg8::EpiBf16<0>) } SEAM(P + 2); CHKL(2, P + 2, chk_plain(F, P + 2, BIG, D_FF, F.in[4] + (size_t)l * D_FF * D_MODEL, D_MODEL, 0, Y, D_MODEL, 0, nullptr));
        if (IN(P + 3)) { PH_OPQ(); NORM_RUN(P + 3, 0.5f, F.in[5] + l * D_MODEL, false); } SEAM(P + 3); CHKL(3, P + 3, chk_norm(F, P + 3, 0.5f, F.in[5] + l * D_MODEL, false));
        if (IN(P + 4)) { PH_OPQ(); Gemm g{X16, (const bf16*)(ws + WS_WIN), M, N_MAIN, D_MODEL}; StaticOrder S; S.init(M, N_MAIN, F.G, F.bid);
            pg8::EpiBf16<0> E{BIG, N_MAIN, RS}; GEMM_RUN(pg8::EpiBf16<0>) } SEAM(P + 4); CHKL(4, P + 4, chk_plain(F, P + 4, X16, D_MODEL, F.in[7] + (size_t)l * D_MODEL * D_IN, D_IN, 0, BIG, N_MAIN, 0, F.in[6] + l * D_MODEL));
        for (int repm_ = 0; repm_ < REP_MIX; ++repm_) {
        if (IN(P + 5)) { PH_OPQ(); for (int r_ = 0; r_ < REP_CA; ++r_) { phase_conv(F, l); phase_attn_mfma(F, l); } for (int r_ = 0; r_ < REP_HA; ++r_) phase_hgrn_a3(F, l); } SEAM(P + 5); CHKL(5, P + 5, chk_conv(F, P + 5, l); chk_attn(F, P + 5, l));
        if (IN(P + 6)) { PH_OPQ(); phase_hgrn_scan2(F); } SEAM(P + 6);
        if (IN(P + 7)) { PH_OPQ(); for (int r_ = 0; r_ < REP_HC; ++r_) phase_hgrn_c3(F, l); } SEAM(P + 7); CHKL(7, P + 7, chk_hgrn(F, P + 7, l, 1, 5, 0); chk_hgrn(F, P + 7, l, 0, 2, 100); chk_hgrn(F, P + 7, l, 1, 7, 252));
        }
        if (IN(P + 8)) { PH_OPQ();
            StaticOrder S; S.init(M, D_MODEL, F.G, F.bid); GT_BEGIN();
            for (int rep_ = 0; rep_ < REP_GEMM * REP_P9; ++rep_) {
            { Gemm g{(const bf16*)(ws + WS_FC), (const bf16*)(ws + WS_BC), M, D_MODEL, CONV_WIDTH};
              pg8::EpiBf16<0> E{BIG, D_MODEL, nullptr}; pg8::gemm_phase<pg8::EpiBf16<0>, StaticOrder, PG8_ALIGN, PG8_SP2>(F.lds, g, S, E, F.wv); }
            { Gemm g{(const bf16*)(ws + WS_FA), (const bf16*)(ws + WS_BA), M, D_MODEL, 1024};
              pg8::EpiBf16<0> E{BIG + (size_t)M * D_MODEL, D_MODEL, nullptr}; pg8::gemm_phase<pg8::EpiBf16<0>, StaticOrder, PG8_ALIGN, PG8_SP2>(F.lds, g, S, E, F.wv); }
            { Gemm g{(const bf16*)(ws + WS_FH), (const bf16*)(ws + WS_BH), M, D_MODEL, 512};
              pg8::EpiBf16<0> E{BIG + (size_t)2 * M * D_MODEL, D_MODEL, nullptr}; pg8::gemm_phase<pg8::EpiBf16<0>, StaticOrder, PG8_ALIGN, PG8_SP2>(F.lds, g, S, E, F.wv); }
            } GT_END();
        } SEAM(P + 8); CHKL(8, P + 8, chk_plain(F, P + 8, (const bf16*)(ws + WS_FC), CONV_WIDTH, F.in[12] + (size_t)l * CONV_WIDTH * D_MODEL, D_MODEL, 0, BIG, D_MODEL, 0, nullptr);
                                  chk_plain(F, P + 8, (const bf16*)(ws + WS_FA), 1024, F.in[13] + (size_t)l * 1024 * D_MODEL, D_MODEL, 0, BIG + (size_t)M * D_MODEL, D_MODEL, 0, nullptr);
                                  chk_plain(F, P + 8, (const bf16*)(ws + WS_FH), 512, F.in[14] + (size_t)l * 512 * D_MODEL, D_MODEL, 0, BIG + (size_t)2 * M * D_MODEL, D_MODEL, 0, nullptr));
        if (IN(P + 9)) { PH_OPQ(); Gemm g{X16, (const bf16*)(ws + WS_WIN) + (size_t)N_MAIN * D_MODEL, M, N_GATES, D_MODEL}; pg8::MergeOrder S; S.base.init(M, D_MODEL, F.G, F.bid);
            pg8::EpiGateMerge E{BIG, MG, RS, (size_t)M * D_MODEL};
            { GT_BEGIN(); for (int rep_ = 0; rep_ < REP_GEMM; ++rep_) { pg8::gemm_phase<pg8::EpiGateMerge, pg8::MergeOrder, PG8_ALIGN, PG8_SP2>(F.lds, g, S, E, F.wv); } GT_END(); } } SEAM(P + 9); CHKL(9, P + 9, chk_merge(F, P + 9, l));
        if (IN(P + 10)) { PH_OPQ(); Gemm g{MG, (const bf16*)(ws + WS_WO), M, D_MODEL, D_MODEL}; StaticOrder S; S.init(M, D_MODEL, F.G, F.bid);
            pg8::EpiBf16<0> E{Y, D_MODEL, nullptr}; GEMM_RUN(pg8::EpiBf16<0>) } SEAM(P + 10); CHKL(10, P + 10, chk_plain(F, P + 10, MG, D_MODEL, F.in[15] + (size_t)l * D_MODEL * D_MODEL, D_MODEL, 0, Y, D_MODEL, 0, nullptr));
        if (IN(P + 11)) { PH_OPQ(); NORM_RUN(P + 11, 1.0f, F.in[16] + l * D_MODEL, false); } SEAM(P + 11); CHKL(11, P + 11, chk_norm(F, P + 11, 1.0f, F.in[16] + l * D_MODEL, false));
        if (IN(P + 12)) { PH_OPQ(); Gemm g{X16, (const bf16*)(ws + WS_GU2), M, 2 * D_FF, D_MODEL}; StaticOrder S; S.init(M, 2 * D_FF, F.G, F.bid);
            pg8::EpiSwiglu E{BIG, D_FF, RS}; GEMM_RUN(pg8::EpiSwiglu) } SEAM(P + 12); CHKL(12, P + 12, chk_gu(F, P + 12, F.in[18] + (size_t)l * D_MODEL * 2 * D_FF, F.in[17] + l * D_MODEL));
        if (IN(P + 13)) { PH_OPQ(); Gemm g{BIG, (const bf16*)(ws + WS_D2), M, D_MODEL, D_FF}; StaticOrder S; S.init(M, D_MODEL, F.G, F.bid, REV_DOWN);
            pg8::EpiBf16<0> E{Y, D_MODEL, nullptr}; GEMM_RUN(pg8::EpiBf16<0>) } SEAM(P + 13); CHKL(13, P + 13, chk_plain(F, P + 13, BIG, D_FF, F.in[19] + (size_t)l * D_FF * D_MODEL, D_MODEL, 0, Y, D_MODEL, 0, nullptr));
        if (IN(P + 14)) { PH_OPQ(); NORM_RUN(P + 14, 0.5f, F.in[20] + l * D_MODEL, false); } SEAM(P + 14); CHKL(14, P + 14, chk_norm(F, P + 14, 0.5f, F.in[20] + l * D_MODEL, false));
        if (IN(P + 15)) { PH_OPQ(); Gemm g{X16, (const bf16*)(ws + WS_PG), M, D_MODEL, D_MODEL}; StaticOrder S; S.init(M, D_MODEL, F.G, F.bid);
            pg8::EpiBf16<2> E{BIG, D_MODEL, RS}; GEMM_RUN(pg8::EpiBf16<2>) } SEAM(P + 15); CHKL(15, P + 15, chk_plain(F, P + 15, X16, D_MODEL, F.in[22] + (size_t)l * D_MODEL * D_MODEL, D_MODEL, 0, BIG, D_MODEL, 2, F.in[21] + l * D_MODEL));
        if (IN(P + 16)) { PH_OPQ(); Gemm g{(const bf16*)(ws + WS_PB), (const bf16*)(ws + WS_PP), M, D_MODEL, PLE_DIM}; StaticOrder S; S.init(M, D_MODEL, F.G, F.bid);
            pg8::EpiGateMul E{BIG, D_MODEL, Y, D_MODEL, 0}; GEMM_RUN(pg8::EpiGateMul) } SEAM(P + 16); CHKL(16, P + 16, chk_ple(F, P + 16, l));
        if (IN(P + 17)) { PH_OPQ(); NORM_RUN(P + 17, 1.0f, F.in[24] + l * D_MODEL, l + 1 == DEPTH); } SEAM(P + 17); CHKL(17, P + 17, chk_norm(F, P + 17, 1.0f, F.in[24] + l * D_MODEL, l + 1 == DEPTH));
    }
#if MK_CHECK
    if (F0.bid == 0 && threadIdx.x == 0) { const unsigned v = __hip_atomic_load((unsigned*)(ws0 + WS_CTL) + CW_CHK, __ATOMIC_RELAXED, __HIP_MEMORY_SCOPE_AGENT); if (v) F0.out[0] = 1000.0f * (float)v;
        const unsigned v2 = __hip_atomic_load((unsigned*)(ws0 + WS_CTL) + 65, __ATOMIC_RELAXED, __HIP_MEMORY_SCOPE_AGENT);
        if (v2 && !v) { const unsigned n = __hip_atomic_load((unsigned*)(ws0 + WS_CTL) + 128 + (NPHASES - v2), __ATOMIC_RELAXED, __HIP_MEMORY_SCOPE_AGENT); F0.out[1] = 100.0f + (float)n; } }
#endif
#if MK_GTIME
    GRID_BAR();
    if (threadIdx.x == 0) atomicAdd((unsigned*)(ws0 + WS_CTL) + 72, MISC[18]);
    GRID_BAR();
    if (F0.bid == 0 && threadIdx.x == 0) { const unsigned tot = __hip_atomic_load((unsigned*)(ws0 + WS_CTL) + 72, __ATOMIC_RELAXED, __HIP_MEMORY_SCOPE_AGENT);
        const float T = (float)tot * 0.01f / (float)F0.G;
        F0.out[0] = (T - GT_BASE) * 0.1f; }
#endif
#if MK_BARTIME
    { const bool cur_is_gemm = false; GRID_BAR(); }
    if (threadIdx.x == 0) { atomicAdd((unsigned*)(ws0 + WS_CTL) + 70, MISC[16]); atomicAdd((unsigned*)(ws0 + WS_CTL) + 71, MISC[17]); }
    { const bool cur_is_gemm = false; GRID_BAR(); }
    if (F0.bid == 0) { const unsigned tot = __hip_atomic_load((unsigned*)(ws0 + WS_CTL) + 70, __ATOMIC_RELAXED, __HIP_MEMORY_SCOPE_AGENT), tg = __hip_atomic_load((unsigned*)(ws0 + WS_CTL) + 71, __ATOMIC_RELAXED, __HIP_MEMORY_SCOPE_AGENT);
        const float V = (float)tot * 0.01f / (float)F0.G, W = (float)tg * 0.01f / (float)F0.G;
        if (threadIdx.x == 0) F0.out[0] = V + 100.0f;
        for (int i = threadIdx.x; i < 100000; i += NTHR) F0.out[(size_t)(i + 1) * 64 + 5] += W * 0.1f; }
#endif
#undef IN
#undef SEAM
}

extern "C" void kernel_launch(void* const* d_in, const int* in_sizes, int n_in, void* d_out, int out_size, void* d_ws, size_t ws_size, hipStream_t stream) {
    static int grid = 0;
    if (grid == 0) {
        if (n_in != 25 || in_sizes[0] != M * D_MODEL || out_size != M * D_MODEL || ws_size < WS_END) {
            fprintf(stderr, "kernel_launch: unexpected shapes (n_in %d, in0 %d, out %d, ws %zu < %zu); nothing launched\n", n_in, n_in > 0 ? in_sizes[0] : -1, out_size, ws_size, (size_t)WS_END); grid = -1; return; }
        int dev = 0, cus = 0, per_cu = 0;
        if (hipGetDevice(&dev) != hipSuccess || hipDeviceGetAttribute(&cus, hipDeviceAttributeMultiprocessorCount, dev) != hipSuccess) { grid = -1; return; }
        if (hipFuncSetAttribute((const void*)fwd, hipFuncAttributeMaxDynamicSharedMemorySize, LDS_BYTES) != hipSuccess) { fprintf(stderr, "kernel_launch: hipFuncSetAttribute failed\n"); grid = -1; return; }
        if (hipOccupancyMaxActiveBlocksPerMultiprocessor(&per_cu, (const void*)fwd, NTHR, LDS_BYTES) != hipSuccess || per_cu < 1)
            fprintf(stderr, "kernel_launch: note: occupancy query reports %d workgroups per CU\n", per_cu);
        (void)hipGetLastError();
        grid = cus;
    }
    if (grid < 0) return;
    if (hipMemsetAsync((char*)d_ws + WS_CTL, 0, CTL_ZERO_BYTES, stream) != hipSuccess) { fprintf(stderr, "kernel_launch: memset failed\n"); return; }
    Args a{};
    for (int i = 0; i < 25; ++i) a.in[i] = (const float*)d_in[i];
    a.out = (float*)d_out; a.ws = (unsigned char*)d_ws;
#if MK_ONE_LAUNCH
    a.ph_lo = 0; a.ph_hi = NPHASES;
    hipLaunchKernelGGL(fwd, dim3(grid), dim3(NTHR), LDS_BYTES, stream, a);
#else
    for (int ph = 0; ph < NPHASES; ++ph) {
        a.ph_lo = ph; a.ph_hi = ph + 1;
        hipLaunchKernelGGL(fwd, dim3(grid), dim3(NTHR), LDS_BYTES, stream, a);
    }
#endif
    const hipError_t le = hipPeekAtLastError();
    if (le != hipSuccess) fprintf(stderr, "kernel_launch: launch failed: %s\n", hipGetErrorName(le));
}
```

```cpp
#include <hip/hip_runtime.h>
#include <cstdio>
#include <cstdint>

#ifndef MK_CHECK
#define MK_CHECK 0
#endif
#ifndef MK_CHECK_MASK
#define MK_CHECK_MASK 0x3ffff
#endif
#ifndef MK_ONE_LAUNCH
#define MK_ONE_LAUNCH 1
#endif
#ifndef WGM_WIDE
#define WGM_WIDE 4
#endif
#ifndef WGM_NARROW
#define WGM_NARROW 4
#endif

namespace pg8 {
#define PG8_LAS __attribute__((address_space(3)))
typedef unsigned short bf16_t;
typedef short bf16x8 __attribute__((ext_vector_type(8)));
typedef float f32x4 __attribute__((ext_vector_type(4)));
typedef unsigned u32x4 __attribute__((ext_vector_type(4)));
constexpr int BM = 256, BK = 64, HALF = 128, HTB = HALF * BK * 2  , STAGE_BYTES = 8 * HTB, NXCD = 8;

__host__ __device__ __forceinline__ int lds_byte(int r, int c) { const int st = (r >> 4) * 2 + (c >> 5), rr = r & 15, cc = c & 31, ob = rr * 64 + cc * 2; return st * 1024 + (ob ^ (((ob >> 9) & 1) << 5)); }
__host__ __device__ __forceinline__ void stage_rc(int b, int& R, int& C) { const int st = b / 1024, sb = b % 1024, swz = sb ^ (((sb >> 9) & 1) << 5); R = (st >> 1) * 16 + swz / 64; C = (st & 1) * 32 + (swz % 64) / 2; }
__host__ __device__ __forceinline__ int perm32(int rho) { const int n = rho >> 4, i = rho & 15; return 8 * (i >> 2) + 4 * n + (i & 3); }

struct Unit { int pm, pn; };
struct Gemm { const bf16_t* A; const bf16_t* Bt; int M, N, K; };

struct StaticOrder {
    int nM, nN, nwg, G, c, WGM;
    __host__ __device__ void init(int M, int N, int G_, int c_) { nM = M / BM; nN = N / BM; nwg = nM * nN; G = G_; c = c_; WGM = (nN > 8) ? WGM_WIDE : WGM_NARROW; }
    __host__ __device__ bool next(int i, Unit& u) const {
        const long L = (long)i * G + c; if (L >= nwg) return false;
        int wgid = (int)L; { const int q = nwg / NXCD, r = nwg % NXCD, xcd = wgid % NXCD, off = wgid / NXCD; wgid = (xcd < r ? xcd * (q + 1) : r * (q + 1) + (xcd - r) * q) + off; }
        const int nig = WGM * nN, gid = wgid / nig, fm = gid * WGM, gsz = (nM - fm) < WGM ? (nM - fm) : WGM;
        u.pm = fm + ((wgid % nig) % gsz); u.pn = (wgid % nig) / gsz; return true;
    }
    __device__ __forceinline__ void a_ready(const Unit&) const {}
    __device__ __forceinline__ void done(const Unit&) const {}
};

typedef float f32x2_t __attribute__((ext_vector_type(2))); typedef __bf16 bf16x2_t __attribute__((ext_vector_type(2)));
__device__ __forceinline__ unsigned cvt_pk_bf16(float lo, float hi) { f32x2_t v = {lo, hi}; bf16x2_t b = __builtin_convertvector(v, bf16x2_t); return __builtin_bit_cast(unsigned, b); }
__device__ __forceinline__ float bf_lo(unsigned w) { return __uint_as_float(w << 16); }
__device__ __forceinline__ float bf_hi(unsigned w) { return __uint_as_float(w & 0xffff0000u); }
__device__ __forceinline__ float sigmoidf_(float v) { return __builtin_amdgcn_rcpf(1.0f + __builtin_amdgcn_exp2f(-1.4426950408889634f * v)); }

#define EPI_STORE16(p, v) __builtin_nontemporal_store((v), (u32x4*)(p))
template <int ACT> struct EpiBf16 {
    static constexpr bool PERM = true, AFTER_DRAIN = false;
    bf16_t* O; int ldc; const float* rs;
    __device__ __forceinline__ void operator()(const f32x4 (&acc)[2][2][4][2], const Unit& u, int wr, int wc, int fr_, int fq_) const {
        (void)fr_; (void)fq_; unsigned z_ = 0u; asm volatile("" : "+s"(z_)); const int ln_ = (int)__builtin_amdgcn_mbcnt_hi(~0u, __builtin_amdgcn_mbcnt_lo(~0u, z_)), fr = ln_ & 15, fq = ln_ >> 4;
        const int row0 = u.pm * BM + wr * 64 + fr, col0 = u.pn * BM + wc * 32 + 8 * fq;
#pragma unroll
        for (int ai = 0; ai < 2; ++ai)
#pragma unroll
            for (int m = 0; m < 4; ++m) { const int row = row0 + ai * HALF + m * 16; bf16_t* rowp = O + (size_t)row * ldc + col0;
                const float sc = rs ? rs[row] : 1.0f;
#pragma unroll
                for (int bj = 0; bj < 2; ++bj) { f32x4 v0 = acc[ai][bj][m][0] * sc, v1 = acc[ai][bj][m][1] * sc;
                    if (ACT == 2) {
#pragma unroll
                        for (int e = 0; e < 4; ++e) { v0[e] = sigmoidf_(v0[e]); v1[e] = sigmoidf_(v1[e]); } }
                    u32x4 w; w.x = cvt_pk_bf16(v0[0], v0[1]); w.y = cvt_pk_bf16(v0[2], v0[3]); w.z = cvt_pk_bf16(v1[0], v1[1]); w.w = cvt_pk_bf16(v1[2], v1[3]);
                    EPI_STORE16(rowp + bj * HALF, w); } }
    }
};
struct EpiSwiglu {
    static constexpr bool PERM = true, AFTER_DRAIN = false;
    bf16_t* H; int ldh; const float* rs;
    __device__ __forceinline__ void operator()(const f32x4 (&acc)[2][2][4][2], const Unit& u, int wr, int wc, int fr_, int fq_) const {
        (void)fr_; (void)fq_; unsigned z_ = 0u; asm volatile("" : "+s"(z_)); const int ln_ = (int)__builtin_amdgcn_mbcnt_hi(~0u, __builtin_amdgcn_mbcnt_lo(~0u, z_)), fr = ln_ & 15, fq = ln_ >> 4;
        const int row0 = u.pm * BM + wr * 64 + fr, col0 = u.pn * HALF + wc * 32 + 8 * fq;
#pragma unroll
        for (int ai = 0; ai < 2; ++ai)
#pragma unroll
            for (int m = 0; m < 4; ++m) { const int row = row0 + ai * HALF + m * 16; bf16_t* rowp = H + (size_t)row * ldh + col0;
                const float sc = rs[row];
                f32x4 h0, h1;
#pragma unroll
                for (int e = 0; e < 4; ++e) { const float g0 = acc[ai][0][m][0][e] * sc, g1 = acc[ai][0][m][1][e] * sc;
                    h0[e] = g0 * sigmoidf_(g0) * (acc[ai][1][m][0][e] * sc); h1[e] = g1 * sigmoidf_(g1) * (acc[ai][1][m][1][e] * sc); }
                u32x4 w; w.x = cvt_pk_bf16(h0[0], h0[1]); w.y = cvt_pk_bf16(h0[2], h0[3]); w.z = cvt_pk_bf16(h1[0], h1[1]); w.w = cvt_pk_bf16(h1[2], h1[3]);
                EPI_STORE16(rowp, w); }
    }
};
struct EpiGateMerge {
    static constexpr bool PERM = true, AFTER_DRAIN = false;
    const bf16_t* YB; bf16_t* MG; const float* rs; size_t ystride;
    __device__ __forceinline__ void operator()(const f32x4 (&acc)[2][2][4][2], const Unit& u, int wr, int wc, int fr_, int fq_) const {
        (void)fr_; (void)fq_; unsigned z_ = 0u; asm volatile("" : "+s"(z_)); const int ln_ = (int)__builtin_amdgcn_mbcnt_hi(~0u, __builtin_amdgcn_mbcnt_lo(~0u, z_)), fr = ln_ & 15, fq = ln_ >> 4;
        const int b = u.pn >> 3, pn8 = u.pn & 7;
        const int row0 = u.pm * BM + wr * 64 + fr, col0 = pn8 * BM + wc * 32 + 8 * fq;
        const bf16_t* yb = YB + (size_t)b * ystride;
#pragma unroll
        for (int ai = 0; ai < 2; ++ai)
#pragma unroll
            for (int mp = 0; mp < 2; ++mp) {
                u32x4 yw[2][2], ow[2][2]; float sc[2];
#pragma unroll
                for (int mm = 0; mm < 2; ++mm) { const int row = row0 + ai * HALF + (2 * mp + mm) * 16; const int off = row * 2048 + col0; sc[mm] = rs[row];
#pragma unroll
                    for (int bj = 0; bj < 2; ++bj) { yw[mm][bj] = *(const u32x4*)(yb + off + bj * HALF); ow[mm][bj] = (u32x4){0u, 0u, 0u, 0u}; if (b) ow[mm][bj] = *(const u32x4*)(MG + off + bj * HALF); } }
#pragma unroll
                for (int mm = 0; mm < 2; ++mm) { const int m = 2 * mp + mm; const int row = row0 + ai * HALF + m * 16; const int off = row * 2048 + col0;
#pragma unroll
                    for (int bj = 0; bj < 2; ++bj) { const f32x4 a0 = acc[ai][bj][m][0], a1 = acc[ai][bj][m][1]; const u32x4 y = yw[mm][bj], o = ow[mm][bj]; const float s = sc[mm];
                        u32x4 w;
                        w.x = cvt_pk_bf16(fmaf(sigmoidf_(a0[0] * s), bf_lo(y.x), bf_lo(o.x)), fmaf(sigmoidf_(a0[1] * s), bf_hi(y.x), bf_hi(o.x)));
                        w.y = cvt_pk_bf16(fmaf(sigmoidf_(a0[2] * s), bf_lo(y.y), bf_lo(o.y)), fmaf(sigmoidf_(a0[3] * s), bf_hi(y.y), bf_hi(o.y)));
                        w.z = cvt_pk_bf16(fmaf(sigmoidf_(a1[0] * s), bf_lo(y.z), bf_lo(o.z)), fmaf(sigmoidf_(a1[1] * s), bf_hi(y.z), bf_hi(o.z)));
                        w.w = cvt_pk_bf16(fmaf(sigmoidf_(a1[2] * s), bf_lo(y.w), bf_lo(o.w)), fmaf(sigmoidf_(a1[3] * s), bf_hi(y.w), bf_hi(o.w)));
                        *(u32x4*)(MG + off + bj * HALF) = w; } }
                asm volatile("" ::: "memory"); }
    }
};
struct MergeOrder {
    StaticOrder base;
    __device__ bool next(int i, Unit& u) const { Unit t; if (!base.next(i / 3, t)) return false; u.pm = t.pm; u.pn = (i % 3) * 8 + t.pn; return true; }
    __device__ __forceinline__ void a_ready(const Unit&) const {}
    __device__ __forceinline__ void done(const Unit&) const {}
};
struct EpiGateMul {
    static constexpr bool PERM = true, AFTER_DRAIN = false;
    const bf16_t* G; int ldg; bf16_t* O; int ldc; int accum;
    __device__ __forceinline__ void operator()(const f32x4 (&acc)[2][2][4][2], const Unit& u, int wr, int wc, int fr_, int fq_) const {
        (void)fr_; (void)fq_; unsigned z_ = 0u; asm volatile("" : "+s"(z_)); const int ln_ = (int)__builtin_amdgcn_mbcnt_hi(~0u, __builtin_amdgcn_mbcnt_lo(~0u, z_)), fr = ln_ & 15, fq = ln_ >> 4;
        const int row0 = u.pm * BM + wr * 64 + fr, col0 = u.pn * BM + wc * 32 + 8 * fq;
#pragma unroll
        for (int ai = 0; ai < 2; ++ai)
#pragma unroll
            for (int m = 0; m < 4; ++m) { const size_t r = (size_t)(row0 + ai * HALF + m * 16);
#pragma unroll
                for (int bj = 0; bj < 2; ++bj) { const u32x4 gw = *(const u32x4*)(G + r * ldg + col0 + bj * HALF);
                    bf16_t* op = O + r * ldc + col0 + bj * HALF;
                    f32x4 v0 = acc[ai][bj][m][0], v1 = acc[ai][bj][m][1];
                    v0[0] *= bf_lo(gw.x); v0[1] *= bf_hi(gw.x); v0[2] *= bf_lo(gw.y); v0[3] *= bf_hi(gw.y);
                    v1[0] *= bf_lo(gw.z); v1[1] *= bf_hi(gw.z); v1[2] *= bf_lo(gw.w); v1[3] *= bf_hi(gw.w);
                    if (accum) { const u32x4 ow = *(const u32x4*)op;
                        v0[0] += bf_lo(ow.x); v0[1] += bf_hi(ow.x); v0[2] += bf_lo(ow.y); v0[3] += bf_hi(ow.y);
                        v1[0] += bf_lo(ow.z); v1[1] += bf_hi(ow.z); v1[2] += bf_lo(ow.w); v1[3] += bf_hi(ow.w); }
                    u32x4 w; w.x = cvt_pk_bf16(v0[0], v0[1]); w.y = cvt_pk_bf16(v0[2], v0[3]); w.z = cvt_pk_bf16(v1[0], v1[1]); w.w = cvt_pk_bf16(v1[2], v1[3]);
                    *(u32x4*)op = w; } }
    }
};

template <class Epi, class Sched, bool ALIGN_EPI = false, bool SP2 = false>
__device__ __forceinline__ void gemm_phase(PG8_LAS unsigned char* lds, const Gemm g, const Sched& S, const Epi& E, int wv) {
    unsigned z_ = 0u; asm volatile("" : "+s"(z_)); int lane_ = (int)__builtin_amdgcn_mbcnt_hi(~0u, __builtin_amdgcn_mbcnt_lo(~0u, z_)); asm volatile("" : "+v"(lane_));
    const int wid = wv, lane = lane_, tid = (wid << 6) | lane, wr = wid >> 2, wc = wid & 3, fr = lane & 15, fq = lane >> 4;
    const int K = g.K, nt = K / BK;
    unsigned voffA[2], voffB[2];
#pragma unroll
    for (int i = 0; i < 2; ++i) { int R, C; stage_rc(tid * 16 + i * 8192, R, C); const int Rb = Epi::PERM ? ((R & ~31) + perm32(R & 31)) : R;
        voffA[i] = (unsigned)(R * K + C) * 2u; voffB[i] = (unsigned)(Rb * K + C) * 2u; }
    const size_t kstep = (size_t)(BK * 2);
    const size_t hstep = (size_t)HALF * K * 2;
    const size_t tstep = 2 * hstep;
    const unsigned ldsw = (unsigned)wid * 1024u;
    const int aoff = lds_byte(wr * 64 + fr, fq * 8), boff = lds_byte(wc * 32 + fr, fq * 8);
#define PG8_SA(b, h) (((b) * 2 + (h)) * HTB)
#define PG8_SB(b, h) ((4 + (b) * 2 + (h)) * HTB)
#define PG8_STAGE(bufoff, gbase, voff) do { _Pragma("unroll") for (int _i = 0; _i < 2; ++_i) \
        __builtin_amdgcn_global_load_lds((const unsigned*)((const char*)(gbase) + (voff)[_i]), (PG8_LAS unsigned*)(lds + (bufoff) + ldsw + _i * 8192), 16, 0, 0); } while (0)
#define PG8_LDA(dst, b, h) do { _Pragma("unroll") for (int m = 0; m < 4; ++m) _Pragma("unroll") for (int k = 0; k < 2; ++k) dst[m][k] = *(const PG8_LAS bf16x8*)(lds + PG8_SA(b, h) + aoff + m * 2048 + k * 1024); } while (0)
#define PG8_LDB(dst, b, h) do { _Pragma("unroll") for (int n = 0; n < 2; ++n) _Pragma("unroll") for (int k = 0; k < 2; ++k) dst[n][k] = *(const PG8_LAS bf16x8*)(lds + PG8_SB(b, h) + boff + n * 2048 + k * 1024); } while (0)
#define PG8_MMA(ai, bj, At, Bt) do { __builtin_amdgcn_s_setprio(1); _Pragma("unroll") for (int m = 0; m < 4; ++m) _Pragma("unroll") for (int n = 0; n < 2; ++n) _Pragma("unroll") for (int k = 0; k < 2; ++k) \
        acc[ai][bj][m][n] = __builtin_amdgcn_mfma_f32_16x16x32_bf16(Bt[n][k], At[m][k], acc[ai][bj][m][n], 0, 0, 0); __builtin_amdgcn_s_setprio(0); } while (0)
#define PG8_WAIT_V(n) asm volatile("s_waitcnt vmcnt(" #n ")" ::: "memory")
#define PG8_WAIT_L(n) asm volatile("s_waitcnt lgkmcnt(" #n ")" ::: "memory")
#define PG8_BAR __builtin_amdgcn_s_barrier()
#define PG8_SCHED __builtin_amdgcn_sched_barrier(0)
    Unit cur, nxt; int ui = 0;
    if (!S.next(0, cur)) return;
    f32x4 acc[2][2][4][2];
#pragma unroll
    for (int a = 0; a < 2; ++a)
#pragma unroll
        for (int b = 0; b < 2; ++b)
#pragma unroll
            for (int m = 0; m < 4; ++m)
#pragma unroll
                for (int n = 0; n < 2; ++n) acc[a][b][m][n] = (f32x4){0.f, 0.f, 0.f, 0.f};
    bf16x8 At[4][2], B0[2][2], B1[2][2];
    const char* cA = (const char*)g.A + (size_t)cur.pm * tstep; const char* cB = (const char*)g.Bt + (size_t)cur.pn * tstep;
    S.a_ready(cur);
    if constexpr (SP2) {
        PG8_STAGE(PG8_SB(0, 0), cB, voffB); PG8_STAGE(PG8_SB(0, 1), cB + hstep, voffB); PG8_STAGE(PG8_SA(0, 0), cA, voffA); PG8_STAGE(PG8_SA(0, 1), cA + hstep, voffA);
        if (wr == 1) PG8_BAR;
        PG8_WAIT_V(2); PG8_BAR;
        PG8_STAGE(PG8_SB(1, 0), cB + kstep, voffB); PG8_STAGE(PG8_SA(1, 0), cA + kstep, voffA); PG8_STAGE(PG8_SB(1, 1), cB + hstep + kstep, voffB);
        PG8_WAIT_V(6); PG8_BAR;
    } else {
        PG8_STAGE(PG8_SB(0, 0), cB, voffB); PG8_STAGE(PG8_SA(0, 0), cA, voffA); PG8_STAGE(PG8_SB(0, 1), cB + hstep, voffB); PG8_STAGE(PG8_SA(0, 1), cA + hstep, voffA);
        if (wr == 1) PG8_BAR;
        PG8_WAIT_V(4); PG8_BAR;
        PG8_STAGE(PG8_SB(1, 0), cB + kstep, voffB); PG8_STAGE(PG8_SA(1, 0), cA + kstep, voffA); PG8_STAGE(PG8_SB(1, 1), cB + hstep + kstep, voffB);
        PG8_WAIT_V(6); PG8_BAR;
    }
    for (;;) {
        const bool has_next = S.next(ui + 1, nxt);
        const char* nA = has_next ? (const char*)g.A + (size_t)nxt.pm * tstep : cA; const char* nB = has_next ? (const char*)g.Bt + (size_t)nxt.pn * tstep : cB;
        for (int t = 0; t < nt; t += 2) {
            const bool last = (t == nt - 2);
            const char* a1 = cA + (size_t)(t + 1) * kstep;
            const char* a2 = last ? nA : cA + (size_t)(t + 2) * kstep; const char* b2 = last ? nB : cB + (size_t)(t + 2) * kstep;
            const char* a3 = a2 + kstep; const char* b3 = b2 + kstep;
            if (last && has_next) S.a_ready(nxt);
            if constexpr (SP2) {
            PG8_LDB(B0, 0, 0); PG8_LDB(B1, 0, 1); PG8_SCHED; PG8_LDA(At, 0, 0); PG8_STAGE(PG8_SA(1, 1), a1 + hstep, voffA);
            PG8_WAIT_V(8); PG8_WAIT_L(0); PG8_BAR; PG8_MMA(0, 0, At, B0); PG8_MMA(0, 1, At, B1); PG8_BAR; PG8_SCHED;
            PG8_LDA(At, 0, 1); PG8_STAGE(PG8_SB(0, 0), b2, voffB); PG8_STAGE(PG8_SB(0, 1), b2 + hstep, voffB); PG8_STAGE(PG8_SA(0, 0), a2, voffA);
            PG8_WAIT_V(8); PG8_WAIT_L(0); PG8_BAR; PG8_MMA(1, 0, At, B0); PG8_MMA(1, 1, At, B1); PG8_BAR; PG8_SCHED;
            PG8_LDB(B0, 1, 0); PG8_LDB(B1, 1, 1); PG8_SCHED; PG8_LDA(At, 1, 0); PG8_STAGE(PG8_SA(0, 1), a2 + hstep, voffA);
            PG8_WAIT_V(8); PG8_WAIT_L(0); PG8_BAR; PG8_MMA(0, 0, At, B0); PG8_MMA(0, 1, At, B1); PG8_BAR; PG8_SCHED;
            PG8_LDA(At, 1, 1); PG8_STAGE(PG8_SB(1, 0), b3, voffB); PG8_STAGE(PG8_SB(1, 1), b3 + hstep, voffB); PG8_STAGE(PG8_SA(1, 0), a3, voffA);
            PG8_WAIT_V(8); PG8_WAIT_L(0); PG8_BAR; PG8_MMA(1, 0, At, B0); PG8_MMA(1, 1, At, B1); PG8_BAR; PG8_SCHED;
            } else {
            PG8_LDB(B0, 0, 0); PG8_SCHED; PG8_LDA(At, 0, 0); PG8_STAGE(PG8_SA(1, 1), a1 + hstep, voffA);
            PG8_WAIT_L(8); PG8_BAR; PG8_WAIT_L(0); PG8_MMA(0, 0, At, B0); PG8_BAR; PG8_SCHED;
            PG8_LDB(B1, 0, 1); PG8_STAGE(PG8_SB(0, 0), b2, voffB);
            PG8_BAR; PG8_WAIT_L(0); PG8_MMA(0, 1, At, B1); PG8_BAR;
            PG8_LDA(At, 0, 1); PG8_STAGE(PG8_SA(0, 0), a2, voffA);
            PG8_BAR; PG8_WAIT_L(0); PG8_MMA(1, 0, At, B0); PG8_BAR; PG8_SCHED;
            PG8_STAGE(PG8_SB(0, 1), b2 + hstep, voffB);
            PG8_WAIT_V(6); PG8_BAR; PG8_MMA(1, 1, At, B1); PG8_BAR;
            PG8_LDB(B0, 1, 0); PG8_SCHED; PG8_LDA(At, 1, 0); PG8_STAGE(PG8_SA(0, 1), a2 + hstep, voffA);
            PG8_WAIT_L(8); PG8_BAR; PG8_WAIT_L(0); PG8_MMA(0, 0, At, B0); PG8_BAR; PG8_SCHED;
            PG8_LDB(B1, 1, 1); PG8_STAGE(PG8_SB(1, 0), b3, voffB);
            PG8_BAR; PG8_WAIT_L(0); PG8_MMA(0, 1, At, B1); PG8_BAR;
            PG8_LDA(At, 1, 1); PG8_STAGE(PG8_SA(1, 0), a3, voffA);
            PG8_BAR; PG8_WAIT_L(0); PG8_MMA(1, 0, At, B0); PG8_BAR; PG8_SCHED;
            PG8_STAGE(PG8_SB(1, 1), b3 + hstep, voffB);
            PG8_WAIT_V(6); PG8_BAR; PG8_MMA(1, 1, At, B1); PG8_BAR;
            }
        }
        if constexpr (ALIGN_EPI) { if (wr == 0) PG8_BAR; }
        if constexpr (!Epi::AFTER_DRAIN) { E(acc, cur, wr, wc, fr, fq); S.done(cur); }
        if (!has_next) break;
#pragma unroll
        for (int a = 0; a < 2; ++a)
#pragma unroll
            for (int b = 0; b < 2; ++b)
#pragma unroll
                for (int m = 0; m < 4; ++m)
#pragma unroll
                    for (int n = 0; n < 2; ++n) acc[a][b][m][n] = (f32x4){0.f, 0.f, 0.f, 0.f};
        cur = nxt; cA = nA; cB = nB; ++ui;
        if constexpr (ALIGN_EPI) { if (wr == 1) PG8_BAR; }
    }
    PG8_WAIT_V(0);
    if constexpr (!ALIGN_EPI) { if (wr == 0) PG8_BAR; }
    PG8_BAR;
#undef PG8_SA
#undef PG8_SB
#undef PG8_STAGE
#undef PG8_LDA
#undef PG8_LDB
#undef PG8_MMA
#undef PG8_WAIT_V
#undef PG8_WAIT_L
#undef PG8_BAR
#undef PG8_SCHED
}
}

#define PG8_SP2 true
#define PG8_ALIGN true

constexpr int NWAVES = 8, NTHR = NWAVES * 64;
constexpr int D_MODEL = 2048, BATCH = 2, SEQ = 16384, DEPTH = 2, PLE_DIM = 256, D_FF = 5632, CONV_WIDTH = 512;
constexpr int NHEAD = 16, NKV = 2, HEAD_DIM = 64, WINDOW = 128;
constexpr int HG_H = 8, HG_DK = 128, HG_DV = 64, HG_C = 64, HG_NC = SEQ / HG_C;
constexpr int M = BATCH * SEQ;
constexpr int D_IN = 12032, N_MAIN = 5888, N_GATES = 6144;
constexpr int C_CX = 0, C_CB = 512, C_CC = 1024, C_AQ = 1536, C_AK = 2560, C_AV = 2688, C_RQ = 2816, C_RF = 3840, C_RI = 4864, C_RG = 5376;
constexpr float NORM_EPS = 1e-6f;
constexpr int NPH = 18;
constexpr int NPHASES = DEPTH * NPH;

constexpr size_t MiB = 1u << 20;
constexpr size_t WS_CTL = 0, CTL_ZERO_BYTES = 1 * MiB;
constexpr size_t WS_GU1 = 2 * MiB, WS_D1 = 46 * MiB, WS_WIN = 68 * MiB, WS_BC = 115 * MiB, WS_BA = 117 * MiB, WS_BH = 121 * MiB, WS_WO = 123 * MiB,
                 WS_GU2 = 131 * MiB, WS_D2 = 175 * MiB, WS_PG = 197 * MiB, WS_PP = 205 * MiB, WS_PB = 206 * MiB;
constexpr size_t WS_X16 = 222 * MiB;
constexpr size_t WS_Y = 350 * MiB;
constexpr size_t WS_FC = WS_Y, WS_FA = WS_Y + 32 * MiB, WS_FH = WS_Y + 96 * MiB;
constexpr size_t WS_BIG = 478 * MiB;
constexpr size_t WS_UT = WS_BIG + 368 * MiB;
constexpr size_t WS_DD = WS_UT + 64 * MiB;
constexpr size_t WS_MG = WS_BIG + 384 * MiB;
constexpr size_t WS_RS = WS_MG + 128 * MiB;
constexpr size_t WS_END = WS_RS + 1 * MiB;
constexpr int CW_BAR = 4096;

constexpr int RING_BYTES = 131072;
constexpr int LDS_X_OFF = RING_BYTES;
constexpr int MISC_OFF = RING_BYTES + 8192;
constexpr int LDS_BYTES = 147456;

#define GAS __attribute__((address_space(1)))
#define LAS __attribute__((address_space(3)))
typedef unsigned short bf16;
typedef unsigned v4u __attribute__((ext_vector_type(4)));
typedef float f32x4 __attribute__((ext_vector_type(4)));
typedef GAS unsigned gu32;
#define LDS_WAIT() asm volatile("s_waitcnt lgkmcnt(0)" ::: "memory")
__device__ __forceinline__ unsigned f2bf(float f) { unsigned u = __builtin_bit_cast(unsigned, f); return (u + 0x7fffu + ((u >> 16) & 1u)) >> 16; }
__device__ __forceinline__ unsigned pk2(float lo, float hi) { return f2bf(lo) | (f2bf(hi) << 16); }
__device__ __forceinline__ float bf2f(bf16 b) { return __uint_as_float((unsigned)b << 16); }
__device__ __forceinline__ float blo(unsigned w) { return __uint_as_float(w << 16); }
__device__ __forceinline__ float bhi(unsigned w) { return __uint_as_float(w & 0xffff0000u); }
__device__ __forceinline__ float sigm(float v) { return __builtin_amdgcn_rcpf(1.0f + __builtin_amdgcn_exp2f(-1.4426950408889634f * v)); }

#define XB_TMO      128
#define XB_XCNT(j)  (256  + 64 * (j))
#define XB_XSUB(j)  (1280 + 64 * (j))
#define XB_XGEN(j)  (2304 + 64 * (j))
#define XB_TOP      3328
#define XB_TOPGEN   3392
#define XCD_BAR_WORDS 3456
#define XB_SPIN_CAP (1u << 18)
__device__ __forceinline__ unsigned xb_ld(unsigned* p)              { return __hip_atomic_load(p, __ATOMIC_RELAXED, __HIP_MEMORY_SCOPE_AGENT); }
__device__ __forceinline__ unsigned xb_add(unsigned* p, unsigned v) { return __hip_atomic_fetch_add(p, v, __ATOMIC_RELAXED, __HIP_MEMORY_SCOPE_AGENT); }
__device__ __forceinline__ unsigned xb_xcc_id() { return (unsigned)__builtin_amdgcn_s_getreg((3 << 11) | 20) & 0xFu; }
#define XB_SPIN(cond, bar) do { unsigned _sp = 0; while (cond) { __builtin_amdgcn_s_sleep(1); \
    if ((++_sp & 255u) == 0u) { if (xb_ld(&(bar)[XB_TMO])) break; if (_sp > XB_SPIN_CAP) { atomicAdd(&(bar)[XB_TMO], 1u); break; } } } } while (0)
struct XcdBarrier { unsigned* bar; unsigned x; volatile LAS unsigned* st; };
__device__ __forceinline__ XcdBarrier xcd_barrier_post(unsigned* bar, volatile LAS unsigned* st) {
    XcdBarrier b; b.bar = bar; b.x = xb_xcc_id(); b.st = st;
    if (threadIdx.x == 0) (void)xb_add(&bar[XB_XCNT(b.x)], 1u);
    return b;
}
__device__ __forceinline__ void xcd_barrier_complete(unsigned* bar, unsigned x, unsigned& nloc, unsigned& nx) {
    const unsigned G = gridDim.x * gridDim.y * gridDim.z;
    unsigned sum, cnt, mine, sp = 0u;
    for (;;) {
        sum = 0u; cnt = 0u; mine = 0u;
#pragma unroll
        for (unsigned j = 0; j < 16; ++j) { const unsigned c = xb_ld(&bar[XB_XCNT(j)]); sum += c; cnt += (c > 0u) ? 1u : 0u; mine = (j == x) ? c : mine; }
        if (sum == G) break;
        __builtin_amdgcn_s_sleep(1);
        if ((++sp & 255u) == 0u) { if (xb_ld(&bar[XB_TMO])) break; if (sp > XB_SPIN_CAP) { atomicAdd(&bar[XB_TMO], 1u); break; } }
    }
    nloc = mine > 0u ? mine : 1u; nx = cnt > 0u ? cnt : 1u;
}
__device__ __forceinline__ void xcd_barrier(const XcdBarrier& b) {
    asm volatile("s_waitcnt vmcnt(0)" ::: "memory");
    __syncthreads();
    if (threadIdx.x == 0) {
        unsigned* bar = b.bar;
        __builtin_amdgcn_s_waitcnt(0);
        unsigned nloc = b.st[0], nx = b.st[1];
        if (nloc == 0u) { xcd_barrier_complete(bar, b.x, nloc, nx); b.st[0] = nloc; b.st[1] = nx; }
        const unsigned old = xb_add(&bar[XB_XSUB(b.x)], 1u);
        const unsigned gen = old / nloc;
        if (old + 1u == (gen + 1u) * nloc) {
            __builtin_amdgcn_fence(__ATOMIC_RELEASE, "agent");
            asm volatile("s_waitcnt vmcnt(0)" ::: "memory");
            const unsigned og = xb_add(&bar[XB_TOP], 1u);
            const unsigned tg = og / nx;
            if (og + 1u == (tg + 1u) * nx) xb_add(&bar[XB_TOPGEN], 1u);
            else XB_SPIN(xb_ld(&bar[XB_TOPGEN]) == tg, bar);
            __builtin_amdgcn_fence(__ATOMIC_ACQUIRE, "agent");
            xb_add(&bar[XB_XGEN(b.x)], 1u);
            asm volatile("s_waitcnt vmcnt(0)" ::: "memory");
        } else {
            XB_SPIN(xb_ld(&bar[XB_XGEN(b.x)]) == gen, bar);
            __builtin_amdgcn_fence(__ATOMIC_ACQUIRE, "agent");
            asm volatile("s_waitcnt vmcnt(0)" ::: "memory");
        }
    }
    __syncthreads();
}

struct Args { const float* in[25]; float* out; unsigned char* ws; int ph_lo, ph_hi; };
struct Frame {
    LAS unsigned char* lds;
    int G, bid, wv;
    const float* const* in;
    float* out; unsigned char* ws;
};
#define PHASE_TID() unsigned z_ = 0u; asm volatile("" : "+s"(z_)); int lane_ = (int)__builtin_amdgcn_mbcnt_hi(~0u, __builtin_amdgcn_mbcnt_lo(~0u, z_)); asm volatile("" : "+v"(lane_)); const int lane = lane_, wave = F.wv, tid = (wave << 6) | lane; (void)lane; (void)wave; (void)tid
template <int MASK> __device__ __forceinline__ float swz_xor(float v) { return __int_as_float(__builtin_amdgcn_ds_swizzle(__float_as_int(v), 0x1f | (MASK << 10))); }
__device__ __forceinline__ float xor32_sum(float v) { const auto rr = __builtin_amdgcn_permlane32_swap(__float_as_uint(v), __float_as_uint(v), false, false); return __uint_as_float(rr[0]) + __uint_as_float(rr[1]); }
__device__ __forceinline__ float xor32_max(float v) { const auto rr = __builtin_amdgcn_permlane32_swap(__float_as_uint(v), __float_as_uint(v), false, false); return fmaxf(__uint_as_float(rr[0]), __uint_as_float(rr[1])); }
__device__ __forceinline__ float wave_sum(float v) {
    v += swz_xor<1>(v); v += swz_xor<2>(v); v += swz_xor<4>(v); v += swz_xor<8>(v); v += swz_xor<16>(v);
    return xor32_sum(v);
}
__device__ __forceinline__ float wave_max(float v) {
    v = fmaxf(v, swz_xor<1>(v)); v = fmaxf(v, swz_xor<2>(v)); v = fmaxf(v, swz_xor<4>(v)); v = fmaxf(v, swz_xor<8>(v)); v = fmaxf(v, swz_xor<16>(v));
    return xor32_max(v);
}

__device__ __forceinline__ void transpose_item(const float* W, int K, int N, bf16* WT, LAS float* scr, int item, int lane, bool gu, const float* gain = nullptr) {
    const int nblk = N / 32, kb = item / nblk, nb = item % nblk, k0 = 64 * kb, nd0 = 32 * nb;
    int ns0 = nd0;
    if (gu) { const int pn = nb >> 3, j = nb & 7; ns0 = ((j & 4) ? D_FF : 0) + 128 * pn + 32 * (j & 3); }
    float wv[32];
#pragma unroll
    for (int i = 0; i < 32; ++i) { const int kk = 2 * i + (lane >> 5); wv[i] = W[(size_t)(k0 + kk) * N + ns0 + (lane & 31)]; }
#pragma unroll
    for (int i = 0; i < 32; ++i) { const int kk = 2 * i + (lane >> 5); scr[kk * 33 + (lane & 31)] = wv[i] * (gain ? gain[k0 + kk] : 1.0f); }
    LDS_WAIT(); asm volatile("" ::: "memory");
    const int c = lane & 7;
#pragma unroll
    for (int j = 0; j < 4; ++j) { const int n = (lane >> 3) + 8 * j; const LAS float* s = scr + (8 * c) * 33 + n;
        v4u o; o.x = pk2(s[0 * 33], s[1 * 33]); o.y = pk2(s[2 * 33], s[3 * 33]); o.z = pk2(s[4 * 33], s[5 * 33]); o.w = pk2(s[6 * 33], s[7 * 33]);
        *(GAS v4u*)(WT + (size_t)(nd0 + n) * K + k0 + 8 * c) = o; }
    LDS_WAIT(); asm volatile("" ::: "memory");
}
__device__ __forceinline__ void x_row_to_bf16(int lane, const float* xrow, bf16* orow, float* rs) {
    float ss = 0.f;
#pragma unroll
    for (int j = 0; j < 4; ++j) { const f32x4 a = *(const f32x4*)(xrow + 8 * lane + 512 * j), b = *(const f32x4*)(xrow + 8 * lane + 512 * j + 4);
        ss += (a.x * a.x + a.y * a.y) + (a.z * a.z + a.w * a.w) + (b.x * b.x + b.y * b.y) + (b.z * b.z + b.w * b.w);
        v4u o; o.x = pk2(a.x, a.y); o.y = pk2(a.z, a.w); o.z = pk2(b.x, b.y); o.w = pk2(b.z, b.w);
        *(v4u*)(orow + 8 * lane + 512 * j) = o; }
    ss = wave_sum(ss);
    if (lane == 0) *rs = 1.0f / sqrtf(ss * (1.0f / D_MODEL) + NORM_EPS);
}

__device__ __forceinline__ void phase_convert(Frame& F, int l) {
    PHASE_TID();
    LAS float* scr = (LAS float*)(F.lds + wave * 16384);
    const int gw = F.bid * NWAVES + wave, NGW = F.G * NWAVES;
    unsigned char* ws = F.ws;
    constexpr int I_GU = (D_MODEL / 64) * (2 * D_FF / 32), I_D = (D_FF / 64) * (D_MODEL / 32), I_WIN = (D_MODEL / 64) * (D_IN / 32),
                  I_BC = (CONV_WIDTH / 64) * (D_MODEL / 32), I_BA = (1024 / 64) * (D_MODEL / 32), I_BH = (512 / 64) * (D_MODEL / 32),
                  I_SQ = (D_MODEL / 64) * (D_MODEL / 32), I_PP = (PLE_DIM / 64) * (D_MODEL / 32);
    constexpr int NITEMS = 2 * I_GU + 2 * I_D + I_WIN + I_BC + I_BA + I_BH + 2 * I_SQ + I_PP;
    for (int it = gw; it < NITEMS; it += NGW) {
        int r = it;
        if (r < I_GU) { transpose_item(F.in[3] + (size_t)l * D_MODEL * 2 * D_FF, D_MODEL, 2 * D_FF, (bf16*)(ws + WS_GU1), scr, r, lane, true, F.in[2] + l * D_MODEL); continue; } r -= I_GU;
        if (r < I_D) { transpose_item(F.in[4] + (size_t)l * D_FF * D_MODEL, D_FF, D_MODEL, (bf16*)(ws + WS_D1), scr, r, lane, false); continue; } r -= I_D;
        if (r < I_WIN) { transpose_item(F.in[7] + (size_t)l * D_MODEL * D_IN, D_MODEL, D_IN, (bf16*)(ws + WS_WIN), scr, r, lane, false, F.in[6] + l * D_MODEL); continue; } r -= I_WIN;
        if (r < I_BC) { transpose_item(F.in[12] + (size_t)l * CONV_WIDTH * D_MODEL, CONV_WIDTH, D_MODEL, (bf16*)(ws + WS_BC), scr, r, lane, false); continue; } r -= I_BC;
        if (r < I_BA) { transpose_item(F.in[13] + (size_t)l * 1024 * D_MODEL, 1024, D_MODEL, (bf16*)(ws + WS_BA), scr, r, lane, false); continue; } r -= I_BA;
        if (r < I_BH) { transpose_item(F.in[14] + (size_t)l * 512 * D_MODEL, 512, D_MODEL, (bf16*)(ws + WS_BH), scr, r, lane, false); continue; } r -= I_BH;
        if (r < I_SQ) { transpose_item(F.in[15] + (size_t)l * D_MODEL * D_MODEL, D_MODEL, D_MODEL, (bf16*)(ws + WS_WO), scr, r, lane, false); continue; } r -= I_SQ;
        if (r < I_GU) { transpose_item(F.in[18] + (size_t)l * D_MODEL * 2 * D_FF, D_MODEL, 2 * D_FF, (bf16*)(ws + WS_GU2), scr, r, lane, true, F.in[17] + l * D_MODEL); continue; } r -= I_GU;
        if (r < I_D) { transpose_item(F.in[19] + (size_t)l * D_FF * D_MODEL, D_FF, D_MODEL, (bf16*)(ws + WS_D2), scr, r, lane, false); continue; } r -= I_D;
        if (r < I_SQ) { transpose_item(F.in[22] + (size_t)l * D_MODEL * D_MODEL, D_MODEL, D_MODEL, (bf16*)(ws + WS_PG), scr, r, lane, false, F.in[21] + l * D_MODEL); continue; } r -= I_SQ;
        transpose_item(F.in[23] + (size_t)l * PLE_DIM * D_MODEL, PLE_DIM, D_MODEL, (bf16*)(ws + WS_PP), scr, r, lane, false);
    }
    { const float* p = F.in[1] + (size_t)l * M * PLE_DIM; bf16* pb = (bf16*)(ws + WS_PB);
      const size_t n8 = (size_t)M * PLE_DIM / 8;
      for (size_t i = (size_t)F.bid * NTHR + tid; i < n8; i += (size_t)F.G * NTHR) {
          const f32x4 a = *(const f32x4*)(p + 8 * i), b = *(const f32x4*)(p + 8 * i + 4);
          v4u o; o.x = pk2(a.x, a.y); o.y = pk2(a.z, a.w); o.z = pk2(b.x, b.y); o.w = pk2(b.z, b.w);
          *(v4u*)(pb + 8 * i) = o; } }
    if (l == 0) {
        for (int m = gw; m < M; m += NGW) x_row_to_bf16(lane, F.in[0] + (size_t)m * D_MODEL, (bf16*)(ws + WS_X16) + (size_t)m * D_MODEL, (float*)(ws + WS_RS) + m);
    }
}

__device__ __forceinline__ void phase_norm(Frame& F, float alpha, const float* wpost, bool final_, int ph = 0) {
    PHASE_TID();
    const int gw = F.bid * NWAVES + wave, NGW = F.G * NWAVES;
    const bf16* Y = (const bf16*)(F.ws + WS_Y); bf16* X = (bf16*)(F.ws + WS_X16); float* RS = (float*)(F.ws + WS_RS);
    for (int m0 = gw; m0 < M; m0 += 2 * NGW) {
        v4u yw[2][4], xw[2][4];
#pragma unroll
        for (int q = 0; q < 2; ++q) { const int m = m0 + q * NGW;
            if (m < M) {
#pragma unroll
                for (int j = 0; j < 4; ++j) { yw[q][j] = *(const v4u*)(Y + (size_t)m * D_MODEL + 8 * lane + 512 * j); xw[q][j] = *(const v4u*)(X + (size_t)m * D_MODEL + 8 * lane + 512 * j); } } }
#pragma unroll
        for (int q = 0; q < 2; ++q) { const int m = m0 + q * NGW;
            if (m < M) {
                bf16* xrow = X + (size_t)m * D_MODEL;
                float y[4][8]; float ss = 0.f;
#pragma unroll
                for (int j = 0; j < 4; ++j) { const v4u w = yw[q][j];
                    y[j][0] = blo(w.x); y[j][1] = bhi(w.x); y[j][2] = blo(w.y); y[j][3] = bhi(w.y); y[j][4] = blo(w.z); y[j][5] = bhi(w.z); y[j][6] = blo(w.w); y[j][7] = bhi(w.w);
#pragma unroll
                    for (int e = 0; e < 8; ++e) ss += y[j][e] * y[j][e]; }
                const float rstd = alpha / sqrtf(wave_sum(ss) * (1.0f / D_MODEL) + NORM_EPS);
#if MK_CHECK
                { float mxv = 0.f;
#pragma unroll
                  for (int j = 0; j < 4; ++j)
#pragma unroll
                      for (int e = 0; e < 8; ++e) mxv = fmaxf(mxv, fabsf(y[j][e]));
                  mxv = wave_max(mxv) * rstd / alpha;
                  if (mxv > 20.0f && lane == 0) { atomicMax((unsigned*)(F.ws + WS_CTL) + 65, (unsigned)(NPHASES - ph)); atomicAdd((unsigned*)(F.ws + WS_CTL) + 128 + ph, 1u); } }
#endif
                float ss2 = 0.f;
#pragma unroll
                for (int j = 0; j < 4; ++j) { const int c = 8 * lane + 512 * j; const v4u xv = xw[q][j];
                    const f32x4 w0 = *(const f32x4*)(wpost + c), w1 = *(const f32x4*)(wpost + c + 4);
                    y[j][0] = blo(xv.x) + y[j][0] * rstd * w0.x; y[j][1] = bhi(xv.x) + y[j][1] * rstd * w0.y; y[j][2] = blo(xv.y) + y[j][2] * rstd * w0.z; y[j][3] = bhi(xv.y) + y[j][3] * rstd * w0.w;
                    y[j][4] = blo(xv.z) + y[j][4] * rstd * w1.x; y[j][5] = bhi(xv.z) + y[j][5] * rstd * w1.y; y[j][6] = blo(xv.w) + y[j][6] * rstd * w1.z; y[j][7] = bhi(xv.w) + y[j][7] * rstd * w1.w;
                    if (final_) { float* xo = F.out + (size_t)m * D_MODEL + c;
                        *(f32x4*)xo = (f32x4){y[j][0], y[j][1], y[j][2], y[j][3]}; *(f32x4*)(xo + 4) = (f32x4){y[j][4], y[j][5], y[j][6], y[j][7]}; }
                    else { v4u o; o.x = pk2(y[j][0], y[j][1]); o.y = pk2(y[j][2], y[j][3]); o.z = pk2(y[j][4], y[j][5]); o.w = pk2(y[j][6], y[j][7]);
                        *(v4u*)(xrow + c) = o;
#pragma unroll
                        for (int e = 0; e < 8; ++e) ss2 += y[j][e] * y[j][e]; } }
                if (!final_) { ss2 = wave_sum(ss2); if (lane == 0) RS[m] = 1.0f / sqrtf(ss2 * (1.0f / D_MODEL) + NORM_EPS); }
            } }
    }
}

__device__ __forceinline__ void phase_conv(Frame& F, int l) {
    PHASE_TID();
    const bf16* main_ = (const bf16*)(F.ws + WS_BIG); bf16* FC = (bf16*)(F.ws + WS_FC);
    const float* cw = F.in[8] + (size_t)l * 3 * CONV_WIDTH;
    for (int strip = F.bid * NTHR + tid; strip < (M / 16) * 64; strip += F.G * NTHR) {
        const int cg = strip & 63, row0 = (strip >> 6) * 16, t0 = row0 & (SEQ - 1);
        float w[3][8];
#pragma unroll
        for (int j = 0; j < 3; ++j) { const f32x4 a = *(const f32x4*)(cw + j * CONV_WIDTH + 8 * cg), b = *(const f32x4*)(cw + j * CONV_WIDTH + 8 * cg + 4);
            w[j][0] = a.x; w[j][1] = a.y; w[j][2] = a.z; w[j][3] = a.w; w[j][4] = b.x; w[j][5] = b.y; w[j][6] = b.z; w[j][7] = b.w; }
        float u1[8], u2[8];
#pragma unroll
        for (int e = 0; e < 8; ++e) { u1[e] = 0.f; u2[e] = 0.f; }
        if (t0 > 0) {
            const bf16* r1 = main_ + (size_t)(row0 - 1) * N_MAIN + 8 * cg; const bf16* r2 = main_ + (size_t)(row0 - 2) * N_MAIN + 8 * cg;
            const v4u x1 = *(const v4u*)(r1 + C_CX), c1 = *(const v4u*)(r1 + C_CC), x2 = *(const v4u*)(r2 + C_CX), c2 = *(const v4u*)(r2 + C_CC);
            u1[0] = blo(x1.x) * blo(c1.x); u1[1] = bhi(x1.x) * bhi(c1.x); u1[2] = blo(x1.y) * blo(c1.y); u1[3] = bhi(x1.y) * bhi(c1.y);
            u1[4] = blo(x1.z) * blo(c1.z); u1[5] = bhi(x1.z) * bhi(c1.z); u1[6] = blo(x1.w) * blo(c1.w); u1[7] = bhi(x1.w) * bhi(c1.w);
            u2[0] = blo(x2.x) * blo(c2.x); u2[1] = bhi(x2.x) * bhi(c2.x); u2[2] = blo(x2.y) * blo(c2.y); u2[3] = bhi(x2.y) * bhi(c2.y);
            u2[4] = blo(x2.z) * blo(c2.z); u2[5] = bhi(x2.z) * bhi(c2.z); u2[6] = blo(x2.w) * blo(c2.w); u2[7] = bhi(x2.w) * bhi(c2.w);
        }
#pragma unroll 1
        for (int rq = 0; rq < 16; rq += 4) {
            v4u xv[4], cv[4], bv[4];
#pragma unroll
            for (int i = 0; i < 4; ++i) { const bf16* rp = main_ + (size_t)(row0 + rq + i) * N_MAIN + 8 * cg; xv[i] = *(const v4u*)(rp + C_CX); cv[i] = *(const v4u*)(rp + C_CC); bv[i] = *(const v4u*)(rp + C_CB); }
#pragma unroll
            for (int i = 0; i < 4; ++i) {
                float u0[8], y[8];
                u0[0] = blo(xv[i].x) * blo(cv[i].x); u0[1] = bhi(xv[i].x) * bhi(cv[i].x); u0[2] = blo(xv[i].y) * blo(cv[i].y); u0[3] = bhi(xv[i].y) * bhi(cv[i].y);
                u0[4] = blo(xv[i].z) * blo(cv[i].z); u0[5] = bhi(xv[i].z) * bhi(cv[i].z); u0[6] = blo(xv[i].w) * blo(cv[i].w); u0[7] = bhi(xv[i].w) * bhi(cv[i].w);
#pragma unroll
                for (int e = 0; e < 8; ++e) { y[e] = w[2][e] * u0[e] + w[1][e] * u1[e] + w[0][e] * u2[e]; u2[e] = u1[e]; u1[e] = u0[e]; }
                v4u o; o.x = pk2(y[0] * blo(bv[i].x), y[1] * bhi(bv[i].x)); o.y = pk2(y[2] * blo(bv[i].y), y[3] * bhi(bv[i].y));
                o.z = pk2(y[4] * blo(bv[i].z), y[5] * bhi(bv[i].z)); o.w = pk2(y[6] * blo(bv[i].w), y[7] * bhi(bv[i].w));
                *(v4u*)(FC + (size_t)(row0 + rq + i) * CONV_WIDTH + 8 * cg) = o; }
        }
    }
}
typedef float f32x16 __attribute__((ext_vector_type(16)));
typedef short s16x8 __attribute__((ext_vector_type(8)));
typedef short s16x4 __attribute__((ext_vector_type(4)));
typedef unsigned u32x2 __attribute__((ext_vector_type(2)));
constexpr int AT_KP = 144, AT_VP = 520, AT_VOFF = 256 * AT_KP;
__device__ __forceinline__ void phase_attn_mfma(Frame& F, int l) {
    PHASE_TID();
    const bf16* main_ = (const bf16*)(F.ws + WS_BIG); bf16* FA = (bf16*)(F.ws + WS_FA);
    LAS unsigned char* KL = F.lds; LAS unsigned char* VL = F.lds + AT_VOFF;
    const int r32 = lane & 31, hi = lane >> 5;
    constexpr float L2E = 1.4426950408889634f, NEG = -1e30f;
    constexpr int NU = BATCH * (SEQ / 128) * NKV;
    v4u kvr[4], vvr[4];
#define AT_LOAD(u_) do { const int hk_ = (u_) & 1, n_ = ((u_) >> 1) & 127, b_ = (u_) >> 8; const size_t r0_ = (size_t)b_ * SEQ + (size_t)n_ * 128; \
        _Pragma("unroll") for (int i = 0; i < 4; ++i) { const int idx = tid + NTHR * i, key = idx & 255, dg = idx >> 8; kvr[i] = (v4u){0u, 0u, 0u, 0u}; vvr[i] = (v4u){0u, 0u, 0u, 0u}; \
            if (n_ > 0 || key >= 128) { const bf16* rp = main_ + (r0_ - 128 + key) * N_MAIN + hk_ * 64 + dg * 8; kvr[i] = *(const v4u*)(rp + C_AK); vvr[i] = *(const v4u*)(rp + C_AV); } } } while (0)
    int unit = F.bid;
    if (unit < NU) AT_LOAD(unit);
    for (; unit < NU; unit += F.G) {
        const int hk = unit & 1, n = (unit >> 1) & 127, b = unit >> 8;
        const size_t row0 = (size_t)b * SEQ + (size_t)n * 128;
        const int h = hk * 8 + wave;
        s16x8 qf[4];
#pragma unroll
        for (int ks = 0; ks < 4; ++ks) qf[ks] = *(const s16x8*)(main_ + (row0 + r32) * N_MAIN + C_AQ + h * 64 + 16 * ks + 8 * hi);
#pragma unroll
        for (int i = 0; i < 4; ++i) { const int idx = tid + NTHR * i, key = idx & 255, dg = idx >> 8; const v4u vv = vvr[i];
            *(LAS v4u*)(KL + key * AT_KP + dg * 16) = kvr[i];
            LAS unsigned short* vp = (LAS unsigned short*)(VL + (dg * 8) * AT_VP + key * 2);
            vp[0 * (AT_VP / 2)] = (unsigned short)(vv.x & 0xffffu); vp[1 * (AT_VP / 2)] = (unsigned short)(vv.x >> 16);
            vp[2 * (AT_VP / 2)] = (unsigned short)(vv.y & 0xffffu); vp[3 * (AT_VP / 2)] = (unsigned short)(vv.y >> 16);
            vp[4 * (AT_VP / 2)] = (unsigned short)(vv.z & 0xffffu); vp[5 * (AT_VP / 2)] = (unsigned short)(vv.z >> 16);
            vp[6 * (AT_VP / 2)] = (unsigned short)(vv.w & 0xffffu); vp[7 * (AT_VP / 2)] = (unsigned short)(vv.w >> 16); }
        __syncthreads();
        const float slope2 = exp2f(-0.5f * (float)(h + 1)) * L2E, sink2 = F.in[9][l * NHEAD + h] * L2E;
        const float nsb2 = -slope2 * (float)(r32 + 128 - 4 * hi);
#pragma unroll 1
        for (int c = 0; c < 4; ++c) {
            const size_t qrow = row0 + 32 * c + r32;
            if (c == 3 && unit + F.G < NU) { AT_LOAD(unit + F.G); }
            f32x16 S[5];
            float mx = NEG;
#pragma unroll
            for (int d = 0; d < 5; ++d) {
                const int kt = c + d;
                if (n == 0 && kt < 4) {
#pragma unroll
                    for (int r = 0; r < 16; ++r) S[d][r] = NEG;
                } else {
                    f32x16 acc;
#pragma unroll
                    for (int r = 0; r < 16; ++r) acc[r] = 0.f;
#pragma unroll
                    for (int ks = 0; ks < 4; ++ks) { const s16x8 a = *(const LAS s16x8*)(KL + (32 * kt + r32) * AT_KP + (16 * ks + 8 * hi) * 2);
                        acc = __builtin_amdgcn_mfma_f32_32x32x16_bf16(a, qf[ks], acc, 0, 0, 0); }
#pragma unroll
                    for (int r = 0; r < 16; ++r) { const int cr = (r & 3) + 8 * (r >> 2);
                        float s = fmaf(slope2, (float)(32 * d + cr), fmaf(acc[r], 0.125f * L2E, nsb2));
                        if (d == 0) { if (!(r32 - 4 * hi - cr < 0)) s = NEG; }
                        if (d == 4) { if (!(r32 - 4 * hi - cr >= 0)) s = NEG; }
                        S[d][r] = s; mx = fmaxf(mx, s); }
                }
            }
            if (c < 3) {
#pragma unroll
                for (int ks = 0; ks < 4; ++ks) qf[ks] = *(const s16x8*)(main_ + (qrow + 32) * N_MAIN + C_AQ + h * 64 + 16 * ks + 8 * hi);
            }
            mx = xor32_max(mx);
            mx = fmaxf(mx, sink2);
            float sum = 0.f;
            f32x16 O0, O1;
#pragma unroll
            for (int r = 0; r < 16; ++r) { O0[r] = 0.f; O1[r] = 0.f; }
#pragma unroll
            for (int d = 0; d < 5; ++d) {
                const int kt = c + d;
                if (n == 0 && kt < 4) continue;
#pragma unroll
                for (int r = 0; r < 16; ++r) { const float p = __builtin_amdgcn_exp2f(S[d][r] - mx); S[d][r] = p; sum += p; }
#pragma unroll
                for (int s = 0; s < 2; ++s) {
                    v4u pw; pw.x = pg8::cvt_pk_bf16(S[d][8 * s + 0], S[d][8 * s + 1]); pw.y = pg8::cvt_pk_bf16(S[d][8 * s + 2], S[d][8 * s + 3]);
                    pw.z = pg8::cvt_pk_bf16(S[d][8 * s + 4], S[d][8 * s + 5]); pw.w = pg8::cvt_pk_bf16(S[d][8 * s + 6], S[d][8 * s + 7]);
                    const s16x8 pf = __builtin_bit_cast(s16x8, pw);
                    const int kb = (32 * kt + 16 * s + 4 * hi) * 2;
                    { const s16x4 lo = *(const LAS s16x4*)(VL + r32 * AT_VP + kb), hh = *(const LAS s16x4*)(VL + r32 * AT_VP + kb + 16);
                      const s16x8 a = __builtin_shufflevector(lo, hh, 0, 1, 2, 3, 4, 5, 6, 7); O0 = __builtin_amdgcn_mfma_f32_32x32x16_bf16(a, pf, O0, 0, 0, 0); }
                    { const s16x4 lo = *(const LAS s16x4*)(VL + (32 + r32) * AT_VP + kb), hh = *(const LAS s16x4*)(VL + (32 + r32) * AT_VP + kb + 16);
                      const s16x8 a = __builtin_shufflevector(lo, hh, 0, 1, 2, 3, 4, 5, 6, 7); O1 = __builtin_amdgcn_mfma_f32_32x32x16_bf16(a, pf, O1, 0, 0, 0); }
                }
            }
            sum = xor32_sum(sum);
            const float inv = 1.0f / (sum + __builtin_amdgcn_exp2f(sink2 - mx));
            bf16* op = FA + qrow * 1024 + h * 64 + 4 * hi;
#pragma unroll
            for (int rg = 0; rg < 4; ++rg) {
                u32x2 w0; w0.x = pg8::cvt_pk_bf16(O0[4 * rg] * inv, O0[4 * rg + 1] * inv); w0.y = pg8::cvt_pk_bf16(O0[4 * rg + 2] * inv, O0[4 * rg + 3] * inv);
                u32x2 w1; w1.x = pg8::cvt_pk_bf16(O1[4 * rg] * inv, O1[4 * rg + 1] * inv); w1.y = pg8::cvt_pk_bf16(O1[4 * rg + 2] * inv, O1[4 * rg + 3] * inv);
                *(u32x2*)(op + 8 * rg) = w0; *(u32x2*)(op + 32 + 8 * rg) = w1; }
        }
        __syncthreads();
    }
#undef AT_LOAD
}

__device__ __forceinline__ float hgrn_lb(const float* logits, int l, int ch) {
    float mx = -1e30f;
#pragma unroll
    for (int i = 0; i < DEPTH; ++i) mx = fmaxf(mx, logits[i * (HG_H * HG_DK) + ch]);
    float den = 0.f, num = 0.f;
#pragma unroll
    for (int i = 0; i < DEPTH; ++i) { const float e = __expf(logits[i * (HG_H * HG_DK) + ch] - mx); den += e; if (i < l) num += e; }
    return num / den;
}
__device__ __forceinline__ float hgrn_lb2(float x0, float x1, int l) { if (l == 0) return 0.f; const float mx = fmaxf(x0, x1), e0 = __expf(x0 - mx), e1 = __expf(x1 - mx); return e0 / (e0 + e1); }
static_assert(DEPTH == 2, "hgrn_lb2 is written for two layers");
constexpr int HG_P = 144, HG_PK = 272;
__device__ __forceinline__ void phase_hgrn_scan2(Frame& F) {
    PHASE_TID();
    bf16* UTB = (bf16*)(F.ws + WS_UT); const float* DD = (const float*)(F.ws + WS_DD);
    for (int e = F.bid * NTHR + tid; e < BATCH * HG_H * 8192; e += F.G * NTHR) {
        const int bh = e >> 13, vk = e & 8191, k = vk & 127;
        float s = 0.f;
        bf16* up = UTB + (size_t)bh * HG_NC * 8192 + vk; const float* dp = DD + (size_t)bh * HG_NC * 128 + k;
        for (int c = 0; c < HG_NC; c += 32) {
            bf16 u[32]; float d[32];
#pragma unroll
            for (int i = 0; i < 32; ++i) { u[i] = up[(size_t)(c + i) * 8192]; d[i] = dp[(size_t)(c + i) * 128]; }
#pragma unroll
            for (int i = 0; i < 32; ++i) { up[(size_t)(c + i) * 8192] = (bf16)f2bf(s); s = d[i] * s + bf2f(u[i]); }
        }
    }
}

__device__ __forceinline__ void phase_hgrn_c3(Frame& F, int l) {
    PHASE_TID();
    LAS unsigned char* QA = F.lds; LAS unsigned char* KB = F.lds + 17408; LAS unsigned char* QE = F.lds + 34816; LAS unsigned char* VT = F.lds + 52224;
    LAS float* QT = (LAS float*)(F.lds + 61440); LAS float* SSQ = (LAS float*)(F.lds + 63488);
    const bf16* main_ = (const bf16*)(F.ws + WS_BIG); const bf16* UTB = (const bf16*)(F.ws + WS_UT); bf16* FH = (bf16*)(F.ws + WS_FH);
    const float* nw = F.in[11] + (size_t)l * HG_DV;
    const int k = tid & 127, tq = tid >> 7, r32 = lane & 31, hi = lane >> 5;
    const int vt = wave & 1, tt_ = (wave >> 1) & 1;
    constexpr int NU = BATCH * HG_H * HG_NC;
    bf16 zr[16], qr[16]; v4u vtw = (v4u){0u, 0u, 0u, 0u}; float lg0 = 0.f, lg1 = 0.f;
#define HGC_LOAD(u_) do { const int c_ = (u_) & (HG_NC - 1), bh_ = (u_) >> 8, h_ = bh_ & 7, b_ = bh_ >> 3; const size_t r0_ = (size_t)b_ * SEQ + (size_t)c_ * HG_C; \
        _Pragma("unroll") for (int tt = 0; tt < 16; ++tt) { const bf16* rp_ = main_ + (r0_ + tq * 16 + tt) * N_MAIN + h_ * HG_DK + k; zr[tt] = rp_[C_RF]; qr[tt] = rp_[C_RQ]; } \
        vtw = *(const v4u*)(main_ + (r0_ + (tid & 63)) * N_MAIN + C_RI + h_ * HG_DV + (tid >> 6) * 8); lg0 = F.in[10][h_ * HG_DK + k]; lg1 = F.in[10][HG_H * HG_DK + h_ * HG_DK + k]; } while (0)
    f32x4 nwv[4];
#pragma unroll
    for (int rg = 0; rg < 4; ++rg) nwv[rg] = *(const f32x4*)(nw + 32 * vt + 8 * rg + 4 * hi);
    int unit = F.bid;
    if (unit < NU) HGC_LOAD(unit);
    for (; unit < NU; unit += F.G) {
        const int c = unit & (HG_NC - 1), bh = unit >> 8, h = bh & 7, b = bh >> 3;
        const size_t row0 = (size_t)b * SEQ + (size_t)c * HG_C;
        s16x8 sf[8]; u32x2 gw[4];
        if (wave < 4) { const bf16* sp = UTB + (size_t)unit * 8192 + (32 * vt + r32) * 128 + 8 * hi;
#pragma unroll
            for (int ks = 0; ks < 8; ++ks) sf[ks] = *(const s16x8*)(sp + 16 * ks);
            const bf16* gp = main_ + (row0 + 32 * tt_ + r32) * N_MAIN + C_RG + h * HG_DV + 32 * vt + 4 * hi;
#pragma unroll
            for (int rg = 0; rg < 4; ++rg) gw[rg] = *(const u32x2*)(gp + 8 * rg); }
        const float lb = hgrn_lb2(lg0, lg1, l), lbe = fmaxf(lb, 1e-20f);
        float a[16], kc[16], q[16]; float run = 0.f;
#pragma unroll
        for (int tt = 0; tt < 16; ++tt) { const float z = bf2f(zr[tt]), qv = bf2f(qr[tt]);
            const float sg = sigm(z); run += __logf(lbe + (1.0f - lbe) * sg); a[tt] = run; kc[tt] = (1.0f - lb) * (1.0f - sg); q[tt] = qv * sigm(qv); }
        QT[tq * 128 + k] = run;
        { LAS unsigned short* vp = (LAS unsigned short*)(VT + ((tid >> 6) * 8) * HG_P + (tid & 63) * 2);
          vp[0 * (HG_P / 2)] = (unsigned short)(vtw.x & 0xffffu); vp[1 * (HG_P / 2)] = (unsigned short)(vtw.x >> 16);
          vp[2 * (HG_P / 2)] = (unsigned short)(vtw.y & 0xffffu); vp[3 * (HG_P / 2)] = (unsigned short)(vtw.y >> 16);
          vp[4 * (HG_P / 2)] = (unsigned short)(vtw.z & 0xffffu); vp[5 * (HG_P / 2)] = (unsigned short)(vtw.z >> 16);
          vp[6 * (HG_P / 2)] = (unsigned short)(vtw.w & 0xffffu); vp[7 * (HG_P / 2)] = (unsigned short)(vtw.w >> 16); }
        __syncthreads();
        float off = 0.f; const float aref = QT[k] + QT[128 + k];
#pragma unroll
        for (int qq = 0; qq < 3; ++qq) { if (qq < tq) off += QT[qq * 128 + k]; }
        const float earef = __expf(aref);
#pragma unroll
        for (int tt = 0; tt < 16; ++tt) { const int t = tq * 16 + tt; const float e1 = __expf(off + a[tt] - aref), qa = q[tt] * e1;
            *(LAS unsigned short*)(QA + t * HG_PK + k * 2) = (unsigned short)f2bf(qa);
            *(LAS unsigned short*)(KB + t * HG_PK + k * 2) = (unsigned short)f2bf(kc[tt] * __builtin_amdgcn_rcpf(e1));
            *(LAS unsigned short*)(QE + t * HG_PK + k * 2) = (unsigned short)f2bf(qa * earef); }
        __syncthreads();
        if (unit + F.G < NU) HGC_LOAD(unit + F.G);
        f32x16 O;
#pragma unroll
        for (int r = 0; r < 16; ++r) O[r] = 0.f;
        if (wave < 4) {
#pragma unroll
            for (int st = 0; st < 2; ++st) {
                if (st <= tt_) {
                    f32x16 acc;
#pragma unroll
                    for (int r = 0; r < 16; ++r) acc[r] = 0.f;
#pragma unroll
                    for (int ks = 0; ks < 8; ++ks) { const s16x8 A = *(const LAS s16x8*)(KB + (32 * st + r32) * HG_PK + (16 * ks + 8 * hi) * 2);
                        const s16x8 B = *(const LAS s16x8*)(QA + (32 * tt_ + r32) * HG_PK + (16 * ks + 8 * hi) * 2);
                        acc = __builtin_amdgcn_mfma_f32_32x32x16_bf16(A, B, acc, 0, 0, 0); }
                    if (st == tt_) {
#pragma unroll
                        for (int r = 0; r < 16; ++r) { if ((r & 3) + 8 * (r >> 2) + 4 * hi > r32) acc[r] = 0.f; } }
#pragma unroll
                    for (int s2 = 0; s2 < 2; ++s2) {
                        v4u pw; pw.x = pg8::cvt_pk_bf16(acc[8 * s2 + 0], acc[8 * s2 + 1]); pw.y = pg8::cvt_pk_bf16(acc[8 * s2 + 2], acc[8 * s2 + 3]);
                        pw.z = pg8::cvt_pk_bf16(acc[8 * s2 + 4], acc[8 * s2 + 5]); pw.w = pg8::cvt_pk_bf16(acc[8 * s2 + 6], acc[8 * s2 + 7]);
                        const int kb = (32 * st + 16 * s2 + 4 * hi) * 2;
                        const s16x4 lo = *(const LAS s16x4*)(VT + (32 * vt + r32) * HG_P + kb), hh = *(const LAS s16x4*)(VT + (32 * vt + r32) * HG_P + kb + 16);
                        O = __builtin_amdgcn_mfma_f32_32x32x16_bf16(__builtin_shufflevector(lo, hh, 0, 1, 2, 3, 4, 5, 6, 7), __builtin_bit_cast(s16x8, pw), O, 0, 0, 0);
                    }
                }
            }
#pragma unroll
            for (int ks = 0; ks < 8; ++ks) { const s16x8 B = *(const LAS s16x8*)(QE + (32 * tt_ + r32) * HG_PK + (16 * ks + 8 * hi) * 2);
                O = __builtin_amdgcn_mfma_f32_32x32x16_bf16(sf[ks], B, O, 0, 0, 0); }
            float ss = 0.f;
#pragma unroll
            for (int r = 0; r < 16; ++r) ss += O[r] * O[r];
            ss = xor32_sum(ss);
            if (hi == 0) SSQ[vt * 64 + 32 * tt_ + r32] = ss;
        }
        __syncthreads();
        if (wave < 4) {
            const float rstd = 1.0f / sqrtf((SSQ[32 * tt_ + r32] + SSQ[64 + 32 * tt_ + r32]) * (1.0f / HG_DV) + NORM_EPS);
            const size_t row = row0 + 32 * tt_ + r32;
#pragma unroll
            for (int rg = 0; rg < 4; ++rg) { const int v = 32 * vt + 8 * rg + 4 * hi;
                const f32x4 nv = nwv[rg];
                const float g0 = blo(gw[rg].x), g1 = bhi(gw[rg].x), g2 = blo(gw[rg].y), g3 = bhi(gw[rg].y);
                u32x2 w; w.x = pg8::cvt_pk_bf16(O[4 * rg] * rstd * nv.x * g0 * sigm(g0), O[4 * rg + 1] * rstd * nv.y * g1 * sigm(g1));
                w.y = pg8::cvt_pk_bf16(O[4 * rg + 2] * rstd * nv.z * g2 * sigm(g2), O[4 * rg + 3] * rstd * nv.w * g3 * sigm(g3));
                *(u32x2*)(FH + row * 512 + h * HG_DV + v) = w; }
        }
    }
#undef HGC_LOAD
    __syncthreads();
}


__device__ __forceinline__ void phase_hgrn_a3(Frame& F, int l) {
    PHASE_TID();
    LAS unsigned char* KDT = F.lds; LAS unsigned char* VT = F.lds + 18432; LAS float* QT = (LAS float*)(F.lds + 27648);
    const bf16* main_ = (const bf16*)(F.ws + WS_BIG); bf16* UTB = (bf16*)(F.ws + WS_UT); float* DD = (float*)(F.ws + WS_DD);
    const int k = tid & 127, tq = tid >> 7, r32 = lane & 31, hi = lane >> 5;
    constexpr int NU = BATCH * HG_H * HG_NC;
    bf16 zr[16]; v4u vtw = (v4u){0u, 0u, 0u, 0u}; float lg0 = 0.f, lg1 = 0.f;
#define HGA_LOAD(u_) do { const int c_ = (u_) & (HG_NC - 1), bh_ = (u_) >> 8, h_ = bh_ & 7, b_ = bh_ >> 3; const size_t r0_ = (size_t)b_ * SEQ + (size_t)c_ * HG_C; \
        _Pragma("unroll") for (int tt = 0; tt < 16; ++tt) zr[tt] = main_[(r0_ + tq * 16 + tt) * N_MAIN + C_RF + h_ * HG_DK + k]; \
        vtw = *(const v4u*)(main_ + (r0_ + (tid & 63)) * N_MAIN + C_RI + h_ * HG_DV + (tid >> 6) * 8); lg0 = F.in[10][h_ * HG_DK + k]; lg1 = F.in[10][HG_H * HG_DK + h_ * HG_DK + k]; } while (0)
    int unit = F.bid;
    if (unit < NU) HGA_LOAD(unit);
    for (; unit < NU; unit += F.G) {
        const float lb = hgrn_lb2(lg0, lg1, l), lbe = fmaxf(lb, 1e-20f);
        float a[16], kc[16]; float run = 0.f;
#pragma unroll
        for (int tt = 0; tt < 16; ++tt) { const float z = bf2f(zr[tt]); const float sg = sigm(z); run += __logf(lbe + (1.0f - lbe) * sg); a[tt] = run; kc[tt] = (1.0f - lb) * (1.0f - sg); }
        QT[tq * 128 + k] = run;
        { LAS unsigned short* vp = (LAS unsigned short*)(VT + ((tid >> 6) * 8) * HG_P + (tid & 63) * 2);
          vp[0 * (HG_P / 2)] = (unsigned short)(vtw.x & 0xffffu); vp[1 * (HG_P / 2)] = (unsigned short)(vtw.x >> 16);
          vp[2 * (HG_P / 2)] = (unsigned short)(vtw.y & 0xffffu); vp[3 * (HG_P / 2)] = (unsigned short)(vtw.y >> 16);
          vp[4 * (HG_P / 2)] = (unsigned short)(vtw.z & 0xffffu); vp[5 * (HG_P / 2)] = (unsigned short)(vtw.z >> 16);
          vp[6 * (HG_P / 2)] = (unsigned short)(vtw.w & 0xffffu); vp[7 * (HG_P / 2)] = (unsigned short)(vtw.w >> 16); }
        __syncthreads();
        if (unit + F.G < NU) HGA_LOAD(unit + F.G);
        float off = 0.f, tot = 0.f;
#pragma unroll
        for (int q = 0; q < 4; ++q) { const float x = QT[q * 128 + k]; if (q < tq) off += x; tot += x; }
        float kd[16];
#pragma unroll
        for (int tt = 0; tt < 16; ++tt) kd[tt] = kc[tt] * __expf(tot - (off + a[tt]));
        { v4u w0, w1; w0.x = pg8::cvt_pk_bf16(kd[0], kd[1]); w0.y = pg8::cvt_pk_bf16(kd[2], kd[3]); w0.z = pg8::cvt_pk_bf16(kd[4], kd[5]); w0.w = pg8::cvt_pk_bf16(kd[6], kd[7]);
          w1.x = pg8::cvt_pk_bf16(kd[8], kd[9]); w1.y = pg8::cvt_pk_bf16(kd[10], kd[11]); w1.z = pg8::cvt_pk_bf16(kd[12], kd[13]); w1.w = pg8::cvt_pk_bf16(kd[14], kd[15]);
          *(LAS v4u*)(KDT + k * HG_P + tq * 32) = w0; *(LAS v4u*)(KDT + k * HG_P + tq * 32 + 16) = w1; }
        if (tq == 0) DD[(size_t)unit * 128 + k] = __expf(tot);
        __syncthreads();
        { const int kt = wave >> 1, vt = wave & 1;
          f32x16 acc;
#pragma unroll
          for (int r = 0; r < 16; ++r) acc[r] = 0.f;
#pragma unroll
          for (int ks = 0; ks < 4; ++ks) { const s16x8 A = *(const LAS s16x8*)(KDT + (32 * kt + r32) * HG_P + (16 * ks + 8 * hi) * 2);
              const s16x8 B = *(const LAS s16x8*)(VT + (32 * vt + r32) * HG_P + (16 * ks + 8 * hi) * 2);
              acc = __builtin_amdgcn_mfma_f32_32x32x16_bf16(A, B, acc, 0, 0, 0); }
          bf16* up = UTB + (size_t)unit * 8192 + (32 * vt + r32) * 128 + 32 * kt + 4 * hi;
#pragma unroll
          for (int rg = 0; rg < 4; ++rg) { u32x2 w; w.x = pg8::cvt_pk_bf16(acc[4 * rg], acc[4 * rg + 1]); w.y = pg8::cvt_pk_bf16(acc[4 * rg + 2], acc[4 * rg + 3]); *(u32x2*)(up + 8 * rg) = w; } }
        __syncthreads();
    }
#undef HGA_LOAD
}

#if MK_CHECK
constexpr int CW_CHK = 64;
__device__ __forceinline__ float bfr(float f) { return __uint_as_float(f2bf(f) << 16); }
__device__ __forceinline__ float dot_ar_wc(const bf16* arow, const float* W, int K, int N, int c) {
    float s = 0.f;
#pragma unroll 8
    for (int k = 0; k < K; ++k) s += bf2f(arow[k]) * bfr(W[(size_t)k * N + c]);
    return s;
}
__device__ __forceinline__ bool chk_bad(float got, float ref) { return !(fabsf(got - ref) <= 0.04f + 0.03f * fabsf(ref)); }
__device__ __forceinline__ void chk_report(Frame& F, int ph, bool fail) { if (fail) atomicMax((unsigned*)(F.ws + WS_CTL) + CW_CHK, (unsigned)(NPHASES - ph)); }
__device__ __forceinline__ void chk_rc(int tid, int ph, int N, int& r, int& c) {
    unsigned h1 = ((unsigned)tid + 1u) * 2654435761u + (unsigned)ph * 40503u; h1 ^= h1 >> 15; h1 *= 0x85ebca6bu; h1 ^= h1 >> 13;
    unsigned h2 = ((unsigned)tid + 77u) * 0x9E3779B1u + (unsigned)ph * 7919u; h2 ^= h2 >> 16; h2 *= 0xc2b2ae35u; h2 ^= h2 >> 13;
    r = (int)(h1 % (unsigned)M); c = (int)(h2 % (unsigned)N);
    if (tid == 0) r = 0; if (tid == 1) r = M - 1; if (tid == 2) r = SEQ - 1; if (tid == 3) r = SEQ; if (tid == 4) r = M - 300; if (tid == 5) r = 31500;
}
__device__ __forceinline__ float chk_rstd_bf(const bf16* row) { float ss = 0.f; for (int k = 0; k < D_MODEL; ++k) { const float v = bf2f(row[k]); ss += v * v; } return 1.0f / sqrtf(ss * (1.0f / D_MODEL) + NORM_EPS); }
__device__ __forceinline__ float chk_rstd_f(const float* row) { float ss = 0.f; for (int k = 0; k < D_MODEL; ++k) { const float v = row[k]; ss += v * v; } return 1.0f / sqrtf(ss * (1.0f / D_MODEL) + NORM_EPS); }
__device__ __forceinline__ void chk_x16(Frame& F, int ph) {
    PHASE_TID(); int r, c; chk_rc(tid, ph, D_MODEL, r, c);
    const float* x = F.in[0];
    bool fail = chk_bad(bf2f(((const bf16*)(F.ws + WS_X16))[(size_t)r * D_MODEL + c]), x[(size_t)r * D_MODEL + c]);
    const float rr = chk_rstd_f(x + (size_t)r * D_MODEL), rg = ((const float*)(F.ws + WS_RS))[r];
    fail = fail || !(fabsf(rg - rr) <= 0.002f * rr);
    chk_report(F, ph, fail);
}
__device__ __forceinline__ float dot_ar_wc_g(const bf16* arow, const float* W, int K, int N, int c, const float* gain) {
    float s = 0.f;
#pragma unroll 8
    for (int k = 0; k < K; ++k) s += bf2f(arow[k]) * bfr(W[(size_t)k * N + c] * (gain ? gain[k] : 1.0f));
    return s;
}
__device__ __forceinline__ void chk_gu(Frame& F, int ph, const float* Wgu, const float* gain) {
    PHASE_TID(); int r, j; chk_rc(tid, ph, D_FF, r, j);
    const bf16* a = (const bf16*)(F.ws + WS_X16) + (size_t)r * D_MODEL; const float rs = ((const float*)(F.ws + WS_RS))[r];
    const float g = rs * dot_ar_wc_g(a, Wgu, D_MODEL, 2 * D_FF, j, gain), u = rs * dot_ar_wc_g(a, Wgu, D_MODEL, 2 * D_FF, D_FF + j, gain);
    chk_report(F, ph, chk_bad(bf2f(((const bf16*)(F.ws + WS_BIG))[(size_t)r * D_FF + j]), g * sigm(g) * u));
}
__device__ __forceinline__ void chk_plain(Frame& F, int ph, const bf16* A, int K, const float* W, int NW, int coff, const bf16* OUT, int N, int act, const float* gain) {
    PHASE_TID(); int r, c; chk_rc(tid, ph, N, r, c);
    float ref = dot_ar_wc_g(A + (size_t)r * K, W, K, NW, coff + c, gain); if (gain) ref *= ((const float*)(F.ws + WS_RS))[r]; if (act == 2) ref = sigm(ref);
    chk_report(F, ph, chk_bad(bf2f(OUT[(size_t)r * N + c]), ref));
}
__device__ __forceinline__ void chk_norm(Frame& F, int ph, float alpha, const float* wpost, bool final_) {
    PHASE_TID(); int r, c; chk_rc(tid, ph, D_MODEL, r, c);
    const bf16* y = (const bf16*)(F.ws + WS_Y) + (size_t)r * D_MODEL;
    const float xi = ((const float*)(F.ws + WS_END))[tid];
    const float ref = xi + alpha * bf2f(y[c]) * chk_rstd_bf(y) * wpost[c];
    bool fail;
    if (final_) fail = !(fabsf(F.out[(size_t)r * D_MODEL + c] - ref) <= 0.01f + 0.01f * fabsf(ref));
    else { const bf16* xr = (const bf16*)(F.ws + WS_X16) + (size_t)r * D_MODEL;
        fail = chk_bad(bf2f(xr[c]), ref);
        const float rr = chk_rstd_bf(xr), rg = ((const float*)(F.ws + WS_RS))[r]; fail = fail || !(fabsf(rg - rr) <= 0.01f * rr); }
    chk_report(F, ph, fail);
}
__device__ __forceinline__ void chk_save(Frame& F, int ph) {
    PHASE_TID(); int r, c; chk_rc(tid, ph, D_MODEL, r, c);
    ((float*)(F.ws + WS_END))[tid] = bf2f(((const bf16*)(F.ws + WS_X16))[(size_t)r * D_MODEL + c]);
}
__device__ __forceinline__ void chk_conv(Frame& F, int ph, int l) {
    PHASE_TID(); int r, c; chk_rc(tid, ph, CONV_WIDTH, r, c);
    const bf16* mn = (const bf16*)(F.ws + WS_BIG); const float* cw = F.in[8] + (size_t)l * 3 * CONV_WIDTH; const int t = r & (SEQ - 1);
    float y = 0.f;
    for (int j = 0; j < 3; ++j) if (t - j >= 0) { const bf16* rp = mn + (size_t)(r - j) * N_MAIN; y += cw[(2 - j) * CONV_WIDTH + c] * bf2f(rp[C_CC + c]) * bf2f(rp[C_CX + c]); }
    const float ref = bf2f(mn[(size_t)r * N_MAIN + C_CB + c]) * y;
    chk_report(F, ph, chk_bad(bf2f(((const bf16*)(F.ws + WS_FC))[(size_t)r * CONV_WIDTH + c]), ref));
}
__device__ __forceinline__ void chk_attn(Frame& F, int ph, int l) {
    PHASE_TID(); int r, c; chk_rc(tid, ph, 1024, r, c);
    const bf16* mn = (const bf16*)(F.ws + WS_BIG); const int h = c >> 6, d = c & 63, hk = h >> 3, t = r & (SEQ - 1);
    const float slope = exp2f(-0.5f * (float)(h + 1)), sink = F.in[9][l * NHEAD + h];
    const bf16* qp = mn + (size_t)r * N_MAIN + C_AQ + h * 64; const int jmax = t < 127 ? t : 127;
    float mx = sink;
    for (int j = 0; j <= jmax; ++j) { const bf16* kp = mn + (size_t)(r - j) * N_MAIN + C_AK + hk * 64; float s = 0.f; for (int e = 0; e < 64; ++e) s += bf2f(qp[e]) * bf2f(kp[e]); s = s * 0.125f - slope * (float)j; mx = fmaxf(mx, s); }
    float den = expf(sink - mx), acc = 0.f;
    for (int j = 0; j <= jmax; ++j) { const bf16* kp = mn + (size_t)(r - j) * N_MAIN + C_AK + hk * 64; float s = 0.f; for (int e = 0; e < 64; ++e) s += bf2f(qp[e]) * bf2f(kp[e]); s = s * 0.125f - slope * (float)j;
        const float p = expf(s - mx); den += p; acc += p * bf2f(mn[(size_t)(r - j) * N_MAIN + C_AV + hk * 64 + d]); }
    chk_report(F, ph, chk_bad(bf2f(((const bf16*)(F.ws + WS_FA))[(size_t)r * 1024 + c]), acc / den));
}
__device__ __forceinline__ void chk_hgrn(Frame& F, int ph, int l, int b, int h, int c0) {
    PHASE_TID();
    LAS float* L = (LAS float*)F.lds; LAS float* S = L; LAS float* PO = L + 8192;
    const bf16* mn = (const bf16*)(F.ws + WS_BIG); const bf16* FH = (const bf16*)(F.ws + WS_FH);
    const int v = tid & 63, kg = tid >> 6;
    for (int kk = 0; kk < 16; ++kk) { const int k = kg * 16 + kk; S[k * 64 + v] = c0 ? bf2f(((const bf16*)(F.ws + WS_UT))[(size_t)(((b * HG_H + h) << 8) + c0) * 8192 + v * 128 + k]) : 0.f; }
    __syncthreads();
    bool fail = false;
    for (int t = 0; t < 200; ++t) {
        const size_t row = (size_t)b * SEQ + (size_t)c0 * HG_C + t; const bf16* rp = mn + row * N_MAIN;
        const float iv = bf2f(rp[C_RI + h * 64 + v]); float po = 0.f;
        for (int kk = 0; kk < 16; ++kk) { const int k = kg * 16 + kk;
            const float lb = hgrn_lb(F.in[10], l, h * HG_DK + k), lbe = fmaxf(lb, 1e-20f);
            const float z = bf2f(rp[C_RF + h * HG_DK + k]), sg = 1.0f / (1.0f + expf(-z));
            const float f = lbe + (1.0f - lbe) * sg, kc = (1.0f - lb) * (1.0f - sg);
            const float qr = bf2f(rp[C_RQ + h * HG_DK + k]), qv = qr / (1.0f + expf(-qr));
            const float s = f * S[k * 64 + v] + kc * iv; S[k * 64 + v] = s; po += s * qv; }
        PO[kg * 64 + v] = po;
        __syncthreads();
        if (tid < 64) { float o = 0.f; for (int q = 0; q < 8; ++q) o += PO[q * 64 + tid];
            const float ss = wave_sum(o * o); const float gv = bf2f(rp[C_RG + h * 64 + tid]);
            const float ref = o * (1.0f / sqrtf(ss * (1.0f / 64.0f) + NORM_EPS)) * F.in[11][l * HG_DV + tid] * gv / (1.0f + expf(-gv));
            fail = fail || chk_bad(bf2f(FH[row * 512 + h * 64 + tid]), ref); }
        __syncthreads();
    }
    chk_report(F, ph, fail);
}
__device__ __forceinline__ void chk_merge(Frame& F, int ph, int l) {
    PHASE_TID(); int r, c; chk_rc(tid, ph, D_MODEL, r, c);
    const bf16* a = (const bf16*)(F.ws + WS_X16) + (size_t)r * D_MODEL; const float rs = ((const float*)(F.ws + WS_RS))[r];
    const float* Win = F.in[7] + (size_t)l * D_MODEL * D_IN; const float* gain = F.in[6] + l * D_MODEL;
    const bf16* YB = (const bf16*)(F.ws + WS_BIG);
    float ref = 0.f;
    for (int b = 0; b < 3; ++b) { const float g = sigm(rs * dot_ar_wc_g(a, Win, D_MODEL, D_IN, N_MAIN + b * D_MODEL + c, gain));
        ref += g * bf2f(YB[(size_t)b * M * D_MODEL + (size_t)r * D_MODEL + c]); }
    chk_report(F, ph, chk_bad(bf2f(((const bf16*)(F.ws + WS_MG))[(size_t)r * D_MODEL + c]), ref));
}
__device__ __forceinline__ void chk_ple(Frame& F, int ph, int l) {
    PHASE_TID(); int r, c; chk_rc(tid, ph, D_MODEL, r, c);
    const float y = dot_ar_wc((const bf16*)(F.ws + WS_PB) + (size_t)r * PLE_DIM, F.in[23] + (size_t)l * PLE_DIM * D_MODEL, PLE_DIM, D_MODEL, c);
    const float ref = bf2f(((const bf16*)(F.ws + WS_BIG))[(size_t)r * D_MODEL + c]) * y;
    chk_report(F, ph, chk_bad(bf2f(((const bf16*)(F.ws + WS_Y))[(size_t)r * D_MODEL + c]), ref));
}
#endif

__global__ void __launch_bounds__(NTHR, 2) fwd(Args args) {
    extern __shared__ __attribute__((aligned(16))) unsigned char lds[];
    Frame F0;
    F0.lds = (LAS unsigned char*)lds;
    F0.G = gridDim.x; F0.bid = blockIdx.x; F0.in = args.in; F0.out = args.out; F0.ws = args.ws; F0.wv = __builtin_amdgcn_readfirstlane((int)(threadIdx.x >> 6));
    unsigned char* ws0 = args.ws;
    volatile LAS unsigned* MISC = (volatile LAS unsigned*)(F0.lds + MISC_OFF);
    if (threadIdx.x < 32) MISC[threadIdx.x] = 0u;
    __syncthreads();
#if MK_ONE_LAUNCH
    XcdBarrier bar = xcd_barrier_post((unsigned*)(ws0 + WS_CTL) + CW_BAR, MISC + 8);
#define GRID_BAR() xcd_barrier(bar)
#else
#define GRID_BAR() do {} while (0)
#endif
    const int lo = args.ph_lo, hi = args.ph_hi;
#define IN(k) (lo <= (k) && (k) < hi)
#if MK_CHECK
#define SEAM(k) do { if (IN(k)) GRID_BAR(); } while (0)
#define CHKL(kl, k, stmt) do { if (IN(k)) { if (((MK_CHECK_MASK >> (kl)) & 1) && F0.bid == 0) { PH_OPQ(); stmt; } GRID_BAR(); } } while (0)
#define CHKSAVE(k) do { if (F0.bid == 0) chk_save(F, (k)); GRID_BAR(); } while (0)
#else
#define CHKSAVE(k) do {} while (0)
#define SEAM(k) do { if (IN(k) && IN((k) + 1)) GRID_BAR(); } while (0)
#define CHKL(kl, k, stmt) do {} while (0)
#endif
#define PH_OPQ() Frame F = F0; unsigned char* ws = ws0; int l = l0; { asm volatile("" : "+s"(ws), "+s"(l)); F.ws = ws; } \
    bf16* X16 = (bf16*)(ws + WS_X16); bf16* Y = (bf16*)(ws + WS_Y); bf16* BIG = (bf16*)(ws + WS_BIG); bf16* MG = (bf16*)(ws + WS_MG); const float* RS = (const float*)(ws + WS_RS); \
    (void)X16; (void)Y; (void)BIG; (void)MG; (void)RS; (void)l
    using pg8::Gemm; using pg8::StaticOrder;
#define GEMM_RUN(EPI) pg8::gemm_phase<EPI, StaticOrder, PG8_ALIGN, PG8_SP2>(F.lds, g, S, E, F.wv);
#define NORM_RUN(k, alpha, wpost, fin) do { CHKSAVE(k); phase_norm(F, (alpha), (wpost), (fin), (k)); } while (0)

    for (int l0 = 0; l0 < DEPTH; ++l0) {
        const int P = l0 * NPH;
        if (IN(P + 0)) { PH_OPQ(); phase_convert(F, l); } SEAM(P + 0); CHKL(0, P + 0, if (l == 0) chk_x16(F, P + 0));
        if (IN(P + 1)) { PH_OPQ(); Gemm g{X16, (const bf16*)(ws + WS_GU1), M, 2 * D_FF, D_MODEL}; StaticOrder S; S.init(M, 2 * D_FF, F.G, F.bid);
            pg8::EpiSwiglu E{BIG, D_FF, RS}; GEMM_RUN(pg8::EpiSwiglu) } SEAM(P + 1); CHKL(1, P + 1, chk_gu(F, P + 1, F.in[3] + (size_t)l * D_MODEL * 2 * D_FF, F.in[2] + l * D_MODEL));
        if (IN(P + 2)) { PH_OPQ(); Gemm g{BIG, (const bf16*)(ws + WS_D1), M, D_MODEL, D_FF}; StaticOrder S; S.init(M, D_MODEL, F.G, F.bid);
            pg8::EpiBf16<0> E{Y, D_MODEL, nullptr}; GEMM_RUN(pg8::EpiBf16<0>) } SEAM(P + 2); CHKL(2, P + 2, chk_plain(F, P + 2, BIG, D_FF, F.in[4] + (size_t)l * D_FF * D_MODEL, D_MODEL, 0, Y, D_MODEL, 0, nullptr));
        if (IN(P + 3)) { PH_OPQ(); NORM_RUN(P + 3, 0.5f, F.in[5] + l * D_MODEL, false); } SEAM(P + 3); CHKL(3, P + 3, chk_norm(F, P + 3, 0.5f, F.in[5] + l * D_MODEL, false));
        if (IN(P + 4)) { PH_OPQ(); Gemm g{X16, (const bf16*)(ws + WS_WIN), M, N_MAIN, D_MODEL}; StaticOrder S; S.init(M, N_MAIN, F.G, F.bid);
            pg8::EpiBf16<0> E{BIG, N_MAIN, RS}; GEMM_RUN(pg8::EpiBf16<0>) } SEAM(P + 4); CHKL(4, P + 4, chk_plain(F, P + 4, X16, D_MODEL, F.in[7] + (size_t)l * D_MODEL * D_IN, D_IN, 0, BIG, N_MAIN, 0, F.in[6] + l * D_MODEL));
        if (IN(P + 5)) { PH_OPQ(); phase_conv(F, l); phase_attn_mfma(F, l); phase_hgrn_a3(F, l); } SEAM(P + 5); CHKL(5, P + 5, chk_conv(F, P + 5, l); chk_attn(F, P + 5, l));
        if (IN(P + 6)) { PH_OPQ(); phase_hgrn_scan2(F); } SEAM(P + 6);
        if (IN(P + 7)) { PH_OPQ(); phase_hgrn_c3(F, l); } SEAM(P + 7); CHKL(7, P + 7, chk_hgrn(F, P + 7, l, 1, 5, 0); chk_hgrn(F, P + 7, l, 0, 2, 100); chk_hgrn(F, P + 7, l, 1, 7, 252));
        if (IN(P + 8)) { PH_OPQ();
            StaticOrder S; S.init(M, D_MODEL, F.G, F.bid);
            { Gemm g{(const bf16*)(ws + WS_FC), (const bf16*)(ws + WS_BC), M, D_MODEL, CONV_WIDTH};
              pg8::EpiBf16<0> E{BIG, D_MODEL, nullptr}; pg8::gemm_phase<pg8::EpiBf16<0>, StaticOrder, PG8_ALIGN, PG8_SP2>(F.lds, g, S, E, F.wv); }
            { Gemm g{(const bf16*)(ws + WS_FA), (const bf16*)(ws + WS_BA), M, D_MODEL, 1024};
              pg8::EpiBf16<0> E{BIG + (size_t)M * D_MODEL, D_MODEL, nullptr}; pg8::gemm_phase<pg8::EpiBf16<0>, StaticOrder, PG8_ALIGN, PG8_SP2>(F.lds, g, S, E, F.wv); }
            { Gemm g{(const bf16*)(ws + WS_FH), (const bf16*)(ws + WS_BH), M, D_MODEL, 512};
              pg8::EpiBf16<0> E{BIG + (size_t)2 * M * D_MODEL, D_MODEL, nullptr}; pg8::gemm_phase<pg8::EpiBf16<0>, StaticOrder, PG8_ALIGN, PG8_SP2>(F.lds, g, S, E, F.wv); }
        } SEAM(P + 8); CHKL(8, P + 8, chk_plain(F, P + 8, (const bf16*)(ws + WS_FC), CONV_WIDTH, F.in[12] + (size_t)l * CONV_WIDTH * D_MODEL, D_MODEL, 0, BIG, D_MODEL, 0, nullptr);
                                  chk_plain(F, P + 8, (const bf16*)(ws + WS_FA), 1024, F.in[13] + (size_t)l * 1024 * D_MODEL, D_MODEL, 0, BIG + (size_t)M * D_MODEL, D_MODEL, 0, nullptr);
                                  chk_plain(F, P + 8, (const bf16*)(ws + WS_FH), 512, F.in[14] + (size_t)l * 512 * D_MODEL, D_MODEL, 0, BIG + (size_t)2 * M * D_MODEL, D_MODEL, 0, nullptr));
        if (IN(P + 9)) { PH_OPQ(); Gemm g{X16, (const bf16*)(ws + WS_WIN) + (size_t)N_MAIN * D_MODEL, M, N_GATES, D_MODEL}; pg8::MergeOrder S; S.base.init(M, D_MODEL, F.G, F.bid);
            pg8::EpiGateMerge E{BIG, MG, RS, (size_t)M * D_MODEL};
            pg8::gemm_phase<pg8::EpiGateMerge, pg8::MergeOrder, PG8_ALIGN, PG8_SP2>(F.lds, g, S, E, F.wv); } SEAM(P + 9); CHKL(9, P + 9, chk_merge(F, P + 9, l));
        if (IN(P + 10)) { PH_OPQ(); Gemm g{MG, (const bf16*)(ws + WS_WO), M, D_MODEL, D_MODEL}; StaticOrder S; S.init(M, D_MODEL, F.G, F.bid);
            pg8::EpiBf16<0> E{Y, D_MODEL, nullptr}; GEMM_RUN(pg8::EpiBf16<0>) } SEAM(P + 10); CHKL(10, P + 10, chk_plain(F, P + 10, MG, D_MODEL, F.in[15] + (size_t)l * D_MODEL * D_MODEL, D_MODEL, 0, Y, D_MODEL, 0, nullptr));
        if (IN(P + 11)) { PH_OPQ(); NORM_RUN(P + 11, 1.0f, F.in[16] + l * D_MODEL, false); } SEAM(P + 11); CHKL(11, P + 11, chk_norm(F, P + 11, 1.0f, F.in[16] + l * D_MODEL, false));
        if (IN(P + 12)) { PH_OPQ(); Gemm g{X16, (const bf16*)(ws + WS_GU2), M, 2 * D_FF, D_MODEL}; StaticOrder S; S.init(M, 2 * D_FF, F.G, F.bid);
            pg8::EpiSwiglu E{BIG, D_FF, RS}; GEMM_RUN(pg8::EpiSwiglu) } SEAM(P + 12); CHKL(12, P + 12, chk_gu(F, P + 12, F.in[18] + (size_t)l * D_MODEL * 2 * D_FF, F.in[17] + l * D_MODEL));
        if (IN(P + 13)) { PH_OPQ(); Gemm g{BIG, (const bf16*)(ws + WS_D2), M, D_MODEL, D_FF}; StaticOrder S; S.init(M, D_MODEL, F.G, F.bid);
            pg8::EpiBf16<0> E{Y, D_MODEL, nullptr}; GEMM_RUN(pg8::EpiBf16<0>) } SEAM(P + 13); CHKL(13, P + 13, chk_plain(F, P + 13, BIG, D_FF, F.in[19] + (size_t)l * D_FF * D_MODEL, D_MODEL, 0, Y, D_MODEL, 0, nullptr));
        if (IN(P + 14)) { PH_OPQ(); NORM_RUN(P + 14, 0.5f, F.in[20] + l * D_MODEL, false); } SEAM(P + 14); CHKL(14, P + 14, chk_norm(F, P + 14, 0.5f, F.in[20] + l * D_MODEL, false));
        if (IN(P + 15)) { PH_OPQ(); Gemm g{X16, (const bf16*)(ws + WS_PG), M, D_MODEL, D_MODEL}; StaticOrder S; S.init(M, D_MODEL, F.G, F.bid);
            pg8::EpiBf16<2> E{BIG, D_MODEL, RS}; GEMM_RUN(pg8::EpiBf16<2>) } SEAM(P + 15); CHKL(15, P + 15, chk_plain(F, P + 15, X16, D_MODEL, F.in[22] + (size_t)l * D_MODEL * D_MODEL, D_MODEL, 0, BIG, D_MODEL, 2, F.in[21] + l * D_MODEL));
        if (IN(P + 16)) { PH_OPQ(); Gemm g{(const bf16*)(ws + WS_PB), (const bf16*)(ws + WS_PP), M, D_MODEL, PLE_DIM}; StaticOrder S; S.init(M, D_MODEL, F.G, F.bid);
            pg8::EpiGateMul E{BIG, D_MODEL, Y, D_MODEL, 0}; GEMM_RUN(pg8::EpiGateMul) } SEAM(P + 16); CHKL(16, P + 16, chk_ple(F, P + 16, l));
        if (IN(P + 17)) { PH_OPQ(); NORM_RUN(P + 17, 1.0f, F.in[24] + l * D_MODEL, l + 1 == DEPTH); } SEAM(P + 17); CHKL(17, P + 17, chk_norm(F, P + 17, 1.0f, F.in[24] + l * D_MODEL, l + 1 == DEPTH));
    }
#if MK_CHECK
    if (F0.bid == 0 && threadIdx.x == 0) { const unsigned v = __hip_atomic_load((unsigned*)(ws0 + WS_CTL) + CW_CHK, __ATOMIC_RELAXED, __HIP_MEMORY_SCOPE_AGENT); if (v) F0.out[0] = 1000.0f * (float)v;
        const unsigned v2 = __hip_atomic_load((unsigned*)(ws0 + WS_CTL) + 65, __ATOMIC_RELAXED, __HIP_MEMORY_SCOPE_AGENT);
        if (v2 && !v) { const unsigned n = __hip_atomic_load((unsigned*)(ws0 + WS_CTL) + 128 + (NPHASES - v2), __ATOMIC_RELAXED, __HIP_MEMORY_SCOPE_AGENT); F0.out[1] = 100.0f + (float)n; } }
#endif
#undef IN
#undef SEAM
}

extern "C" void kernel_launch(void* const* d_in, const int* in_sizes, int n_in, void* d_out, int out_size, void* d_ws, size_t ws_size, hipStream_t stream) {
    static int grid = 0;
    if (grid == 0) {
        if (n_in != 25 || in_sizes[0] != M * D_MODEL || out_size != M * D_MODEL || ws_size < WS_END) {
            fprintf(stderr, "kernel_launch: unexpected shapes (n_in %d, in0 %d, out %d, ws %zu < %zu); nothing launched\n", n_in, n_in > 0 ? in_sizes[0] : -1, out_size, ws_size, (size_t)WS_END); grid = -1; return; }
        int dev = 0, cus = 0, per_cu = 0;
        if (hipGetDevice(&dev) != hipSuccess || hipDeviceGetAttribute(&cus, hipDeviceAttributeMultiprocessorCount, dev) != hipSuccess) { grid = -1; return; }
        if (hipFuncSetAttribute((const void*)fwd, hipFuncAttributeMaxDynamicSharedMemorySize, LDS_BYTES) != hipSuccess) { fprintf(stderr, "kernel_launch: hipFuncSetAttribute failed\n"); grid = -1; return; }
        if (hipOccupancyMaxActiveBlocksPerMultiprocessor(&per_cu, (const void*)fwd, NTHR, LDS_BYTES) != hipSuccess || per_cu < 1)
            fprintf(stderr, "kernel_launch: note: occupancy query reports %d workgroups per CU\n", per_cu);
        (void)hipGetLastError();
        grid = cus;
    }
    if (grid < 0) return;
    if (hipMemsetAsync((char*)d_ws + WS_CTL, 0, CTL_ZERO_BYTES, stream) != hipSuccess) { fprintf(stderr, "kernel_launch: memset failed\n"); return; }
    Args a{};
    for (int i = 0; i < 25; ++i) a.in[i] = (const float*)d_in[i];
    a.out = (float*)d_out; a.ws = (unsigned char*)d_ws;
#if MK_ONE_LAUNCH
    a.ph_lo = 0; a.ph_hi = NPHASES;
    hipLaunchKernelGGL(fwd, dim3(grid), dim3(NTHR), LDS_BYTES, stream, a);
#else
    for (int ph = 0; ph < NPHASES; ++ph) {
        a.ph_lo = ph; a.ph_hi = ph + 1;
        hipLaunchKernelGGL(fwd, dim3(grid), dim3(NTHR), LDS_BYTES, stream, a);
    }
#endif
    const hipError_t le = hipPeekAtLastError();
    if (le != hipSuccess) fprintf(stderr, "kernel_launch: launch failed: %s\n", hipGetErrorName(le));
}
```

```cpp
#include <hip/hip_runtime.h>
#include <cstdio>
#include <cstdint>

#ifndef MK_CHECK
#define MK_CHECK 0
#endif
#ifndef MK_CHECK_MASK
#define MK_CHECK_MASK 0x3ffff
#endif
#ifndef MK_ONE_LAUNCH
#define MK_ONE_LAUNCH 1
#endif
#ifndef WGM_WIDE
#define WGM_WIDE 4
#endif
#ifndef WGM_NARROW
#define WGM_NARROW 4
#endif

namespace pg8 {
#define PG8_LAS __attribute__((address_space(3)))
typedef unsigned short bf16_t;
typedef short bf16x8 __attribute__((ext_vector_type(8)));
typedef float f32x4 __attribute__((ext_vector_type(4)));
typedef unsigned u32x4 __attribute__((ext_vector_type(4)));
constexpr int BM = 256, BK = 64, HALF = 128, HTB = HALF * BK * 2  , STAGE_BYTES = 8 * HTB, NXCD = 8;

__host__ __device__ __forceinline__ int lds_byte(int r, int c) { const int st = (r >> 4) * 2 + (c >> 5), rr = r & 15, cc = c & 31, ob = rr * 64 + cc * 2; return st * 1024 + (ob ^ (((ob >> 9) & 1) << 5)); }
__host__ __device__ __forceinline__ void stage_rc(int b, int& R, int& C) { const int st = b / 1024, sb = b % 1024, swz = sb ^ (((sb >> 9) & 1) << 5); R = (st >> 1) * 16 + swz / 64; C = (st & 1) * 32 + (swz % 64) / 2; }
__host__ __device__ __forceinline__ int perm32(int rho) { const int n = rho >> 4, i = rho & 15; return 8 * (i >> 2) + 4 * n + (i & 3); }

struct Unit { int pm, pn; };
struct Gemm { const bf16_t* A; const bf16_t* Bt; int M, N, K; };

struct StaticOrder {
    int nM, nN, nwg, G, c, WGM;
    __host__ __device__ void init(int M, int N, int G_, int c_) { nM = M / BM; nN = N / BM; nwg = nM * nN; G = G_; c = c_; WGM = (nN > 8) ? WGM_WIDE : WGM_NARROW; }
    __host__ __device__ bool next(int i, Unit& u) const {
        const long L = (long)i * G + c; if (L >= nwg) return false;
        int wgid = (int)L; { const int q = nwg / NXCD, r = nwg % NXCD, xcd = wgid % NXCD, off = wgid / NXCD; wgid = (xcd < r ? xcd * (q + 1) : r * (q + 1) + (xcd - r) * q) + off; }
        const int nig = WGM * nN, gid = wgid / nig, fm = gid * WGM, gsz = (nM - fm) < WGM ? (nM - fm) : WGM;
        u.pm = fm + ((wgid % nig) % gsz); u.pn = (wgid % nig) / gsz; return true;
    }
    __device__ __forceinline__ void a_ready(const Unit&) const {}
    __device__ __forceinline__ void done(const Unit&) const {}
};

typedef float f32x2_t __attribute__((ext_vector_type(2))); typedef __bf16 bf16x2_t __attribute__((ext_vector_type(2)));
__device__ __forceinline__ unsigned cvt_pk_bf16(float lo, float hi) { f32x2_t v = {lo, hi}; bf16x2_t b = __builtin_convertvector(v, bf16x2_t); return __builtin_bit_cast(unsigned, b); }
__device__ __forceinline__ float bf_lo(unsigned w) { return __uint_as_float(w << 16); }
__device__ __forceinline__ float bf_hi(unsigned w) { return __uint_as_float(w & 0xffff0000u); }
__device__ __forceinline__ float sigmoidf_(float v) { return __builtin_amdgcn_rcpf(1.0f + __builtin_amdgcn_exp2f(-1.4426950408889634f * v)); }

#define EPI_STORE16(p, v) __builtin_nontemporal_store((v), (u32x4*)(p))
template <int ACT> struct EpiBf16 {
    static constexpr bool PERM = true, AFTER_DRAIN = false;
    bf16_t* O; int ldc; const float* rs;
    __device__ __forceinline__ void operator()(const f32x4 (&acc)[2][2][4][2], const Unit& u, int wr, int wc, int fr_, int fq_) const {
        (void)fr_; (void)fq_; unsigned z_ = 0u; asm volatile("" : "+s"(z_)); const int ln_ = (int)__builtin_amdgcn_mbcnt_hi(~0u, __builtin_amdgcn_mbcnt_lo(~0u, z_)), fr = ln_ & 15, fq = ln_ >> 4;
        const int row0 = u.pm * BM + wr * 64 + fr, col0 = u.pn * BM + wc * 32 + 8 * fq;
#pragma unroll
        for (int ai = 0; ai < 2; ++ai)
#pragma unroll
            for (int m = 0; m < 4; ++m) { const int row = row0 + ai * HALF + m * 16; bf16_t* rowp = O + (size_t)row * ldc + col0;
                const float sc = rs ? rs[row] : 1.0f;
#pragma unroll
                for (int bj = 0; bj < 2; ++bj) { f32x4 v0 = acc[ai][bj][m][0] * sc, v1 = acc[ai][bj][m][1] * sc;
                    if (ACT == 2) {
#pragma unroll
                        for (int e = 0; e < 4; ++e) { v0[e] = sigmoidf_(v0[e]); v1[e] = sigmoidf_(v1[e]); } }
                    u32x4 w; w.x = cvt_pk_bf16(v0[0], v0[1]); w.y = cvt_pk_bf16(v0[2], v0[3]); w.z = cvt_pk_bf16(v1[0], v1[1]); w.w = cvt_pk_bf16(v1[2], v1[3]);
                    EPI_STORE16(rowp + bj * HALF, w); } }
    }
};
struct EpiSwiglu {
    static constexpr bool PERM = true, AFTER_DRAIN = false;
    bf16_t* H; int ldh; const float* rs;
    __device__ __forceinline__ void operator()(const f32x4 (&acc)[2][2][4][2], const Unit& u, int wr, int wc, int fr_, int fq_) const {
        (void)fr_; (void)fq_; unsigned z_ = 0u; asm volatile("" : "+s"(z_)); const int ln_ = (int)__builtin_amdgcn_mbcnt_hi(~0u, __builtin_amdgcn_mbcnt_lo(~0u, z_)), fr = ln_ & 15, fq = ln_ >> 4;
        const int row0 = u.pm * BM + wr * 64 + fr, col0 = u.pn * HALF + wc * 32 + 8 * fq;
#pragma unroll
        for (int ai = 0; ai < 2; ++ai)
#pragma unroll
            for (int m = 0; m < 4; ++m) { const int row = row0 + ai * HALF + m * 16; bf16_t* rowp = H + (size_t)row * ldh + col0;
                const float sc = rs[row];
                f32x4 h0, h1;
#pragma unroll
                for (int e = 0; e < 4; ++e) { const float g0 = acc[ai][0][m][0][e] * sc, g1 = acc[ai][0][m][1][e] * sc;
                    h0[e] = g0 * sigmoidf_(g0) * (acc[ai][1][m][0][e] * sc); h1[e] = g1 * sigmoidf_(g1) * (acc[ai][1][m][1][e] * sc); }
                u32x4 w; w.x = cvt_pk_bf16(h0[0], h0[1]); w.y = cvt_pk_bf16(h0[2], h0[3]); w.z = cvt_pk_bf16(h1[0], h1[1]); w.w = cvt_pk_bf16(h1[2], h1[3]);
                EPI_STORE16(rowp, w); }
    }
};
struct EpiGateMerge {
    static constexpr bool PERM = true, AFTER_DRAIN = false;
    const bf16_t* YB; bf16_t* MG; const float* rs; size_t ystride;
    __device__ __forceinline__ void operator()(const f32x4 (&acc)[2][2][4][2], const Unit& u, int wr, int wc, int fr_, int fq_) const {
        (void)fr_; (void)fq_; unsigned z_ = 0u; asm volatile("" : "+s"(z_)); const int ln_ = (int)__builtin_amdgcn_mbcnt_hi(~0u, __builtin_amdgcn_mbcnt_lo(~0u, z_)), fr = ln_ & 15, fq = ln_ >> 4;
        const int b = u.pn >> 3, pn8 = u.pn & 7;
        const int row0 = u.pm * BM + wr * 64 + fr, col0 = pn8 * BM + wc * 32 + 8 * fq;
        const bf16_t* yb = YB + (size_t)b * ystride;
#pragma unroll
        for (int ai = 0; ai < 2; ++ai)
#pragma unroll
            for (int mp = 0; mp < 2; ++mp) {
                u32x4 yw[2][2], ow[2][2]; float sc[2];
#pragma unroll
                for (int mm = 0; mm < 2; ++mm) { const int row = row0 + ai * HALF + (2 * mp + mm) * 16; const int off = row * 2048 + col0; sc[mm] = rs[row];
#pragma unroll
                    for (int bj = 0; bj < 2; ++bj) { yw[mm][bj] = *(const u32x4*)(yb + off + bj * HALF); ow[mm][bj] = (u32x4){0u, 0u, 0u, 0u}; if (b) ow[mm][bj] = *(const u32x4*)(MG + off + bj * HALF); } }
#pragma unroll
                for (int mm = 0; mm < 2; ++mm) { const int m = 2 * mp + mm; const int row = row0 + ai * HALF + m * 16; const int off = row * 2048 + col0;
#pragma unroll
                    for (int bj = 0; bj < 2; ++bj) { const f32x4 a0 = acc[ai][bj][m][0], a1 = acc[ai][bj][m][1]; const u32x4 y = yw[mm][bj], o = ow[mm][bj]; const float s = sc[mm];
                        u32x4 w;
                        w.x = cvt_pk_bf16(fmaf(sigmoidf_(a0[0] * s), bf_lo(y.x), bf_lo(o.x)), fmaf(sigmoidf_(a0[1] * s), bf_hi(y.x), bf_hi(o.x)));
                        w.y = cvt_pk_bf16(fmaf(sigmoidf_(a0[2] * s), bf_lo(y.y), bf_lo(o.y)), fmaf(sigmoidf_(a0[3] * s), bf_hi(y.y), bf_hi(o.y)));
                        w.z = cvt_pk_bf16(fmaf(sigmoidf_(a1[0] * s), bf_lo(y.z), bf_lo(o.z)), fmaf(sigmoidf_(a1[1] * s), bf_hi(y.z), bf_hi(o.z)));
                        w.w = cvt_pk_bf16(fmaf(sigmoidf_(a1[2] * s), bf_lo(y.w), bf_lo(o.w)), fmaf(sigmoidf_(a1[3] * s), bf_hi(y.w), bf_hi(o.w)));
                        *(u32x4*)(MG + off + bj * HALF) = w; } }
                asm volatile("" ::: "memory"); }
    }
};
struct MergeOrder {
    StaticOrder base;
    __device__ bool next(int i, Unit& u) const { Unit t; if (!base.next(i / 3, t)) return false; u.pm = t.pm; u.pn = (i % 3) * 8 + t.pn; return true; }
    __device__ __forceinline__ void a_ready(const Unit&) const {}
    __device__ __forceinline__ void done(const Unit&) const {}
};
struct EpiGateMul {
    static constexpr bool PERM = true, AFTER_DRAIN = false;
    const bf16_t* G; int ldg; bf16_t* O; int ldc; int accum;
    __device__ __forceinline__ void operator()(const f32x4 (&acc)[2][2][4][2], const Unit& u, int wr, int wc, int fr_, int fq_) const {
        (void)fr_; (void)fq_; unsigned z_ = 0u; asm volatile("" : "+s"(z_)); const int ln_ = (int)__builtin_amdgcn_mbcnt_hi(~0u, __builtin_amdgcn_mbcnt_lo(~0u, z_)), fr = ln_ & 15, fq = ln_ >> 4;
        const int row0 = u.pm * BM + wr * 64 + fr, col0 = u.pn * BM + wc * 32 + 8 * fq;
#pragma unroll
        for (int ai = 0; ai < 2; ++ai)
#pragma unroll
            for (int m = 0; m < 4; ++m) { const size_t r = (size_t)(row0 + ai * HALF + m * 16);
#pragma unroll
                for (int bj = 0; bj < 2; ++bj) { const u32x4 gw = *(const u32x4*)(G + r * ldg + col0 + bj * HALF);
                    bf16_t* op = O + r * ldc + col0 + bj * HALF;
                    f32x4 v0 = acc[ai][bj][m][0], v1 = acc[ai][bj][m][1];
                    v0[0] *= bf_lo(gw.x); v0[1] *= bf_hi(gw.x); v0[2] *= bf_lo(gw.y); v0[3] *= bf_hi(gw.y);
                    v1[0] *= bf_lo(gw.z); v1[1] *= bf_hi(gw.z); v1[2] *= bf_lo(gw.w); v1[3] *= bf_hi(gw.w);
                    if (accum) { const u32x4 ow = *(const u32x4*)op;
                        v0[0] += bf_lo(ow.x); v0[1] += bf_hi(ow.x); v0[2] += bf_lo(ow.y); v0[3] += bf_hi(ow.y);
                        v1[0] += bf_lo(ow.z); v1[1] += bf_hi(ow.z); v1[2] += bf_lo(ow.w); v1[3] += bf_hi(ow.w); }
                    u32x4 w; w.x = cvt_pk_bf16(v0[0], v0[1]); w.y = cvt_pk_bf16(v0[2], v0[3]); w.z = cvt_pk_bf16(v1[0], v1[1]); w.w = cvt_pk_bf16(v1[2], v1[3]);
                    *(u32x4*)op = w; } }
    }
};

template <class Epi, class Sched, bool ALIGN_EPI = false, bool SP2 = false>
__device__ __forceinline__ void gemm_phase(PG8_LAS unsigned char* lds, const Gemm g, const Sched& S, const Epi& E, int wv) {
    unsigned z_ = 0u; asm volatile("" : "+s"(z_)); int lane_ = (int)__builtin_amdgcn_mbcnt_hi(~0u, __builtin_amdgcn_mbcnt_lo(~0u, z_)); asm volatile("" : "+v"(lane_));
    const int wid = wv, lane = lane_, tid = (wid << 6) | lane, wr = wid >> 2, wc = wid & 3, fr = lane & 15, fq = lane >> 4;
    const int K = g.K, nt = K / BK;
    unsigned voffA[2], voffB[2];
#pragma unroll
    for (int i = 0; i < 2; ++i) { int R, C; stage_rc(tid * 16 + i * 8192, R, C); const int Rb = Epi::PERM ? ((R & ~31) + perm32(R & 31)) : R;
        voffA[i] = (unsigned)(R * K + C) * 2u; voffB[i] = (unsigned)(Rb * K + C) * 2u; }
    const size_t kstep = (size_t)(BK * 2);
    const size_t hstep = (size_t)HALF * K * 2;
    const size_t tstep = 2 * hstep;
    const unsigned ldsw = (unsigned)wid * 1024u;
    const int aoff = lds_byte(wr * 64 + fr, fq * 8), boff = lds_byte(wc * 32 + fr, fq * 8);
#define PG8_SA(b, h) (((b) * 2 + (h)) * HTB)
#define PG8_SB(b, h) ((4 + (b) * 2 + (h)) * HTB)
#define PG8_STAGE(bufoff, gbase, voff) do { _Pragma("unroll") for (int _i = 0; _i < 2; ++_i) \
        __builtin_amdgcn_global_load_lds((const unsigned*)((const char*)(gbase) + (voff)[_i]), (PG8_LAS unsigned*)(lds + (bufoff) + ldsw + _i * 8192), 16, 0, 0); } while (0)
#define PG8_LDA(dst, b, h) do { _Pragma("unroll") for (int m = 0; m < 4; ++m) _Pragma("unroll") for (int k = 0; k < 2; ++k) dst[m][k] = *(const PG8_LAS bf16x8*)(lds + PG8_SA(b, h) + aoff + m * 2048 + k * 1024); } while (0)
#define PG8_LDB(dst, b, h) do { _Pragma("unroll") for (int n = 0; n < 2; ++n) _Pragma("unroll") for (int k = 0; k < 2; ++k) dst[n][k] = *(const PG8_LAS bf16x8*)(lds + PG8_SB(b, h) + boff + n * 2048 + k * 1024); } while (0)
#define PG8_MMA(ai, bj, At, Bt) do { __builtin_amdgcn_s_setprio(1); _Pragma("unroll") for (int m = 0; m < 4; ++m) _Pragma("unroll") for (int n = 0; n < 2; ++n) _Pragma("unroll") for (int k = 0; k < 2; ++k) \
        acc[ai][bj][m][n] = __builtin_amdgcn_mfma_f32_16x16x32_bf16(Bt[n][k], At[m][k], acc[ai][bj][m][n], 0, 0, 0); __builtin_amdgcn_s_setprio(0); } while (0)
#define PG8_WAIT_V(n) asm volatile("s_waitcnt vmcnt(" #n ")" ::: "memory")
#define PG8_WAIT_L(n) asm volatile("s_waitcnt lgkmcnt(" #n ")" ::: "memory")
#define PG8_BAR __builtin_amdgcn_s_barrier()
#define PG8_SCHED __builtin_amdgcn_sched_barrier(0)
    Unit cur, nxt; int ui = 0;
    if (!S.next(0, cur)) return;
    f32x4 acc[2][2][4][2];
#pragma unroll
    for (int a = 0; a < 2; ++a)
#pragma unroll
        for (int b = 0; b < 2; ++b)
#pragma unroll
            for (int m = 0; m < 4; ++m)
#pragma unroll
                for (int n = 0; n < 2; ++n) acc[a][b][m][n] = (f32x4){0.f, 0.f, 0.f, 0.f};
    bf16x8 At[4][2], B0[2][2], B1[2][2];
    const char* cA = (const char*)g.A + (size_t)cur.pm * tstep; const char* cB = (const char*)g.Bt + (size_t)cur.pn * tstep;
    S.a_ready(cur);
    if constexpr (SP2) {
        PG8_STAGE(PG8_SB(0, 0), cB, voffB); PG8_STAGE(PG8_SB(0, 1), cB + hstep, voffB); PG8_STAGE(PG8_SA(0, 0), cA, voffA); PG8_STAGE(PG8_SA(0, 1), cA + hstep, voffA);
        if (wr == 1) PG8_BAR;
        PG8_WAIT_V(2); PG8_BAR;
        PG8_STAGE(PG8_SB(1, 0), cB + kstep, voffB); PG8_STAGE(PG8_SA(1, 0), cA + kstep, voffA); PG8_STAGE(PG8_SB(1, 1), cB + hstep + kstep, voffB);
        PG8_WAIT_V(6); PG8_BAR;
    } else {
        PG8_STAGE(PG8_SB(0, 0), cB, voffB); PG8_STAGE(PG8_SA(0, 0), cA, voffA); PG8_STAGE(PG8_SB(0, 1), cB + hstep, voffB); PG8_STAGE(PG8_SA(0, 1), cA + hstep, voffA);
        if (wr == 1) PG8_BAR;
        PG8_WAIT_V(4); PG8_BAR;
        PG8_STAGE(PG8_SB(1, 0), cB + kstep, voffB); PG8_STAGE(PG8_SA(1, 0), cA + kstep, voffA); PG8_STAGE(PG8_SB(1, 1), cB + hstep + kstep, voffB);
        PG8_WAIT_V(6); PG8_BAR;
    }
    for (;;) {
        const bool has_next = S.next(ui + 1, nxt);
        const char* nA = has_next ? (const char*)g.A + (size_t)nxt.pm * tstep : cA; const char* nB = has_next ? (const char*)g.Bt + (size_t)nxt.pn * tstep : cB;
        for (int t = 0; t < nt; t += 2) {
            const bool last = (t == nt - 2);
            const char* a1 = cA + (size_t)(t + 1) * kstep;
            const char* a2 = last ? nA : cA + (size_t)(t + 2) * kstep; const char* b2 = last ? nB : cB + (size_t)(t + 2) * kstep;
            const char* a3 = a2 + kstep; const char* b3 = b2 + kstep;
            if (last && has_next) S.a_ready(nxt);
            if constexpr (SP2) {
            PG8_LDB(B0, 0, 0); PG8_LDB(B1, 0, 1); PG8_SCHED; PG8_LDA(At, 0, 0); PG8_STAGE(PG8_SA(1, 1), a1 + hstep, voffA);
            PG8_WAIT_V(8); PG8_WAIT_L(0); PG8_BAR; PG8_MMA(0, 0, At, B0); PG8_MMA(0, 1, At, B1); PG8_BAR; PG8_SCHED;
            PG8_LDA(At, 0, 1); PG8_STAGE(PG8_SB(0, 0), b2, voffB); PG8_STAGE(PG8_SB(0, 1), b2 + hstep, voffB); PG8_STAGE(PG8_SA(0, 0), a2, voffA);
            PG8_WAIT_V(8); PG8_WAIT_L(0); PG8_BAR; PG8_MMA(1, 0, At, B0); PG8_MMA(1, 1, At, B1); PG8_BAR; PG8_SCHED;
            PG8_LDB(B0, 1, 0); PG8_LDB(B1, 1, 1); PG8_SCHED; PG8_LDA(At, 1, 0); PG8_STAGE(PG8_SA(0, 1), a2 + hstep, voffA);
            PG8_WAIT_V(8); PG8_WAIT_L(0); PG8_BAR; PG8_MMA(0, 0, At, B0); PG8_MMA(0, 1, At, B1); PG8_BAR; PG8_SCHED;
            PG8_LDA(At, 1, 1); PG8_STAGE(PG8_SB(1, 0), b3, voffB); PG8_STAGE(PG8_SB(1, 1), b3 + hstep, voffB); PG8_STAGE(PG8_SA(1, 0), a3, voffA);
            PG8_WAIT_V(8); PG8_WAIT_L(0); PG8_BAR; PG8_MMA(1, 0, At, B0); PG8_MMA(1, 1, At, B1); PG8_BAR; PG8_SCHED;
            } else {
            PG8_LDB(B0, 0, 0); PG8_SCHED; PG8_LDA(At, 0, 0); PG8_STAGE(PG8_SA(1, 1), a1 + hstep, voffA);
            PG8_WAIT_L(8); PG8_BAR; PG8_WAIT_L(0); PG8_MMA(0, 0, At, B0); PG8_BAR; PG8_SCHED;
            PG8_LDB(B1, 0, 1); PG8_STAGE(PG8_SB(0, 0), b2, voffB);
            PG8_BAR; PG8_WAIT_L(0); PG8_MMA(0, 1, At, B1); PG8_BAR;
            PG8_LDA(At, 0, 1); PG8_STAGE(PG8_SA(0, 0), a2, voffA);
            PG8_BAR; PG8_WAIT_L(0); PG8_MMA(1, 0, At, B0); PG8_BAR; PG8_SCHED;
            PG8_STAGE(PG8_SB(0, 1), b2 + hstep, voffB);
            PG8_WAIT_V(6); PG8_BAR; PG8_MMA(1, 1, At, B1); PG8_BAR;
            PG8_LDB(B0, 1, 0); PG8_SCHED; PG8_LDA(At, 1, 0); PG8_STAGE(PG8_SA(0, 1), a2 + hstep, voffA);
            PG8_WAIT_L(8); PG8_BAR; PG8_WAIT_L(0); PG8_MMA(0, 0, At, B0); PG8_BAR; PG8_SCHED;
            PG8_LDB(B1, 1, 1); PG8_STAGE(PG8_SB(1, 0), b3, voffB);
            PG8_BAR; PG8_WAIT_L(0); PG8_MMA(0, 1, At, B1); PG8_BAR;
            PG8_LDA(At, 1, 1); PG8_STAGE(PG8_SA(1, 0), a3, voffA);
            PG8_BAR; PG8_WAIT_L(0); PG8_MMA(1, 0, At, B0); PG8_BAR; PG8_SCHED;
            PG8_STAGE(PG8_SB(1, 1), b3 + hstep, voffB);
            PG8_WAIT_V(6); PG8_BAR; PG8_MMA(1, 1, At, B1); PG8_BAR;
            }
        }
        if constexpr (ALIGN_EPI) { if (wr == 0) PG8_BAR; }
        if constexpr (!Epi::AFTER_DRAIN) { E(acc, cur, wr, wc, fr, fq); S.done(cur); }
        if (!has_next) break;
#pragma unroll
        for (int a = 0; a < 2; ++a)
#pragma unroll
            for (int b = 0; b < 2; ++b)
#pragma unroll
                for (int m = 0; m < 4; ++m)
#pragma unroll
                    for (int n = 0; n < 2; ++n) acc[a][b][m][n] = (f32x4){0.f, 0.f, 0.f, 0.f};
        cur = nxt; cA = nA; cB = nB; ++ui;
        if constexpr (ALIGN_EPI) { if (wr == 1) PG8_BAR; }
    }
    PG8_WAIT_V(0);
    if constexpr (!ALIGN_EPI) { if (wr == 0) PG8_BAR; }
    PG8_BAR;
#undef PG8_SA
#undef PG8_SB
#undef PG8_STAGE
#undef PG8_LDA
#undef PG8_LDB
#undef PG8_MMA
#undef PG8_WAIT_V
#undef PG8_WAIT_L
#undef PG8_BAR
#undef PG8_SCHED
}
}

#define PG8_SP2 true
#define PG8_ALIGN true

constexpr int NWAVES = 8, NTHR = NWAVES * 64;
constexpr int D_MODEL = 2048, BATCH = 2, SEQ = 16384, DEPTH = 2, PLE_DIM = 256, D_FF = 5632, CONV_WIDTH = 512;
constexpr int NHEAD = 16, NKV = 2, HEAD_DIM = 64, WINDOW = 128;
constexpr int HG_H = 8, HG_DK = 128, HG_DV = 64, HG_C = 64, HG_NC = SEQ / HG_C;
constexpr int M = BATCH * SEQ;
constexpr int D_IN = 12032, N_MAIN = 5888, N_GATES = 6144;
constexpr int C_CX = 0, C_CB = 512, C_CC = 1024, C_AQ = 1536, C_AK = 2560, C_AV = 2688, C_RQ = 2816, C_RF = 3840, C_RI = 4864, C_RG = 5376;
constexpr float NORM_EPS = 1e-6f;
constexpr int NPH = 18;
constexpr int NPHASES = DEPTH * NPH;

constexpr size_t MiB = 1u << 20;
constexpr size_t WS_CTL = 0, CTL_ZERO_BYTES = 1 * MiB;
constexpr size_t WS_GU1 = 2 * MiB, WS_D1 = 46 * MiB, WS_WIN = 68 * MiB, WS_BC = 115 * MiB, WS_BA = 117 * MiB, WS_BH = 121 * MiB, WS_WO = 123 * MiB,
                 WS_GU2 = 131 * MiB, WS_D2 = 175 * MiB, WS_PG = 197 * MiB, WS_PP = 205 * MiB, WS_PB = 206 * MiB;
constexpr size_t WS_X16 = 222 * MiB;
constexpr size_t WS_Y = 350 * MiB;
constexpr size_t WS_FC = WS_Y, WS_FA = WS_Y + 32 * MiB, WS_FH = WS_Y + 96 * MiB;
constexpr size_t WS_BIG = 478 * MiB;
constexpr size_t WS_UT = WS_BIG + 368 * MiB;
constexpr size_t WS_DD = WS_UT + 64 * MiB;
constexpr size_t WS_MG = WS_BIG + 384 * MiB;
constexpr size_t WS_RS = WS_MG + 128 * MiB;
constexpr size_t WS_END = WS_RS + 1 * MiB;
constexpr int CW_BAR = 4096;

constexpr int RING_BYTES = 131072;
constexpr int LDS_X_OFF = RING_BYTES;
constexpr int MISC_OFF = RING_BYTES + 8192;
constexpr int LDS_BYTES = 147456;

#define GAS __attribute__((address_space(1)))
#define LAS __attribute__((address_space(3)))
typedef unsigned short bf16;
typedef unsigned v4u __attribute__((ext_vector_type(4)));
typedef float f32x4 __attribute__((ext_vector_type(4)));
typedef GAS unsigned gu32;
#define LDS_WAIT() asm volatile("s_waitcnt lgkmcnt(0)" ::: "memory")
__device__ __forceinline__ unsigned f2bf(float f) { unsigned u = __builtin_bit_cast(unsigned, f); return (u + 0x7fffu + ((u >> 16) & 1u)) >> 16; }
__device__ __forceinline__ unsigned pk2(float lo, float hi) { return f2bf(lo) | (f2bf(hi) << 16); }
__device__ __forceinline__ float bf2f(bf16 b) { return __uint_as_float((unsigned)b << 16); }
__device__ __forceinline__ float blo(unsigned w) { return __uint_as_float(w << 16); }
__device__ __forceinline__ float bhi(unsigned w) { return __uint_as_float(w & 0xffff0000u); }
__device__ __forceinline__ float sigm(float v) { return __builtin_amdgcn_rcpf(1.0f + __builtin_amdgcn_exp2f(-1.4426950408889634f * v)); }

#define XB_TMO      128
#define XB_XCNT(j)  (256  + 64 * (j))
#define XB_XSUB(j)  (1280 + 64 * (j))
#define XB_XGEN(j)  (2304 + 64 * (j))
#define XB_TOP      3328
#define XB_TOPGEN   3392
#define XCD_BAR_WORDS 3456
#define XB_SPIN_CAP (1u << 18)
__device__ __forceinline__ unsigned xb_ld(unsigned* p)              { return __hip_atomic_load(p, __ATOMIC_RELAXED, __HIP_MEMORY_SCOPE_AGENT); }
__device__ __forceinline__ unsigned xb_add(unsigned* p, unsigned v) { return __hip_atomic_fetch_add(p, v, __ATOMIC_RELAXED, __HIP_MEMORY_SCOPE_AGENT); }
__device__ __forceinline__ unsigned xb_xcc_id() { return (unsigned)__builtin_amdgcn_s_getreg((3 << 11) | 20) & 0xFu; }
#define XB_SPIN(cond, bar) do { unsigned _sp = 0; while (cond) { __builtin_amdgcn_s_sleep(1); \
    if ((++_sp & 255u) == 0u) { if (xb_ld(&(bar)[XB_TMO])) break; if (_sp > XB_SPIN_CAP) { atomicAdd(&(bar)[XB_TMO], 1u); break; } } } } while (0)
struct XcdBarrier { unsigned* bar; unsigned x; volatile LAS unsigned* st; };
__device__ __forceinline__ XcdBarrier xcd_barrier_post(unsigned* bar, volatile LAS unsigned* st) {
    XcdBarrier b; b.bar = bar; b.x = xb_xcc_id(); b.st = st;
    if (threadIdx.x == 0) (void)xb_add(&bar[XB_XCNT(b.x)], 1u);
    return b;
}
__device__ __forceinline__ void xcd_barrier_complete(unsigned* bar, unsigned x, unsigned& nloc, unsigned& nx) {
    const unsigned G = gridDim.x * gridDim.y * gridDim.z;
    unsigned sum, cnt, mine, sp = 0u;
    for (;;) {
        sum = 0u; cnt = 0u; mine = 0u;
#pragma unroll
        for (unsigned j = 0; j < 16; ++j) { const unsigned c = xb_ld(&bar[XB_XCNT(j)]); sum += c; cnt += (c > 0u) ? 1u : 0u; mine = (j == x) ? c : mine; }
        if (sum == G) break;
        __builtin_amdgcn_s_sleep(1);
        if ((++sp & 255u) == 0u) { if (xb_ld(&bar[XB_TMO])) break; if (sp > XB_SPIN_CAP) { atomicAdd(&bar[XB_TMO], 1u); break; } }
    }
    nloc = mine > 0u ? mine : 1u; nx = cnt > 0u ? cnt : 1u;
}
__device__ __forceinline__ void xcd_barrier(const XcdBarrier& b) {
    asm volatile("s_waitcnt vmcnt(0)" ::: "memory");
    __syncthreads();
    if (threadIdx.x == 0) {
        unsigned* bar = b.bar;
        __builtin_amdgcn_s_waitcnt(0);
        unsigned nloc = b.st[0], nx = b.st[1];
        if (nloc == 0u) { xcd_barrier_complete(bar, b.x, nloc, nx); b.st[0] = nloc; b.st[1] = nx; }
        const unsigned old = xb_add(&bar[XB_XSUB(b.x)], 1u);
        const unsigned gen = old / nloc;
        if (old + 1u == (gen + 1u) * nloc) {
            __builtin_amdgcn_fence(__ATOMIC_RELEASE, "agent");
            asm volatile("s_waitcnt vmcnt(0)" ::: "memory");
            const unsigned og = xb_add(&bar[XB_TOP], 1u);
            const unsigned tg = og / nx;
            if (og + 1u == (tg + 1u) * nx) xb_add(&bar[XB_TOPGEN], 1u);
            else XB_SPIN(xb_ld(&bar[XB_TOPGEN]) == tg, bar);
            __builtin_amdgcn_fence(__ATOMIC_ACQUIRE, "agent");
            xb_add(&bar[XB_XGEN(b.x)], 1u);
            asm volatile("s_waitcnt vmcnt(0)" ::: "memory");
        } else {
            XB_SPIN(xb_ld(&bar[XB_XGEN(b.x)]) == gen, bar);
            __builtin_amdgcn_fence(__ATOMIC_ACQUIRE, "agent");
            asm volatile("s_waitcnt vmcnt(0)" ::: "memory");
        }
    }
    __syncthreads();
}

struct Args { const float* in[25]; float* out; unsigned char* ws; int ph_lo, ph_hi; };
struct Frame {
    LAS unsigned char* lds;
    int G, bid, wv;
    const float* const* in;
    float* out; unsigned char* ws;
};
#define PHASE_TID() unsigned z_ = 0u; asm volatile("" : "+s"(z_)); int lane_ = (int)__builtin_amdgcn_mbcnt_hi(~0u, __builtin_amdgcn_mbcnt_lo(~0u, z_)); asm volatile("" : "+v"(lane_)); const int lane = lane_, wave = F.wv, tid = (wave << 6) | lane; (void)lane; (void)wave; (void)tid
template <int MASK> __device__ __forceinline__ float swz_xor(float v) { return __int_as_float(__builtin_amdgcn_ds_swizzle(__float_as_int(v), 0x1f | (MASK << 10))); }
__device__ __forceinline__ float xor32_sum(float v) { const auto rr = __builtin_amdgcn_permlane32_swap(__float_as_uint(v), __float_as_uint(v), false, false); return __uint_as_float(rr[0]) + __uint_as_float(rr[1]); }
__device__ __forceinline__ float xor32_max(float v) { const auto rr = __builtin_amdgcn_permlane32_swap(__float_as_uint(v), __float_as_uint(v), false, false); return fmaxf(__uint_as_float(rr[0]), __uint_as_float(rr[1])); }
__device__ __forceinline__ float wave_sum(float v) {
    v += swz_xor<1>(v); v += swz_xor<2>(v); v += swz_xor<4>(v); v += swz_xor<8>(v); v += swz_xor<16>(v);
    return xor32_sum(v);
}
__device__ __forceinline__ float wave_max(float v) {
    v = fmaxf(v, swz_xor<1>(v)); v = fmaxf(v, swz_xor<2>(v)); v = fmaxf(v, swz_xor<4>(v)); v = fmaxf(v, swz_xor<8>(v)); v = fmaxf(v, swz_xor<16>(v));
    return xor32_max(v);
}

__device__ __forceinline__ void transpose_item(const float* W, int K, int N, bf16* WT, LAS float* scr, int item, int lane, bool gu, const float* gain = nullptr) {
    const int nblk = N / 32, kb = item / nblk, nb = item % nblk, k0 = 64 * kb, nd0 = 32 * nb;
    int ns0 = nd0;
    if (gu) { const int pn = nb >> 3, j = nb & 7; ns0 = ((j & 4) ? D_FF : 0) + 128 * pn + 32 * (j & 3); }
    float wv[32];
#pragma unroll
    for (int i = 0; i < 32; ++i) { const int kk = 2 * i + (lane >> 5); wv[i] = W[(size_t)(k0 + kk) * N + ns0 + (lane & 31)]; }
#pragma unroll
    for (int i = 0; i < 32; ++i) { const int kk = 2 * i + (lane >> 5); scr[kk * 33 + (lane & 31)] = wv[i] * (gain ? gain[k0 + kk] : 1.0f); }
    LDS_WAIT(); asm volatile("" ::: "memory");
    const int c = lane & 7;
#pragma unroll
    for (int j = 0; j < 4; ++j) { const int n = (lane >> 3) + 8 * j; const LAS float* s = scr + (8 * c) * 33 + n;
        v4u o; o.x = pk2(s[0 * 33], s[1 * 33]); o.y = pk2(s[2 * 33], s[3 * 33]); o.z = pk2(s[4 * 33], s[5 * 33]); o.w = pk2(s[6 * 33], s[7 * 33]);
        *(GAS v4u*)(WT + (size_t)(nd0 + n) * K + k0 + 8 * c) = o; }
    LDS_WAIT(); asm volatile("" ::: "memory");
}
__device__ __forceinline__ void x_row_to_bf16(int lane, const float* xrow, bf16* orow, float* rs) {
    float ss = 0.f;
#pragma unroll
    for (int j = 0; j < 4; ++j) { const f32x4 a = *(const f32x4*)(xrow + 8 * lane + 512 * j), b = *(const f32x4*)(xrow + 8 * lane + 512 * j + 4);
        ss += (a.x * a.x + a.y * a.y) + (a.z * a.z + a.w * a.w) + (b.x * b.x + b.y * b.y) + (b.z * b.z + b.w * b.w);
        v4u o; o.x = pk2(a.x, a.y); o.y = pk2(a.z, a.w); o.z = pk2(b.x, b.y); o.w = pk2(b.z, b.w);
        *(v4u*)(orow + 8 * lane + 512 * j) = o; }
    ss = wave_sum(ss);
    if (lane == 0) *rs = 1.0f / sqrtf(ss * (1.0f / D_MODEL) + NORM_EPS);
}

__device__ __forceinline__ void phase_convert(Frame& F, int l) {
    PHASE_TID();
    LAS float* scr = (LAS float*)(F.lds + wave * 16384);
    const int gw = F.bid * NWAVES + wave, NGW = F.G * NWAVES;
    unsigned char* ws = F.ws;
    constexpr int I_GU = (D_MODEL / 64) * (2 * D_FF / 32), I_D = (D_FF / 64) * (D_MODEL / 32), I_WIN = (D_MODEL / 64) * (D_IN / 32),
                  I_BC = (CONV_WIDTH / 64) * (D_MODEL / 32), I_BA = (1024 / 64) * (D_MODEL / 32), I_BH = (512 / 64) * (D_MODEL / 32),
                  I_SQ = (D_MODEL / 64) * (D_MODEL / 32), I_PP = (PLE_DIM / 64) * (D_MODEL / 32);
    constexpr int NITEMS = 2 * I_GU + 2 * I_D + I_WIN + I_BC + I_BA + I_BH + 2 * I_SQ + I_PP;
    for (int it = gw; it < NITEMS; it += NGW) {
        int r = it;
        if (r < I_GU) { transpose_item(F.in[3] + (size_t)l * D_MODEL * 2 * D_FF, D_MODEL, 2 * D_FF, (bf16*)(ws + WS_GU1), scr, r, lane, true, F.in[2] + l * D_MODEL); continue; } r -= I_GU;
        if (r < I_D) { transpose_item(F.in[4] + (size_t)l * D_FF * D_MODEL, D_FF, D_MODEL, (bf16*)(ws + WS_D1), scr, r, lane, false); continue; } r -= I_D;
        if (r < I_WIN) { transpose_item(F.in[7] + (size_t)l * D_MODEL * D_IN, D_MODEL, D_IN, (bf16*)(ws + WS_WIN), scr, r, lane, false, F.in[6] + l * D_MODEL); continue; } r -= I_WIN;
        if (r < I_BC) { transpose_item(F.in[12] + (size_t)l * CONV_WIDTH * D_MODEL, CONV_WIDTH, D_MODEL, (bf16*)(ws + WS_BC), scr, r, lane, false); continue; } r -= I_BC;
        if (r < I_BA) { transpose_item(F.in[13] + (size_t)l * 1024 * D_MODEL, 1024, D_MODEL, (bf16*)(ws + WS_BA), scr, r, lane, false); continue; } r -= I_BA;
        if (r < I_BH) { transpose_item(F.in[14] + (size_t)l * 512 * D_MODEL, 512, D_MODEL, (bf16*)(ws + WS_BH), scr, r, lane, false); continue; } r -= I_BH;
        if (r < I_SQ) { transpose_item(F.in[15] + (size_t)l * D_MODEL * D_MODEL, D_MODEL, D_MODEL, (bf16*)(ws + WS_WO), scr, r, lane, false); continue; } r -= I_SQ;
        if (r < I_GU) { transpose_item(F.in[18] + (size_t)l * D_MODEL * 2 * D_FF, D_MODEL, 2 * D_FF, (bf16*)(ws + WS_GU2), scr, r, lane, true, F.in[17] + l * D_MODEL); continue; } r -= I_GU;
        if (r < I_D) { transpose_item(F.in[19] + (size_t)l * D_FF * D_MODEL, D_FF, D_MODEL, (bf16*)(ws + WS_D2), scr, r, lane, false); continue; } r -= I_D;
        if (r < I_SQ) { transpose_item(F.in[22] + (size_t)l * D_MODEL * D_MODEL, D_MODEL, D_MODEL, (bf16*)(ws + WS_PG), scr, r, lane, false, F.in[21] + l * D_MODEL); continue; } r -= I_SQ;
        transpose_item(F.in[23] + (size_t)l * PLE_DIM * D_MODEL, PLE_DIM, D_MODEL, (bf16*)(ws + WS_PP), scr, r, lane, false);
    }
    { const float* p = F.in[1] + (size_t)l * M * PLE_DIM; bf16* pb = (bf16*)(ws + WS_PB);
      const size_t n8 = (size_t)M * PLE_DIM / 8;
      for (size_t i = (size_t)F.bid * NTHR + tid; i < n8; i += (size_t)F.G * NTHR) {
          const f32x4 a = *(const f32x4*)(p + 8 * i), b = *(const f32x4*)(p + 8 * i + 4);
          v4u o; o.x = pk2(a.x, a.y); o.y = pk2(a.z, a.w); o.z = pk2(b.x, b.y); o.w = pk2(b.z, b.w);
          *(v4u*)(pb + 8 * i) = o; } }
    if (l == 0) {
        for (int m = gw; m < M; m += NGW) x_row_to_bf16(lane, F.in[0] + (size_t)m * D_MODEL, (bf16*)(ws + WS_X16) + (size_t)m * D_MODEL, (float*)(ws + WS_RS) + m);
    }
}

__device__ __forceinline__ void phase_norm(Frame& F, float alpha, const float* wpost, bool final_, int ph = 0) {
    PHASE_TID();
    const int gw = F.bid * NWAVES + wave, NGW = F.G * NWAVES;
    const bf16* Y = (const bf16*)(F.ws + WS_Y); bf16* X = (bf16*)(F.ws + WS_X16); float* RS = (float*)(F.ws + WS_RS);
    for (int m0 = gw; m0 < M; m0 += 2 * NGW) {
        v4u yw[2][4], xw[2][4];
#pragma unroll
        for (int q = 0; q < 2; ++q) { const int m = m0 + q * NGW;
            if (m < M) {
#pragma unroll
                for (int j = 0; j < 4; ++j) { yw[q][j] = *(const v4u*)(Y + (size_t)m * D_MODEL + 8 * lane + 512 * j); xw[q][j] = *(const v4u*)(X + (size_t)m * D_MODEL + 8 * lane + 512 * j); } } }
#pragma unroll
        for (int q = 0; q < 2; ++q) { const int m = m0 + q * NGW;
            if (m < M) {
                bf16* xrow = X + (size_t)m * D_MODEL;
                float y[4][8]; float ss = 0.f;
#pragma unroll
                for (int j = 0; j < 4; ++j) { const v4u w = yw[q][j];
                    y[j][0] = blo(w.x); y[j][1] = bhi(w.x); y[j][2] = blo(w.y); y[j][3] = bhi(w.y); y[j][4] = blo(w.z); y[j][5] = bhi(w.z); y[j][6] = blo(w.w); y[j][7] = bhi(w.w);
#pragma unroll
                    for (int e = 0; e < 8; ++e) ss += y[j][e] * y[j][e]; }
                const float rstd = alpha / sqrtf(wave_sum(ss) * (1.0f / D_MODEL) + NORM_EPS);
#if MK_CHECK
                { float mxv = 0.f;
#pragma unroll
                  for (int j = 0; j < 4; ++j)
#pragma unroll
                      for (int e = 0; e < 8; ++e) mxv = fmaxf(mxv, fabsf(y[j][e]));
                  mxv = wave_max(mxv) * rstd / alpha;
                  if (mxv > 20.0f && lane == 0) { atomicMax((unsigned*)(F.ws + WS_CTL) + 65, (unsigned)(NPHASES - ph)); atomicAdd((unsigned*)(F.ws + WS_CTL) + 128 + ph, 1u); } }
#endif
                float ss2 = 0.f;
#pragma unroll
                for (int j = 0; j < 4; ++j) { const int c = 8 * lane + 512 * j; const v4u xv = xw[q][j];
                    const f32x4 w0 = *(const f32x4*)(wpost + c), w1 = *(const f32x4*)(wpost + c + 4);
                    y[j][0] = blo(xv.x) + y[j][0] * rstd * w0.x; y[j][1] = bhi(xv.x) + y[j][1] * rstd * w0.y; y[j][2] = blo(xv.y) + y[j][2] * rstd * w0.z; y[j][3] = bhi(xv.y) + y[j][3] * rstd * w0.w;
                    y[j][4] = blo(xv.z) + y[j][4] * rstd * w1.x; y[j][5] = bhi(xv.z) + y[j][5] * rstd * w1.y; y[j][6] = blo(xv.w) + y[j][6] * rstd * w1.z; y[j][7] = bhi(xv.w) + y[j][7] * rstd * w1.w;
                    if (final_) { float* xo = F.out + (size_t)m * D_MODEL + c;
                        *(f32x4*)xo = (f32x4){y[j][0], y[j][1], y[j][2], y[j][3]}; *(f32x4*)(xo + 4) = (f32x4){y[j][4], y[j][5], y[j][6], y[j][7]}; }
                    else { v4u o; o.x = pk2(y[j][0], y[j][1]); o.y = pk2(y[j][2], y[j][3]); o.z = pk2(y[j][4], y[j][5]); o.w = pk2(y[j][6], y[j][7]);
                        *(v4u*)(xrow + c) = o;
#pragma unroll
                        for (int e = 0; e < 8; ++e) ss2 += y[j][e] * y[j][e]; } }
                if (!final_) { ss2 = wave_sum(ss2); if (lane == 0) RS[m] = 1.0f / sqrtf(ss2 * (1.0f / D_MODEL) + NORM_EPS); }
            } }
    }
}

__device__ __forceinline__ void phase_conv(Frame& F, int l) {
    PHASE_TID();
    const bf16* main_ = (const bf16*)(F.ws + WS_BIG); bf16* FC = (bf16*)(F.ws + WS_FC);
    const float* cw = F.in[8] + (size_t)l * 3 * CONV_WIDTH;
    for (int strip = F.bid * NTHR + tid; strip < (M / 16) * 64; strip += F.G * NTHR) {
        const int cg = strip & 63, row0 = (strip >> 6) * 16, t0 = row0 & (SEQ - 1);
        float w[3][8];
#pragma unroll
        for (int j = 0; j < 3; ++j) { const f32x4 a = *(const f32x4*)(cw + j * CONV_WIDTH + 8 * cg), b = *(const f32x4*)(cw + j * CONV_WIDTH + 8 * cg + 4);
            w[j][0] = a.x; w[j][1] = a.y; w[j][2] = a.z; w[j][3] = a.w; w[j][4] = b.x; w[j][5] = b.y; w[j][6] = b.z; w[j][7] = b.w; }
        float u1[8], u2[8];
#pragma unroll
        for (int e = 0; e < 8; ++e) { u1[e] = 0.f; u2[e] = 0.f; }
        if (t0 > 0) {
            const bf16* r1 = main_ + (size_t)(row0 - 1) * N_MAIN + 8 * cg; const bf16* r2 = main_ + (size_t)(row0 - 2) * N_MAIN + 8 * cg;
            const v4u x1 = *(const v4u*)(r1 + C_CX), c1 = *(const v4u*)(r1 + C_CC), x2 = *(const v4u*)(r2 + C_CX), c2 = *(const v4u*)(r2 + C_CC);
            u1[0] = blo(x1.x) * blo(c1.x); u1[1] = bhi(x1.x) * bhi(c1.x); u1[2] = blo(x1.y) * blo(c1.y); u1[3] = bhi(x1.y) * bhi(c1.y);
            u1[4] = blo(x1.z) * blo(c1.z); u1[5] = bhi(x1.z) * bhi(c1.z); u1[6] = blo(x1.w) * blo(c1.w); u1[7] = bhi(x1.w) * bhi(c1.w);
            u2[0] = blo(x2.x) * blo(c2.x); u2[1] = bhi(x2.x) * bhi(c2.x); u2[2] = blo(x2.y) * blo(c2.y); u2[3] = bhi(x2.y) * bhi(c2.y);
            u2[4] = blo(x2.z) * blo(c2.z); u2[5] = bhi(x2.z) * bhi(c2.z); u2[6] = blo(x2.w) * blo(c2.w); u2[7] = bhi(x2.w) * bhi(c2.w);
        }
#pragma unroll 1
        for (int rq = 0; rq < 16; rq += 4) {
            v4u xv[4], cv[4], bv[4];
#pragma unroll
            for (int i = 0; i < 4; ++i) { const bf16* rp = main_ + (size_t)(row0 + rq + i) * N_MAIN + 8 * cg; xv[i] = *(const v4u*)(rp + C_CX); cv[i] = *(const v4u*)(rp + C_CC); bv[i] = *(const v4u*)(rp + C_CB); }
#pragma unroll
            for (int i = 0; i < 4; ++i) {
                float u0[8], y[8];
                u0[0] = blo(xv[i].x) * blo(cv[i].x); u0[1] = bhi(xv[i].x) * bhi(cv[i].x); u0[2] = blo(xv[i].y) * blo(cv[i].y); u0[3] = bhi(xv[i].y) * bhi(cv[i].y);
                u0[4] = blo(xv[i].z) * blo(cv[i].z); u0[5] = bhi(xv[i].z) * bhi(cv[i].z); u0[6] = blo(xv[i].w) * blo(cv[i].w); u0[7] = bhi(xv[i].w) * bhi(cv[i].w);
#pragma unroll
                for (int e = 0; e < 8; ++e) { y[e] = w[2][e] * u0[e] + w[1][e] * u1[e] + w[0][e] * u2[e]; u2[e] = u1[e]; u1[e] = u0[e]; }
                v4u o; o.x = pk2(y[0] * blo(bv[i].x), y[1] * bhi(bv[i].x)); o.y = pk2(y[2] * blo(bv[i].y), y[3] * bhi(bv[i].y));
                o.z = pk2(y[4] * blo(bv[i].z), y[5] * bhi(bv[i].z)); o.w = pk2(y[6] * blo(bv[i].w), y[7] * bhi(bv[i].w));
                *(v4u*)(FC + (size_t)(row0 + rq + i) * CONV_WIDTH + 8 * cg) = o; }
        }
    }
}
typedef float f32x16 __attribute__((ext_vector_type(16)));
typedef short s16x8 __attribute__((ext_vector_type(8)));
typedef short s16x4 __attribute__((ext_vector_type(4)));
typedef unsigned u32x2 __attribute__((ext_vector_type(2)));
constexpr int AT_KP = 144, AT_VP = 520, AT_VOFF = 256 * AT_KP;
__device__ __forceinline__ void phase_attn_mfma(Frame& F, int l) {
    PHASE_TID();
    const bf16* main_ = (const bf16*)(F.ws + WS_BIG); bf16* FA = (bf16*)(F.ws + WS_FA);
    LAS unsigned char* KL = F.lds; LAS unsigned char* VL = F.lds + AT_VOFF;
    const int r32 = lane & 31, hi = lane >> 5;
    constexpr float L2E = 1.4426950408889634f, NEG = -1e30f;
    constexpr int NU = BATCH * (SEQ / 128) * NKV;
    v4u kvr[4], vvr[4];
#define AT_LOAD(u_) do { const int hk_ = (u_) & 1, n_ = ((u_) >> 1) & 127, b_ = (u_) >> 8; const size_t r0_ = (size_t)b_ * SEQ + (size_t)n_ * 128; \
        _Pragma("unroll") for (int i = 0; i < 4; ++i) { const int idx = tid + NTHR * i, key = idx & 255, dg = idx >> 8; kvr[i] = (v4u){0u, 0u, 0u, 0u}; vvr[i] = (v4u){0u, 0u, 0u, 0u}; \
            if (n_ > 0 || key >= 128) { const bf16* rp = main_ + (r0_ - 128 + key) * N_MAIN + hk_ * 64 + dg * 8; kvr[i] = *(const v4u*)(rp + C_AK); vvr[i] = *(const v4u*)(rp + C_AV); } } } while (0)
    int unit = F.bid;
    if (unit < NU) AT_LOAD(unit);
    for (; unit < NU; unit += F.G) {
        const int hk = unit & 1, n = (unit >> 1) & 127, b = unit >> 8;
        const size_t row0 = (size_t)b * SEQ + (size_t)n * 128;
        const int h = hk * 8 + wave;
        s16x8 qf[4];
#pragma unroll
        for (int ks = 0; ks < 4; ++ks) qf[ks] = *(const s16x8*)(main_ + (row0 + r32) * N_MAIN + C_AQ + h * 64 + 16 * ks + 8 * hi);
#pragma unroll
        for (int i = 0; i < 4; ++i) { const int idx = tid + NTHR * i, key = idx & 255, dg = idx >> 8; const v4u vv = vvr[i];
            *(LAS v4u*)(KL + key * AT_KP + dg * 16) = kvr[i];
            LAS unsigned short* vp = (LAS unsigned short*)(VL + (dg * 8) * AT_VP + key * 2);
            vp[0 * (AT_VP / 2)] = (unsigned short)(vv.x & 0xffffu); vp[1 * (AT_VP / 2)] = (unsigned short)(vv.x >> 16);
            vp[2 * (AT_VP / 2)] = (unsigned short)(vv.y & 0xffffu); vp[3 * (AT_VP / 2)] = (unsigned short)(vv.y >> 16);
            vp[4 * (AT_VP / 2)] = (unsigned short)(vv.z & 0xffffu); vp[5 * (AT_VP / 2)] = (unsigned short)(vv.z >> 16);
            vp[6 * (AT_VP / 2)] = (unsigned short)(vv.w & 0xffffu); vp[7 * (AT_VP / 2)] = (unsigned short)(vv.w >> 16); }
        __syncthreads();
        const float slope2 = exp2f(-0.5f * (float)(h + 1)) * L2E, sink2 = F.in[9][l * NHEAD + h] * L2E;
        const float nsb2 = -slope2 * (float)(r32 + 128 - 4 * hi);
#pragma unroll 1
        for (int c = 0; c < 4; ++c) {
            const size_t qrow = row0 + 32 * c + r32;
            if (c == 3 && unit + F.G < NU) { AT_LOAD(unit + F.G); }
            f32x16 S[5];
            float mx = NEG;
#pragma unroll
            for (int d = 0; d < 5; ++d) {
                const int kt = c + d;
                if (n == 0 && kt < 4) {
#pragma unroll
                    for (int r = 0; r < 16; ++r) S[d][r] = NEG;
                } else {
                    f32x16 acc;
#pragma unroll
                    for (int r = 0; r < 16; ++r) acc[r] = 0.f;
#pragma unroll
                    for (int ks = 0; ks < 4; ++ks) { const s16x8 a = *(const LAS s16x8*)(KL + (32 * kt + r32) * AT_KP + (16 * ks + 8 * hi) * 2);
                        acc = __builtin_amdgcn_mfma_f32_32x32x16_bf16(a, qf[ks], acc, 0, 0, 0); }
#pragma unroll
                    for (int r = 0; r < 16; ++r) { const int cr = (r & 3) + 8 * (r >> 2);
                        float s = fmaf(slope2, (float)(32 * d + cr), fmaf(acc[r], 0.125f * L2E, nsb2));
                        if (d == 0) { if (!(r32 - 4 * hi - cr < 0)) s = NEG; }
                        if (d == 4) { if (!(r32 - 4 * hi - cr >= 0)) s = NEG; }
                        S[d][r] = s; mx = fmaxf(mx, s); }
                }
            }
            if (c < 3) {
#pragma unroll
                for (int ks = 0; ks < 4; ++ks) qf[ks] = *(const s16x8*)(main_ + (qrow + 32) * N_MAIN + C_AQ + h * 64 + 16 * ks + 8 * hi);
            }
            mx = xor32_max(mx);
            mx = fmaxf(mx, sink2);
            float sum = 0.f;
            f32x16 O0, O1;
#pragma unroll
            for (int r = 0; r < 16; ++r) { O0[r] = 0.f; O1[r] = 0.f; }
#pragma unroll
            for (int d = 0; d < 5; ++d) {
                const int kt = c + d;
                if (n == 0 && kt < 4) continue;
#pragma unroll
                for (int r = 0; r < 16; ++r) { const float p = __builtin_amdgcn_exp2f(S[d][r] - mx); S[d][r] = p; sum += p; }
#pragma unroll
                for (int s = 0; s < 2; ++s) {
                    v4u pw; pw.x = pg8::cvt_pk_bf16(S[d][8 * s + 0], S[d][8 * s + 1]); pw.y = pg8::cvt_pk_bf16(S[d][8 * s + 2], S[d][8 * s + 3]);
                    pw.z = pg8::cvt_pk_bf16(S[d][8 * s + 4], S[d][8 * s + 5]); pw.w = pg8::cvt_pk_bf16(S[d][8 * s + 6], S[d][8 * s + 7]);
                    const s16x8 pf = __builtin_bit_cast(s16x8, pw);
                    const int kb = (32 * kt + 16 * s + 4 * hi) * 2;
                    { const s16x4 lo = *(const LAS s16x4*)(VL + r32 * AT_VP + kb), hh = *(const LAS s16x4*)(VL + r32 * AT_VP + kb + 16);
                      const s16x8 a = __builtin_shufflevector(lo, hh, 0, 1, 2, 3, 4, 5, 6, 7); O0 = __builtin_amdgcn_mfma_f32_32x32x16_bf16(a, pf, O0, 0, 0, 0); }
                    { const s16x4 lo = *(const LAS s16x4*)(VL + (32 + r32) * AT_VP + kb), hh = *(const LAS s16x4*)(VL + (32 + r32) * AT_VP + kb + 16);
                      const s16x8 a = __builtin_shufflevector(lo, hh, 0, 1, 2, 3, 4, 5, 6, 7); O1 = __builtin_amdgcn_mfma_f32_32x32x16_bf16(a, pf, O1, 0, 0, 0); }
                }
            }
            sum = xor32_sum(sum);
            const float inv = 1.0f / (sum + __builtin_amdgcn_exp2f(sink2 - mx));
            bf16* op = FA + qrow * 1024 + h * 64 + 4 * hi;
#pragma unroll
            for (int rg = 0; rg < 4; ++rg) {
                u32x2 w0; w0.x = pg8::cvt_pk_bf16(O0[4 * rg] * inv, O0[4 * rg + 1] * inv); w0.y = pg8::cvt_pk_bf16(O0[4 * rg + 2] * inv, O0[4 * rg + 3] * inv);
                u32x2 w1; w1.x = pg8::cvt_pk_bf16(O1[4 * rg] * inv, O1[4 * rg + 1] * inv); w1.y = pg8::cvt_pk_bf16(O1[4 * rg + 2] * inv, O1[4 * rg + 3] * inv);
                *(u32x2*)(op + 8 * rg) = w0; *(u32x2*)(op + 32 + 8 * rg) = w1; }
        }
        __syncthreads();
    }
#undef AT_LOAD
}

__device__ __forceinline__ float hgrn_lb(const float* logits, int l, int ch) {
    float mx = -1e30f;
#pragma unroll
    for (int i = 0; i < DEPTH; ++i) mx = fmaxf(mx, logits[i * (HG_H * HG_DK) + ch]);
    float den = 0.f, num = 0.f;
#pragma unroll
    for (int i = 0; i < DEPTH; ++i) { const float e = __expf(logits[i * (HG_H * HG_DK) + ch] - mx); den += e; if (i < l) num += e; }
    return num / den;
}
__device__ __forceinline__ float hgrn_lb2(float x0, float x1, int l) { if (l == 0) return 0.f; const float mx = fmaxf(x0, x1), e0 = __expf(x0 - mx), e1 = __expf(x1 - mx); return e0 / (e0 + e1); }
static_assert(DEPTH == 2, "hgrn_lb2 is written for two layers");
constexpr int HG_P = 144, HG_PK = 272;
__device__ __forceinline__ void phase_hgrn_scan2(Frame& F) {
    PHASE_TID();
    bf16* UTB = (bf16*)(F.ws + WS_UT); const float* DD = (const float*)(F.ws + WS_DD);
    for (int e = F.bid * NTHR + tid; e < BATCH * HG_H * 8192; e += F.G * NTHR) {
        const int bh = e >> 13, vk = e & 8191, k = vk & 127;
        float s = 0.f;
        bf16* up = UTB + (size_t)bh * HG_NC * 8192 + vk; const float* dp = DD + (size_t)bh * HG_NC * 128 + k;
        for (int c = 0; c < HG_NC; c += 32) {
            bf16 u[32]; float d[32];
#pragma unroll
            for (int i = 0; i < 32; ++i) { u[i] = up[(size_t)(c + i) * 8192]; d[i] = dp[(size_t)(c + i) * 128]; }
#pragma unroll
            for (int i = 0; i < 32; ++i) { up[(size_t)(c + i) * 8192] = (bf16)f2bf(s); s = d[i] * s + bf2f(u[i]); }
        }
    }
}

__device__ __forceinline__ void phase_hgrn_c3(Frame& F, int l) {
    PHASE_TID();
    LAS unsigned char* QA = F.lds; LAS unsigned char* KB = F.lds + 17408; LAS unsigned char* QE = F.lds + 34816; LAS unsigned char* VT = F.lds + 52224;
    LAS float* QT = (LAS float*)(F.lds + 61440); LAS float* SSQ = (LAS float*)(F.lds + 63488);
    const bf16* main_ = (const bf16*)(F.ws + WS_BIG); const bf16* UTB = (const bf16*)(F.ws + WS_UT); bf16* FH = (bf16*)(F.ws + WS_FH);
    const float* nw = F.in[11] + (size_t)l * HG_DV;
    const int k = tid & 127, tq = tid >> 7, r32 = lane & 31, hi = lane >> 5;
    const int vt = wave & 1, tt_ = (wave >> 1) & 1;
    constexpr int NU = BATCH * HG_H * HG_NC;
    bf16 zr[16], qr[16]; v4u vtw = (v4u){0u, 0u, 0u, 0u}; float lg0 = 0.f, lg1 = 0.f;
#define HGC_LOAD(u_) do { const int c_ = (u_) & (HG_NC - 1), bh_ = (u_) >> 8, h_ = bh_ & 7, b_ = bh_ >> 3; const size_t r0_ = (size_t)b_ * SEQ + (size_t)c_ * HG_C; \
        _Pragma("unroll") for (int tt = 0; tt < 16; ++tt) { const bf16* rp_ = main_ + (r0_ + tq * 16 + tt) * N_MAIN + h_ * HG_DK + k; zr[tt] = rp_[C_RF]; qr[tt] = rp_[C_RQ]; } \
        vtw = *(const v4u*)(main_ + (r0_ + (tid & 63)) * N_MAIN + C_RI + h_ * HG_DV + (tid >> 6) * 8); lg0 = F.in[10][h_ * HG_DK + k]; lg1 = F.in[10][HG_H * HG_DK + h_ * HG_DK + k]; } while (0)
    f32x4 nwv[4];
#pragma unroll
    for (int rg = 0; rg < 4; ++rg) nwv[rg] = *(const f32x4*)(nw + 32 * vt + 8 * rg + 4 * hi);
    int unit = F.bid;
    if (unit < NU) HGC_LOAD(unit);
    for (; unit < NU; unit += F.G) {
        const int c = unit & (HG_NC - 1), bh = unit >> 8, h = bh & 7, b = bh >> 3;
        const size_t row0 = (size_t)b * SEQ + (size_t)c * HG_C;
        s16x8 sf[8]; u32x2 gw[4];
        if (wave < 4) { const bf16* sp = UTB + (size_t)unit * 8192 + (32 * vt + r32) * 128 + 8 * hi;
#pragma unroll
            for (int ks = 0; ks < 8; ++ks) sf[ks] = *(const s16x8*)(sp + 16 * ks);
            const bf16* gp = main_ + (row0 + 32 * tt_ + r32) * N_MAIN + C_RG + h * HG_DV + 32 * vt + 4 * hi;
#pragma unroll
            for (int rg = 0; rg < 4; ++rg) gw[rg] = *(const u32x2*)(gp + 8 * rg); }
        const float lb = hgrn_lb2(lg0, lg1, l), lbe = fmaxf(lb, 1e-20f);
        float a[16], kc[16], q[16]; float run = 0.f;
#pragma unroll
        for (int tt = 0; tt < 16; ++tt) { const float z = bf2f(zr[tt]), qv = bf2f(qr[tt]);
            const float sg = sigm(z); run += __logf(lbe + (1.0f - lbe) * sg); a[tt] = run; kc[tt] = (1.0f - lb) * (1.0f - sg); q[tt] = qv * sigm(qv); }
        QT[tq * 128 + k] = run;
        { LAS unsigned short* vp = (LAS unsigned short*)(VT + ((tid >> 6) * 8) * HG_P + (tid & 63) * 2);
          vp[0 * (HG_P / 2)] = (unsigned short)(vtw.x & 0xffffu); vp[1 * (HG_P / 2)] = (unsigned short)(vtw.x >> 16);
          vp[2 * (HG_P / 2)] = (unsigned short)(vtw.y & 0xffffu); vp[3 * (HG_P / 2)] = (unsigned short)(vtw.y >> 16);
          vp[4 * (HG_P / 2)] = (unsigned short)(vtw.z & 0xffffu); vp[5 * (HG_P / 2)] = (unsigned short)(vtw.z >> 16);
          vp[6 * (HG_P / 2)] = (unsigned short)(vtw.w & 0xffffu); vp[7 * (HG_P / 2)] = (unsigned short)(vtw.w >> 16); }
        __syncthreads();
        float off = 0.f; const float aref = QT[k] + QT[128 + k];
#pragma unroll
        for (int qq = 0; qq < 3; ++qq) { if (qq < tq) off += QT[qq * 128 + k]; }
        const float earef = __expf(aref);
#pragma unroll
        for (int tt = 0; tt < 16; ++tt) { const int t = tq * 16 + tt; const float e1 = __expf(off + a[tt] - aref), qa = q[tt] * e1;
            *(LAS unsigned short*)(QA + t * HG_PK + k * 2) = (unsigned short)f2bf(qa);
            *(LAS unsigned short*)(KB + t * HG_PK + k * 2) = (unsigned short)f2bf(kc[tt] * __builtin_amdgcn_rcpf(e1));
            *(LAS unsigned short*)(QE + t * HG_PK + k * 2) = (unsigned short)f2bf(qa * earef); }
        __syncthreads();
        if (unit + F.G < NU) HGC_LOAD(unit + F.G);
        f32x16 O;
#pragma unroll
        for (int r = 0; r < 16; ++r) O[r] = 0.f;
        if (wave < 4) {
#pragma unroll
            for (int st = 0; st < 2; ++st) {
                if (st <= tt_) {
                    f32x16 acc;
#pragma unroll
                    for (int r = 0; r < 16; ++r) acc[r] = 0.f;
#pragma unroll
                    for (int ks = 0; ks < 8; ++ks) { const s16x8 A = *(const LAS s16x8*)(KB + (32 * st + r32) * HG_PK + (16 * ks + 8 * hi) * 2);
                        const s16x8 B = *(const LAS s16x8*)(QA + (32 * tt_ + r32) * HG_PK + (16 * ks + 8 * hi) * 2);
                        acc = __builtin_amdgcn_mfma_f32_32x32x16_bf16(A, B, acc, 0, 0, 0); }
                    if (st == tt_) {
#pragma unroll
                        for (int r = 0; r < 16; ++r) { if ((r & 3) + 8 * (r >> 2) + 4 * hi > r32) acc[r] = 0.f; } }
#pragma unroll
                    for (int s2 = 0; s2 < 2; ++s2) {
                        v4u pw; pw.x = pg8::cvt_pk_bf16(acc[8 * s2 + 0], acc[8 * s2 + 1]); pw.y = pg8::cvt_pk_bf16(acc[8 * s2 + 2], acc[8 * s2 + 3]);
                        pw.z = pg8::cvt_pk_bf16(acc[8 * s2 + 4], acc[8 * s2 + 5]); pw.w = pg8::cvt_pk_bf16(acc[8 * s2 + 6], acc[8 * s2 + 7]);
                        const int kb = (32 * st + 16 * s2 + 4 * hi) * 2;
                        const s16x4 lo = *(const LAS s16x4*)(VT + (32 * vt + r32) * HG_P + kb), hh = *(const LAS s16x4*)(VT + (32 * vt + r32) * HG_P + kb + 16);
                        O = __builtin_amdgcn_mfma_f32_32x32x16_bf16(__builtin_shufflevector(lo, hh, 0, 1, 2, 3, 4, 5, 6, 7), __builtin_bit_cast(s16x8, pw), O, 0, 0, 0);
                    }
                }
            }
#pragma unroll
            for (int ks = 0; ks < 8; ++ks) { const s16x8 B = *(const LAS s16x8*)(QE + (32 * tt_ + r32) * HG_PK + (16 * ks + 8 * hi) * 2);
                O = __builtin_amdgcn_mfma_f32_32x32x16_bf16(sf[ks], B, O, 0, 0, 0); }
            float ss = 0.f;
#pragma unroll
            for (int r = 0; r < 16; ++r) ss += O[r] * O[r];
            ss = xor32_sum(ss);
            if (hi == 0) SSQ[vt * 64 + 32 * tt_ + r32] = ss;
        }
        __syncthreads();
        if (wave < 4) {
            const float rstd = 1.0f / sqrtf((SSQ[32 * tt_ + r32] + SSQ[64 + 32 * tt_ + r32]) * (1.0f / HG_DV) + NORM_EPS);
            const size_t row = row0 + 32 * tt_ + r32;
#pragma unroll
            for (int rg = 0; rg < 4; ++rg) { const int v = 32 * vt + 8 * rg + 4 * hi;
                const f32x4 nv = nwv[rg];
                const float g0 = blo(gw[rg].x), g1 = bhi(gw[rg].x), g2 = blo(gw[rg].y), g3 = bhi(gw[rg].y);
                u32x2 w; w.x = pg8::cvt_pk_bf16(O[4 * rg] * rstd * nv.x * g0 * sigm(g0), O[4 * rg + 1] * rstd * nv.y * g1 * sigm(g1));
                w.y = pg8::cvt_pk_bf16(O[4 * rg + 2] * rstd * nv.z * g2 * sigm(g2), O[4 * rg + 3] * rstd * nv.w * g3 * sigm(g3));
                *(u32x2*)(FH + row * 512 + h * HG_DV + v) = w; }
        }
    }
#undef HGC_LOAD
    __syncthreads();
}


__device__ __forceinline__ void phase_hgrn_a3(Frame& F, int l) {
    PHASE_TID();
    LAS unsigned char* KDT = F.lds; LAS unsigned char* VT = F.lds + 18432; LAS float* QT = (LAS float*)(F.lds + 27648);
    const bf16* main_ = (const bf16*)(F.ws + WS_BIG); bf16* UTB = (bf16*)(F.ws + WS_UT); float* DD = (float*)(F.ws + WS_DD);
    const int k = tid & 127, tq = tid >> 7, r32 = lane & 31, hi = lane >> 5;
    constexpr int NU = BATCH * HG_H * HG_NC;
    bf16 zr[16]; v4u vtw = (v4u){0u, 0u, 0u, 0u}; float lg0 = 0.f, lg1 = 0.f;
#define HGA_LOAD(u_) do { const int c_ = (u_) & (HG_NC - 1), bh_ = (u_) >> 8, h_ = bh_ & 7, b_ = bh_ >> 3; const size_t r0_ = (size_t)b_ * SEQ + (size_t)c_ * HG_C; \
        _Pragma("unroll") for (int tt = 0; tt < 16; ++tt) zr[tt] = main_[(r0_ + tq * 16 + tt) * N_MAIN + C_RF + h_ * HG_DK + k]; \
        vtw = *(const v4u*)(main_ + (r0_ + (tid & 63)) * N_MAIN + C_RI + h_ * HG_DV + (tid >> 6) * 8); lg0 = F.in[10][h_ * HG_DK + k]; lg1 = F.in[10][HG_H * HG_DK + h_ * HG_DK + k]; } while (0)
    int unit = F.bid;
    if (unit < NU) HGA_LOAD(unit);
    for (; unit < NU; unit += F.G) {
        const float lb = hgrn_lb2(lg0, lg1, l), lbe = fmaxf(lb, 1e-20f);
        float a[16], kc[16]; float run = 0.f;
#pragma unroll
        for (int tt = 0; tt < 16; ++tt) { const float z = bf2f(zr[tt]); const float sg = sigm(z); run += __logf(lbe + (1.0f - lbe) * sg); a[tt] = run; kc[tt] = (1.0f - lb) * (1.0f - sg); }
        QT[tq * 128 + k] = run;
        { LAS unsigned short* vp = (LAS unsigned short*)(VT + ((tid >> 6) * 8) * HG_P + (tid & 63) * 2);
          vp[0 * (HG_P / 2)] = (unsigned short)(vtw.x & 0xffffu); vp[1 * (HG_P / 2)] = (unsigned short)(vtw.x >> 16);
          vp[2 * (HG_P / 2)] = (unsigned short)(vtw.y & 0xffffu); vp[3 * (HG_P / 2)] = (unsigned short)(vtw.y >> 16);
          vp[4 * (HG_P / 2)] = (unsigned short)(vtw.z & 0xffffu); vp[5 * (HG_P / 2)] = (unsigned short)(vtw.z >> 16);
          vp[6 * (HG_P / 2)] = (unsigned short)(vtw.w & 0xffffu); vp[7 * (HG_P / 2)] = (unsigned short)(vtw.w >> 16); }
        __syncthreads();
        if (unit + F.G < NU) HGA_LOAD(unit + F.G);
        float off = 0.f, tot = 0.f;
#pragma unroll
        for (int q = 0; q < 4; ++q) { const float x = QT[q * 128 + k]; if (q < tq) off += x; tot += x; }
        float kd[16];
#pragma unroll
        for (int tt = 0; tt < 16; ++tt) kd[tt] = kc[tt] * __expf(tot - (off + a[tt]));
        { v4u w0, w1; w0.x = pg8::cvt_pk_bf16(kd[0], kd[1]); w0.y = pg8::cvt_pk_bf16(kd[2], kd[3]); w0.z = pg8::cvt_pk_bf16(kd[4], kd[5]); w0.w = pg8::cvt_pk_bf16(kd[6], kd[7]);
          w1.x = pg8::cvt_pk_bf16(kd[8], kd[9]); w1.y = pg8::cvt_pk_bf16(kd[10], kd[11]); w1.z = pg8::cvt_pk_bf16(kd[12], kd[13]); w1.w = pg8::cvt_pk_bf16(kd[14], kd[15]);
          *(LAS v4u*)(KDT + k * HG_P + tq * 32) = w0; *(LAS v4u*)(KDT + k * HG_P + tq * 32 + 16) = w1; }
        if (tq == 0) DD[(size_t)unit * 128 + k] = __expf(tot);
        __syncthreads();
        { const int kt = wave >> 1, vt = wave & 1;
          f32x16 acc;
#pragma unroll
          for (int r = 0; r < 16; ++r) acc[r] = 0.f;
#pragma unroll
          for (int ks = 0; ks < 4; ++ks) { const s16x8 A = *(const LAS s16x8*)(KDT + (32 * kt + r32) * HG_P + (16 * ks + 8 * hi) * 2);
              const s16x8 B = *(const LAS s16x8*)(VT + (32 * vt + r32) * HG_P + (16 * ks + 8 * hi) * 2);
              acc = __builtin_amdgcn_mfma_f32_32x32x16_bf16(A, B, acc, 0, 0, 0); }
          bf16* up = UTB + (size_t)unit * 8192 + (32 * vt + r32) * 128 + 32 * kt + 4 * hi;
#pragma unroll
          for (int rg = 0; rg < 4; ++rg) { u32x2 w; w.x = pg8::cvt_pk_bf16(acc[4 * rg], acc[4 * rg + 1]); w.y = pg8::cvt_pk_bf16(acc[4 * rg + 2], acc[4 * rg + 3]); *(u32x2*)(up + 8 * rg) = w; } }
        __syncthreads();
    }
#undef HGA_LOAD
}

#if MK_CHECK
constexpr int CW_CHK = 64;
__device__ __forceinline__ float bfr(float f) { return __uint_as_float(f2bf(f) << 16); }
__device__ __forceinline__ float dot_ar_wc(const bf16* arow, const float* W, int K, int N, int c) {
    float s = 0.f;
#pragma unroll 8
    for (int k = 0; k < K; ++k) s += bf2f(arow[k]) * bfr(W[(size_t)k * N + c]);
    return s;
}
__device__ __forceinline__ bool chk_bad(float got, float ref) { return !(fabsf(got - ref) <= 0.04f + 0.03f * fabsf(ref)); }
__device__ __forceinline__ void chk_report(Frame& F, int ph, bool fail) { if (fail) atomicMax((unsigned*)(F.ws + WS_CTL) + CW_CHK, (unsigned)(NPHASES - ph)); }
__device__ __forceinline__ void chk_rc(int tid, int ph, int N, int& r, int& c) {
    unsigned h1 = ((unsigned)tid + 1u) * 2654435761u + (unsigned)ph * 40503u; h1 ^= h1 >> 15; h1 *= 0x85ebca6bu; h1 ^= h1 >> 13;
    unsigned h2 = ((unsigned)tid + 77u) * 0x9E3779B1u + (unsigned)ph * 7919u; h2 ^= h2 >> 16; h2 *= 0xc2b2ae35u; h2 ^= h2 >> 13;
    r = (int)(h1 % (unsigned)M); c = (int)(h2 % (unsigned)N);
    if (tid == 0) r = 0; if (tid == 1) r = M - 1; if (tid == 2) r = SEQ - 1; if (tid == 3) r = SEQ; if (tid == 4) r = M - 300; if (tid == 5) r = 31500;
}
__device__ __forceinline__ float chk_rstd_bf(const bf16* row) { float ss = 0.f; for (int k = 0; k < D_MODEL; ++k) { const float v = bf2f(row[k]); ss += v * v; } return 1.0f / sqrtf(ss * (1.0f / D_MODEL) + NORM_EPS); }
__device__ __forceinline__ float chk_rstd_f(const float* row) { float ss = 0.f; for (int k = 0; k < D_MODEL; ++k) { const float v = row[k]; ss += v * v; } return 1.0f / sqrtf(ss * (1.0f / D_MODEL) + NORM_EPS); }
__device__ __forceinline__ void chk_x16(Frame& F, int ph) {
    PHASE_TID(); int r, c; chk_rc(tid, ph, D_MODEL, r, c);
    const float* x = F.in[0];
    bool fail = chk_bad(bf2f(((const bf16*)(F.ws + WS_X16))[(size_t)r * D_MODEL + c]), x[(size_t)r * D_MODEL + c]);
    const float rr = chk_rstd_f(x + (size_t)r * D_MODEL), rg = ((const float*)(F.ws + WS_RS))[r];
    fail = fail || !(fabsf(rg - rr) <= 0.002f * rr);
    chk_report(F, ph, fail);
}
__device__ __forceinline__ float dot_ar_wc_g(const bf16* arow, const float* W, int K, int N, int c, const float* gain) {
    float s = 0.f;
#pragma unroll 8
    for (int k = 0; k < K; ++k) s += bf2f(arow[k]) * bfr(W[(size_t)k * N + c] * (gain ? gain[k] : 1.0f));
    return s;
}
__device__ __forceinline__ void chk_gu(Frame& F, int ph, const float* Wgu, const float* gain) {
    PHASE_TID(); int r, j; chk_rc(tid, ph, D_FF, r, j);
    const bf16* a = (const bf16*)(F.ws + WS_X16) + (size_t)r * D_MODEL; const float rs = ((const float*)(F.ws + WS_RS))[r];
    const float g = rs * dot_ar_wc_g(a, Wgu, D_MODEL, 2 * D_FF, j, gain), u = rs * dot_ar_wc_g(a, Wgu, D_MODEL, 2 * D_FF, D_FF + j, gain);
    chk_report(F, ph, chk_bad(bf2f(((const bf16*)(F.ws + WS_BIG))[(size_t)r * D_FF + j]), g * sigm(g) * u));
}
__device__ __forceinline__ void chk_plain(Frame& F, int ph, const bf16* A, int K, const float* W, int NW, int coff, const bf16* OUT, int N, int act, const float* gain) {
    PHASE_TID(); int r, c; chk_rc(tid, ph, N, r, c);
    float ref = dot_ar_wc_g(A + (size_t)r * K, W, K, NW, coff + c, gain); if (gain) ref *= ((const float*)(F.ws + WS_RS))[r]; if (act == 2) ref = sigm(ref);
    chk_report(F, ph, chk_bad(bf2f(OUT[(size_t)r * N + c]), ref));
}
__device__ __forceinline__ void chk_norm(Frame& F, int ph, float alpha, const float* wpost, bool final_) {
    PHASE_TID(); int r, c; chk_rc(tid, ph, D_MODEL, r, c);
    const bf16* y = (const bf16*)(F.ws + WS_Y) + (size_t)r * D_MODEL;
    const float xi = ((const float*)(F.ws + WS_END))[tid];
    const float ref = xi + alpha * bf2f(y[c]) * chk_rstd_bf(y) * wpost[c];
    bool fail;
    if (final_) fail = !(fabsf(F.out[(size_t)r * D_MODEL + c] - ref) <= 0.01f + 0.01f * fabsf(ref));
    else { const bf16* xr = (const bf16*)(F.ws + WS_X16) + (size_t)r * D_MODEL;
        fail = chk_bad(bf2f(xr[c]), ref);
        const float rr = chk_rstd_bf(xr), rg = ((const float*)(F.ws + WS_RS))[r]; fail = fail || !(fabsf(rg - rr) <= 0.01f * rr); }
    chk_report(F, ph, fail);
}
__device__ __forceinline__ void chk_save(Frame& F, int ph) {
    PHASE_TID(); int r, c; chk_rc(tid, ph, D_MODEL, r, c);
    ((float*)(F.ws + WS_END))[tid] = bf2f(((const bf16*)(F.ws + WS_X16))[(size_t)r * D_MODEL + c]);
}
__device__ __forceinline__ void chk_conv(Frame& F, int ph, int l) {
    PHASE_TID(); int r, c; chk_rc(tid, ph, CONV_WIDTH, r, c);
    const bf16* mn = (const bf16*)(F.ws + WS_BIG); const float* cw = F.in[8] + (size_t)l * 3 * CONV_WIDTH; const int t = r & (SEQ - 1);
    float y = 0.f;
    for (int j = 0; j < 3; ++j) if (t - j >= 0) { const bf16* rp = mn + (size_t)(r - j) * N_MAIN; y += cw[(2 - j) * CONV_WIDTH + c] * bf2f(rp[C_CC + c]) * bf2f(rp[C_CX + c]); }
    const float ref = bf2f(mn[(size_t)r * N_MAIN + C_CB + c]) * y;
    chk_report(F, ph, chk_bad(bf2f(((const bf16*)(F.ws + WS_FC))[(size_t)r * CONV_WIDTH + c]), ref));
}
__device__ __forceinline__ void chk_attn(Frame& F, int ph, int l) {
    PHASE_TID(); int r, c; chk_rc(tid, ph, 1024, r, c);
    const bf16* mn = (const bf16*)(F.ws + WS_BIG); const int h = c >> 6, d = c & 63, hk = h >> 3, t = r & (SEQ - 1);
    const float slope = exp2f(-0.5f * (float)(h + 1)), sink = F.in[9][l * NHEAD + h];
    const bf16* qp = mn + (size_t)r * N_MAIN + C_AQ + h * 64; const int jmax = t < 127 ? t : 127;
    float mx = sink;
#pragma unroll 1
    for (int j = 0; j <= jmax; ++j) { const bf16* kp = mn + (size_t)(r - j) * N_MAIN + C_AK + hk * 64; float s = 0.f;
#pragma unroll 1
        for (int e = 0; e < 64; ++e) s += bf2f(qp[e]) * bf2f(kp[e]);
        s = s * 0.125f - slope * (float)j; mx = fmaxf(mx, s); }
    float den = expf(sink - mx), acc = 0.f;
#pragma unroll 1
    for (int j = 0; j <= jmax; ++j) { const bf16* kp = mn + (size_t)(r - j) * N_MAIN + C_AK + hk * 64; float s = 0.f;
#pragma unroll 1
        for (int e = 0; e < 64; ++e) s += bf2f(qp[e]) * bf2f(kp[e]);
        s = s * 0.125f - slope * (float)j;
        const float p = expf(s - mx); den += p; acc += p * bf2f(mn[(size_t)(r - j) * N_MAIN + C_AV + hk * 64 + d]); }
    chk_report(F, ph, chk_bad(bf2f(((const bf16*)(F.ws + WS_FA))[(size_t)r * 1024 + c]), acc / den));
}
__device__ __forceinline__ void chk_hgrn(Frame& F, int ph, int l, int b, int h, int c0) {
    PHASE_TID();
    LAS float* L = (LAS float*)F.lds; LAS float* S = L; LAS float* PO = L + 8192;
    const bf16* mn = (const bf16*)(F.ws + WS_BIG); const bf16* FH = (const bf16*)(F.ws + WS_FH);
    const int v = tid & 63, kg = tid >> 6;
    for (int kk = 0; kk < 16; ++kk) { const int k = kg * 16 + kk; S[k * 64 + v] = c0 ? bf2f(((const bf16*)(F.ws + WS_UT))[(size_t)(((b * HG_H + h) << 8) + c0) * 8192 + v * 128 + k]) : 0.f; }
    __syncthreads();
    bool fail = false;
    for (int t = 0; t < 200; ++t) {
        const size_t row = (size_t)b * SEQ + (size_t)c0 * HG_C + t; const bf16* rp = mn + row * N_MAIN;
        const float iv = bf2f(rp[C_RI + h * 64 + v]); float po = 0.f;
        for (int kk = 0; kk < 16; ++kk) { const int k = kg * 16 + kk;
            const float lb = hgrn_lb(F.in[10], l, h * HG_DK + k), lbe = fmaxf(lb, 1e-20f);
            const float z = bf2f(rp[C_RF + h * HG_DK + k]), sg = 1.0f / (1.0f + expf(-z));
            const float f = lbe + (1.0f - lbe) * sg, kc = (1.0f - lb) * (1.0f - sg);
            const float qr = bf2f(rp[C_RQ + h * HG_DK + k]), qv = qr / (1.0f + expf(-qr));
            const float s = f * S[k * 64 + v] + kc * iv; S[k * 64 + v] = s; po += s * qv; }
        PO[kg * 64 + v] = po;
        __syncthreads();
        if (tid < 64) { float o = 0.f; for (int q = 0; q < 8; ++q) o += PO[q * 64 + tid];
            const float ss = wave_sum(o * o); const float gv = bf2f(rp[C_RG + h * 64 + tid]);
            const float ref = o * (1.0f / sqrtf(ss * (1.0f / 64.0f) + NORM_EPS)) * F.in[11][l * HG_DV + tid] * gv / (1.0f + expf(-gv));
            fail = fail || chk_bad(bf2f(FH[row * 512 + h * 64 + tid]), ref); }
        __syncthreads();
    }
    chk_report(F, ph, fail);
}
__device__ __forceinline__ void chk_merge(Frame& F, int ph, int l) {
    PHASE_TID(); int r, c; chk_rc(tid, ph, D_MODEL, r, c);
    const bf16* a = (const bf16*)(F.ws + WS_X16) + (size_t)r * D_MODEL; const float rs = ((const float*)(F.ws + WS_RS))[r];
    const float* Win = F.in[7] + (size_t)l * D_MODEL * D_IN; const float* gain = F.in[6] + l * D_MODEL;
    const bf16* YB = (const bf16*)(F.ws + WS_BIG);
    float ref = 0.f;
    for (int b = 0; b < 3; ++b) { const float g = sigm(rs * dot_ar_wc_g(a, Win, D_MODEL, D_IN, N_MAIN + b * D_MODEL + c, gain));
        ref += g * bf2f(YB[(size_t)b * M * D_MODEL + (size_t)r * D_MODEL + c]); }
    chk_report(F, ph, chk_bad(bf2f(((const bf16*)(F.ws + WS_MG))[(size_t)r * D_MODEL + c]), ref));
}
__device__ __forceinline__ void chk_ple(Frame& F, int ph, int l) {
    PHASE_TID(); int r, c; chk_rc(tid, ph, D_MODEL, r, c);
    const float y = dot_ar_wc((const bf16*)(F.ws + WS_PB) + (size_t)r * PLE_DIM, F.in[23] + (size_t)l * PLE_DIM * D_MODEL, PLE_DIM, D_MODEL, c);
    const float ref = bf2f(((const bf16*)(F.ws + WS_BIG))[(size_t)r * D_MODEL + c]) * y;
    chk_report(F, ph, chk_bad(bf2f(((const bf16*)(F.ws + WS_Y))[(size_t)r * D_MODEL + c]), ref));
}
#endif

__global__ void __launch_bounds__(NTHR, 2) fwd(Args args) {
    extern __shared__ __attribute__((aligned(16))) unsigned char lds[];
    Frame F0;
    F0.lds = (LAS unsigned char*)lds;
    F0.G = gridDim.x; F0.bid = blockIdx.x; F0.in = args.in; F0.out = args.out; F0.ws = args.ws; F0.wv = __builtin_amdgcn_readfirstlane((int)(threadIdx.x >> 6));
    unsigned char* ws0 = args.ws;
    volatile LAS unsigned* MISC = (volatile LAS unsigned*)(F0.lds + MISC_OFF);
    if (threadIdx.x < 32) MISC[threadIdx.x] = 0u;
    __syncthreads();
#if MK_ONE_LAUNCH
    XcdBarrier bar = xcd_barrier_post((unsigned*)(ws0 + WS_CTL) + CW_BAR, MISC + 8);
#define GRID_BAR() xcd_barrier(bar)
#else
#define GRID_BAR() do {} while (0)
#endif
    const int lo = args.ph_lo, hi = args.ph_hi;
#define IN(k) (lo <= (k) && (k) < hi)
#if MK_CHECK
#define SEAM(k) do { if (IN(k)) GRID_BAR(); } while (0)
#define CHKL(kl, k, stmt) do { if (IN(k)) { if (((MK_CHECK_MASK >> (kl)) & 1) && F0.bid == 0) { PH_OPQ(); stmt; } GRID_BAR(); } } while (0)
#define CHKSAVE(k) do { if (F0.bid == 0) chk_save(F, (k)); GRID_BAR(); } while (0)
#else
#define CHKSAVE(k) do {} while (0)
#define SEAM(k) do { if (IN(k) && IN((k) + 1)) GRID_BAR(); } while (0)
#define CHKL(kl, k, stmt) do {} while (0)
#endif
#define PH_OPQ() Frame F = F0; int l = l0; GAS unsigned char* wsg_ = (GAS unsigned char*)ws0; asm volatile("" : "+s"(wsg_), "+s"(l)); unsigned char* ws = (unsigned char*)wsg_; F.ws = ws;     \
    bf16* X16 = (bf16*)(ws + WS_X16); bf16* Y = (bf16*)(ws + WS_Y); bf16* BIG = (bf16*)(ws + WS_BIG); bf16* MG = (bf16*)(ws + WS_MG); const float* RS = (const float*)(ws + WS_RS); \
    (void)X16; (void)Y; (void)BIG; (void)MG; (void)RS; (void)l
    using pg8::Gemm; using pg8::StaticOrder;
#define GEMM_RUN(EPI) pg8::gemm_phase<EPI, StaticOrder, PG8_ALIGN, PG8_SP2>(F.lds, g, S, E, F.wv);
#define NORM_RUN(k, alpha, wpost, fin) do { CHKSAVE(k); phase_norm(F, (alpha), (wpost), (fin), (k)); } while (0)

    for (int l0 = 0; l0 < DEPTH; ++l0) {
        const int P = l0 * NPH;
        if (IN(P + 0)) { PH_OPQ(); phase_convert(F, l); } SEAM(P + 0); CHKL(0, P + 0, if (l == 0) chk_x16(F, P + 0));
        if (IN(P + 1)) { PH_OPQ(); Gemm g{X16, (const bf16*)(ws + WS_GU1), M, 2 * D_FF, D_MODEL}; StaticOrder S; S.init(M, 2 * D_FF, F.G, F.bid);
            pg8::EpiSwiglu E{BIG, D_FF, RS}; GEMM_RUN(pg8::EpiSwiglu) } SEAM(P + 1); CHKL(1, P + 1, chk_gu(F, P + 1, F.in[3] + (size_t)l * D_MODEL * 2 * D_FF, F.in[2] + l * D_MODEL));
        if (IN(P + 2)) { PH_OPQ(); Gemm g{BIG, (const bf16*)(ws + WS_D1), M, D_MODEL, D_FF}; StaticOrder S; S.init(M, D_MODEL, F.G, F.bid);
            pg8::EpiBf16<0> E{Y, D_MODEL, nullptr}; GEMM_RUN(pg8::EpiBf16<0>) } SEAM(P + 2); CHKL(2, P + 2, chk_plain(F, P + 2, BIG, D_FF, F.in[4] + (size_t)l * D_FF * D_MODEL, D_MODEL, 0, Y, D_MODEL, 0, nullptr));
        if (IN(P + 3)) { PH_OPQ(); NORM_RUN(P + 3, 0.5f, F.in[5] + l * D_MODEL, false); } SEAM(P + 3); CHKL(3, P + 3, chk_norm(F, P + 3, 0.5f, F.in[5] + l * D_MODEL, false));
        if (IN(P + 4)) { PH_OPQ(); Gemm g{X16, (const bf16*)(ws + WS_WIN), M, N_MAIN, D_MODEL}; StaticOrder S; S.init(M, N_MAIN, F.G, F.bid);
            pg8::EpiBf16<0> E{BIG, N_MAIN, RS}; GEMM_RUN(pg8::EpiBf16<0>) } SEAM(P + 4); CHKL(4, P + 4, chk_plain(F, P + 4, X16, D_MODEL, F.in[7] + (size_t)l * D_MODEL * D_IN, D_IN, 0, BIG, N_MAIN, 0, F.in[6] + l * D_MODEL));
        if (IN(P + 5)) { PH_OPQ(); phase_conv(F, l); phase_attn_mfma(F, l); phase_hgrn_a3(F, l); } SEAM(P + 5); CHKL(5, P + 5, chk_conv(F, P + 5, l); chk_attn(F, P + 5, l));
        if (IN(P + 6)) { PH_OPQ(); phase_hgrn_scan2(F); } SEAM(P + 6);
        if (IN(P + 7)) { PH_OPQ(); phase_hgrn_c3(F, l); } SEAM(P + 7); CHKL(7, P + 7, chk_hgrn(F, P + 7, l, 1, 5, 0); chk_hgrn(F, P + 7, l, 0, 2, 100); chk_hgrn(F, P + 7, l, 1, 7, 252));
        if (IN(P + 8)) { PH_OPQ();
            StaticOrder S; S.init(M, D_MODEL, F.G, F.bid);
            { Gemm g{(const bf16*)(ws + WS_FC), (const bf16*)(ws + WS_BC), M, D_MODEL, CONV_WIDTH};
              pg8::EpiBf16<0> E{BIG, D_MODEL, nullptr}; pg8::gemm_phase<pg8::EpiBf16<0>, StaticOrder, PG8_ALIGN, PG8_SP2>(F.lds, g, S, E, F.wv); }
            { Gemm g{(const bf16*)(ws + WS_FA), (const bf16*)(ws + WS_BA), M, D_MODEL, 1024};
              pg8::EpiBf16<0> E{BIG + (size_t)M * D_MODEL, D_MODEL, nullptr}; pg8::gemm_phase<pg8::EpiBf16<0>, StaticOrder, PG8_ALIGN, PG8_SP2>(F.lds, g, S, E, F.wv); }
            { Gemm g{(const bf16*)(ws + WS_FH), (const bf16*)(ws + WS_BH), M, D_MODEL, 512};
              pg8::EpiBf16<0> E{BIG + (size_t)2 * M * D_MODEL, D_MODEL, nullptr}; pg8::gemm_phase<pg8::EpiBf16<0>, StaticOrder, PG8_ALIGN, PG8_SP2>(F.lds, g, S, E, F.wv); }
        } SEAM(P + 8); CHKL(8, P + 8, chk_plain(F, P + 8, (const bf16*)(ws + WS_FC), CONV_WIDTH, F.in[12] + (size_t)l * CONV_WIDTH * D_MODEL, D_MODEL, 0, BIG, D_MODEL, 0, nullptr);
                                  chk_plain(F, P + 8, (const bf16*)(ws + WS_FA), 1024, F.in[13] + (size_t)l * 1024 * D_MODEL, D_MODEL, 0, BIG + (size_t)M * D_MODEL, D_MODEL, 0, nullptr);
                                  chk_plain(F, P + 8, (const bf16*)(ws + WS_FH), 512, F.in[14] + (size_t)l * 512 * D_MODEL, D_MODEL, 0, BIG + (size_t)2 * M * D_MODEL, D_MODEL, 0, nullptr));
        if (IN(P + 9)) { PH_OPQ(); Gemm g{X16, (const bf16*)(ws + WS_WIN) + (size_t)N_MAIN * D_MODEL, M, N_GATES, D_MODEL}; pg8::MergeOrder S; S.base.init(M, D_MODEL, F.G, F.bid);
            pg8::EpiGateMerge E{BIG, MG, RS, (size_t)M * D_MODEL};
            pg8::gemm_phase<pg8::EpiGateMerge, pg8::MergeOrder, PG8_ALIGN, PG8_SP2>(F.lds, g, S, E, F.wv); } SEAM(P + 9); CHKL(9, P + 9, chk_merge(F, P + 9, l));
        if (IN(P + 10)) { PH_OPQ(); Gemm g{MG, (const bf16*)(ws + WS_WO), M, D_MODEL, D_MODEL}; StaticOrder S; S.init(M, D_MODEL, F.G, F.bid);
            pg8::EpiBf16<0> E{Y, D_MODEL, nullptr}; GEMM_RUN(pg8::EpiBf16<0>) } SEAM(P + 10); CHKL(10, P + 10, chk_plain(F, P + 10, MG, D_MODEL, F.in[15] + (size_t)l * D_MODEL * D_MODEL, D_MODEL, 0, Y, D_MODEL, 0, nullptr));
        if (IN(P + 11)) { PH_OPQ(); NORM_RUN(P + 11, 1.0f, F.in[16] + l * D_MODEL, false); } SEAM(P + 11); CHKL(11, P + 11, chk_norm(F, P + 11, 1.0f, F.in[16] + l * D_MODEL, false));
        if (IN(P + 12)) { PH_OPQ(); Gemm g{X16, (const bf16*)(ws + WS_GU2), M, 2 * D_FF, D_MODEL}; StaticOrder S; S.init(M, 2 * D_FF, F.G, F.bid);
            pg8::EpiSwiglu E{BIG, D_FF, RS}; GEMM_RUN(pg8::EpiSwiglu) } SEAM(P + 12); CHKL(12, P + 12, chk_gu(F, P + 12, F.in[18] + (size_t)l * D_MODEL * 2 * D_FF, F.in[17] + l * D_MODEL));
        if (IN(P + 13)) { PH_OPQ(); Gemm g{BIG, (const bf16*)(ws + WS_D2), M, D_MODEL, D_FF}; StaticOrder S; S.init(M, D_MODEL, F.G, F.bid);
            pg8::EpiBf16<0> E{Y, D_MODEL, nullptr}; GEMM_RUN(pg8::EpiBf16<0>) } SEAM(P + 13); CHKL(13, P + 13, chk_plain(F, P + 13, BIG, D_FF, F.in[19] + (size_t)l * D_FF * D_MODEL, D_MODEL, 0, Y, D_MODEL, 0, nullptr));
        if (IN(P + 14)) { PH_OPQ(); NORM_RUN(P + 14, 0.5f, F.in[20] + l * D_MODEL, false); } SEAM(P + 14); CHKL(14, P + 14, chk_norm(F, P + 14, 0.5f, F.in[20] + l * D_MODEL, false));
        if (IN(P + 15)) { PH_OPQ(); Gemm g{X16, (const bf16*)(ws + WS_PG), M, D_MODEL, D_MODEL}; StaticOrder S; S.init(M, D_MODEL, F.G, F.bid);
            pg8::EpiBf16<2> E{BIG, D_MODEL, RS}; GEMM_RUN(pg8::EpiBf16<2>) } SEAM(P + 15); CHKL(15, P + 15, chk_plain(F, P + 15, X16, D_MODEL, F.in[22] + (size_t)l * D_MODEL * D_MODEL, D_MODEL, 0, BIG, D_MODEL, 2, F.in[21] + l * D_MODEL));
        if (IN(P + 16)) { PH_OPQ(); Gemm g{(const bf16*)(ws + WS_PB), (const bf16*)(ws + WS_PP), M, D_MODEL, PLE_DIM}; StaticOrder S; S.init(M, D_MODEL, F.G, F.bid);
            pg8::EpiGateMul E{BIG, D_MODEL, Y, D_MODEL, 0}; GEMM_RUN(pg8::EpiGateMul) } SEAM(P + 16); CHKL(16, P + 16, chk_ple(F, P + 16, l));
        if (IN(P + 17)) { PH_OPQ(); NORM_RUN(P + 17, 1.0f, F.in[24] + l * D_MODEL, l + 1 == DEPTH); } SEAM(P + 17); CHKL(17, P + 17, chk_norm(F, P + 17, 1.0f, F.in[24] + l * D_MODEL, l + 1 == DEPTH));
    }
#if MK_CHECK
    if (F0.bid == 0 && threadIdx.x == 0) { const unsigned v = __hip_atomic_load((unsigned*)(ws0 + WS_CTL) + CW_CHK, __ATOMIC_RELAXED, __HIP_MEMORY_SCOPE_AGENT); if (v) F0.out[0] = 1000.0f * (float)v;
        const unsigned v2 = __hip_atomic_load((unsigned*)(ws0 + WS_CTL) + 65, __ATOMIC_RELAXED, __HIP_MEMORY_SCOPE_AGENT);
        if (v2 && !v) { const unsigned n = __hip_atomic_load((unsigned*)(ws0 + WS_CTL) + 128 + (NPHASES - v2), __ATOMIC_RELAXED, __HIP_MEMORY_SCOPE_AGENT); F0.out[1] = 100.0f + (float)n; } }
#endif
#undef IN
#undef SEAM
}

extern "C" void kernel_launch(void* const* d_in, const int* in_sizes, int n_in, void* d_out, int out_size, void* d_ws, size_t ws_size, hipStream_t stream) {
    static int grid = 0;
    if (grid == 0) {
        if (n_in != 25 || in_sizes[0] != M * D_MODEL || out_size != M * D_MODEL || ws_size < WS_END) {
            fprintf(stderr, "kernel_launch: unexpected shapes (n_in %d, in0 %d, out %d, ws %zu < %zu); nothing launched\n", n_in, n_in > 0 ? in_sizes[0] : -1, out_size, ws_size, (size_t)WS_END); grid = -1; return; }
        int dev = 0, cus = 0, per_cu = 0;
        if (hipGetDevice(&dev) != hipSuccess || hipDeviceGetAttribute(&cus, hipDeviceAttributeMultiprocessorCount, dev) != hipSuccess) { grid = -1; return; }
        if (hipFuncSetAttribute((const void*)fwd, hipFuncAttributeMaxDynamicSharedMemorySize, LDS_BYTES) != hipSuccess) { fprintf(stderr, "kernel_launch: hipFuncSetAttribute failed\n"); grid = -1; return; }
        if (hipOccupancyMaxActiveBlocksPerMultiprocessor(&per_cu, (const void*)fwd, NTHR, LDS_BYTES) != hipSuccess || per_cu < 1)
            fprintf(stderr, "kernel_launch: note: occupancy query reports %d workgroups per CU\n", per_cu);
        (void)hipGetLastError();
        grid = cus;
    }
    if (grid < 0) return;
    if (hipMemsetAsync((char*)d_ws + WS_CTL, 0, CTL_ZERO_BYTES, stream) != hipSuccess) { fprintf(stderr, "kernel_launch: memset failed\n"); return; }
    Args a{};
    for (int i = 0; i < 25; ++i) a.in[i] = (const float*)d_in[i];
    a.out = (float*)d_out; a.ws = (unsigned char*)d_ws;
#if MK_ONE_LAUNCH
    a.ph_lo = 0; a.ph_hi = NPHASES;
    hipLaunchKernelGGL(fwd, dim3(grid), dim3(NTHR), LDS_BYTES, stream, a);
#else
    for (int ph = 0; ph < NPHASES; ++ph) {
        a.ph_lo = ph; a.ph_hi = ph + 1;
        hipLaunchKernelGGL(fwd, dim3(grid), dim3(NTHR), LDS_BYTES, stream, a);
    }
#endif
    const hipError_t le = hipPeekAtLastError();
    if (le != hipSuccess) fprintf(stderr, "kernel_launch: launch failed: %s\n", hipGetErrorName(le));
}
```
